# Optimizing an MI355X kernel written in HIP

```python
import jax, jax.numpy as jnp
from jax import lax
import numpy as np

D_MODEL = 2048
BATCH = 1
SEQ = 16384
DEPTH = 2

CHUNK = 64
HEAD_DIM = 128
D_MIX = D_MODEL
D_GDN = D_MIX // 2
D_SB = D_MIX - D_GDN
N_HEADS_GDN = D_GDN // HEAD_DIM
N_HEADS_SB = D_SB // HEAD_DIM
SHORT_CONV = 4
FFN_CONV = 3
D_FF = ((8 * D_MODEL // 3 + 255) // 256) * 256
SB_BLOCK = 128
EPS = 1e-6
D_IN = 4 * D_GDN + 2 * N_HEADS_GDN + 3 * D_SB

kernel_name = "hybrid_gdn_stickbreaking_convffn_adaln"


def rms_norm(x, gain):
    xf = x.astype(jnp.float32)
    y = xf * lax.rsqrt(jnp.mean(xf * xf, axis=-1, keepdims=True) + EPS)
    return (y * gain.astype(jnp.float32)).astype(x.dtype)


def l2_norm(x):
    xf = x.astype(jnp.float32)
    return xf * lax.rsqrt(jnp.sum(xf * xf, axis=-1, keepdims=True) + EPS)


def causal_dwconv(x, w):
    width = w.shape[0]
    t = x.shape[1]
    xp = jnp.pad(x, ((0, 0), (width - 1, 0), (0, 0)))
    y = xp[:, width - 1:width - 1 + t] * w[width - 1]
    for i in range(width - 1):
        y = y + xp[:, i:i + t] * w[i]
    return y


def gated_delta_rule(q, k, v, g, beta):
    b, t, h, dk = q.shape
    dv = v.shape[-1]
    n, c = t // CHUNK, CHUNK

    def chunks(a):
        a = a.reshape((b, n, c, h) + a.shape[3:])
        return jnp.moveaxis(a, (1, 3), (0, 2))

    q, k, v, g, beta = chunks(q), chunks(k), chunks(v), chunks(g), chunks(beta)
    g = jnp.cumsum(g, axis=-1)
    tri_incl = jnp.tril(jnp.ones((c, c), bool))
    tri_strict = jnp.tril(jnp.ones((c, c), bool), -1)
    decay = jnp.exp(jnp.where(tri_incl, g[..., :, None] - g[..., None, :], -jnp.inf))
    k_beta = k * beta[..., None]
    v_beta = v * beta[..., None]
    lower = jnp.where(tri_strict, jnp.einsum('nbhik,nbhjk->nbhij', k_beta, k) * decay, 0.0)
    eye = jnp.eye(c, dtype=q.dtype)
    t_inv = lax.linalg.triangular_solve(eye + lower, jnp.broadcast_to(eye, lower.shape),
                                        left_side=True, lower=True)
    u = t_inv @ v_beta
    w = t_inv @ (k_beta * jnp.exp(g)[..., None])
    attn_intra = jnp.where(tri_incl, jnp.einsum('nbhik,nbhjk->nbhij', q, k) * decay, 0.0)

    def step(state, inp):
        q_c, k_c, u_c, w_c, g_c, a_c = inp
        v_new = u_c - w_c @ state
        o = (q_c * jnp.exp(g_c)[..., None]) @ state + a_c @ v_new
        g_last = g_c[..., -1]
        k_dec = k_c * jnp.exp(g_last[..., None] - g_c)[..., None]
        state = state * jnp.exp(g_last)[..., None, None] + jnp.einsum('bhck,bhcv->bhkv', k_dec, v_new)
        return state, o

    s0 = jnp.zeros((b, h, dk, dv), q.dtype)
    _, o = lax.scan(step, s0, (q, k, u, w, g, attn_intra))
    return jnp.moveaxis(o, (0, 2), (1, 3)).reshape(b, t, h, dv)


def stick_breaking_attention(q, k, v):
    b, t, h, d = q.shape
    nb = t // SB_BLOCK
    kh = jnp.swapaxes(k, 1, 2)
    vh = jnp.swapaxes(v, 1, 2)
    qb = q.reshape(b, nb, SB_BLOCK, h, d).transpose(1, 0, 3, 2, 4)
    key_pos = jnp.arange(t)
    scale = d ** -0.5

    def block(args):
        q_blk, start = args
        q_pos = start + jnp.arange(SB_BLOCK)
        mask = key_pos[None, :] < q_pos[:, None]
        z = jnp.einsum('bhqd,bhkd->bhqk', q_blk, kh) * scale
        log_stay = jnp.where(mask, jax.nn.log_sigmoid(-z), 0.0)
        between = lax.cumsum(log_stay, axis=3, reverse=True) - log_stay
        a = jnp.where(mask, jnp.exp(jax.nn.log_sigmoid(z) + between), 0.0)
        return jnp.einsum('bhqk,bhkd->bhqd', a, vh)

    starts = jnp.arange(nb) * SB_BLOCK
    o = lax.map(block, (qb, starts))
    return o.transpose(1, 0, 3, 2, 4).reshape(b, t, h, d)


def hybrid_layer(x, mod, norm1, w_in, conv_qkv, a_log, dt_bias, gdn_norm,
                 sb_q_norm, sb_k_norm, w_out, norm2, w_up, conv_ffn, w_down):
    b, t, _ = x.shape
    shift1, scale1, gate1, shift2, scale2, gate2 = jnp.split(mod, 6, axis=-1)

    h = rms_norm(x, norm1) * (1.0 + scale1[:, None]) + shift1[:, None]
    proj = h @ w_in
    o0 = 3 * D_GDN
    o1 = o0 + D_GDN
    o2 = o1 + N_HEADS_GDN
    o3 = o2 + N_HEADS_GDN
    qkv_a = jax.nn.silu(causal_dwconv(proj[..., :o0], conv_qkv)).astype(jnp.float32)
    z_a = proj[..., o0:o1].astype(jnp.float32)
    b_a = proj[..., o1:o2].astype(jnp.float32)
    a_a = proj[..., o2:o3].astype(jnp.float32)
    q_b, k_b, v_b = jnp.split(proj[..., o3:].astype(jnp.float32), 3, axis=-1)

    q_a, k_a, v_a = jnp.split(qkv_a, 3, axis=-1)
    q_a = l2_norm(q_a.reshape(b, t, N_HEADS_GDN, HEAD_DIM)) * (HEAD_DIM ** -0.5)
    k_a = l2_norm(k_a.reshape(b, t, N_HEADS_GDN, HEAD_DIM))
    v_a = v_a.reshape(b, t, N_HEADS_GDN, HEAD_DIM)
    beta = jax.nn.sigmoid(b_a)
    g = -jnp.exp(a_log.astype(jnp.float32)) * jax.nn.softplus(a_a + dt_bias.astype(jnp.float32))
    o_a = gated_delta_rule(q_a, k_a, v_a, g, beta)
    o_a = rms_norm(o_a, gdn_norm) * jax.nn.silu(z_a.reshape(b, t, N_HEADS_GDN, HEAD_DIM))
    o_a = o_a.reshape(b, t, D_GDN)

    q_b = rms_norm(q_b.reshape(b, t, N_HEADS_SB, HEAD_DIM), sb_q_norm)
    k_b = rms_norm(k_b.reshape(b, t, N_HEADS_SB, HEAD_DIM), sb_k_norm)
    v_b = v_b.reshape(b, t, N_HEADS_SB, HEAD_DIM)
    o_b = stick_breaking_attention(q_b, k_b, v_b).reshape(b, t, D_SB)

    y = jnp.concatenate([o_a, o_b], axis=-1).astype(x.dtype) @ w_out
    x = x + gate1[:, None] * y

    h2 = rms_norm(x, norm2) * (1.0 + scale2[:, None]) + shift2[:, None]
    gate_br, val_br = jnp.split(h2 @ w_up, 2, axis=-1)
    f = (jax.nn.silu(causal_dwconv(gate_br, conv_ffn)) * val_br) @ w_down
    return x + gate2[:, None] * f


def setup_inputs(seed: int = 0) -> dict:
    key = jax.random.key(seed)
    ks = jax.random.split(key, 20)
    f32 = jnp.float32
    nrm = lambda k, shape, s: jax.random.normal(k, shape, f32) * s
    dt = jnp.exp(jax.random.uniform(ks[8], (DEPTH, N_HEADS_GDN), f32, np.log(1e-3), np.log(1e-1)))
    return {
        "x": nrm(ks[0], (BATCH, SEQ, D_MODEL), 1.0),
        "c": nrm(ks[1], (BATCH, D_MODEL), 1.0),
        "w_ada": nrm(ks[2], (DEPTH, D_MODEL, 6 * D_MODEL), 0.5 * D_MODEL ** -0.5),
        "b_ada": nrm(ks[3], (DEPTH, 6 * D_MODEL), 0.01),
        "norm1": 1.0 + nrm(ks[4], (DEPTH, D_MODEL), 0.01),
        "w_in": nrm(ks[5], (DEPTH, D_MODEL, D_IN), D_MODEL ** -0.5),
        "conv_qkv": nrm(ks[6], (DEPTH, SHORT_CONV, 3 * D_GDN), SHORT_CONV ** -0.5),
        "a_log": jnp.log(jax.random.uniform(ks[7], (DEPTH, N_HEADS_GDN), f32, 1.0, 16.0)),
        "dt_bias": dt + jnp.log(-jnp.expm1(-dt)),
        "gdn_norm": 1.0 + nrm(ks[9], (DEPTH, HEAD_DIM), 0.01),
        "sb_q_norm": 1.0 + nrm(ks[10], (DEPTH, HEAD_DIM), 0.01),
        "sb_k_norm": 1.0 + nrm(ks[11], (DEPTH, HEAD_DIM), 0.01),
        "w_out": nrm(ks[12], (DEPTH, D_MIX, D_MODEL), D_MIX ** -0.5),
        "norm2": 1.0 + nrm(ks[13], (DEPTH, D_MODEL), 0.01),
        "w_up": nrm(ks[14], (DEPTH, D_MODEL, 2 * D_FF), D_MODEL ** -0.5),
        "conv_ffn": nrm(ks[15], (DEPTH, FFN_CONV, D_FF), FFN_CONV ** -0.5),
        "w_down": nrm(ks[16], (DEPTH, D_FF, D_MODEL), D_FF ** -0.5),
    }


def reference(x, c, w_ada, b_ada, norm1, w_in, conv_qkv, a_log, dt_bias, gdn_norm,
              sb_q_norm, sb_k_norm, w_out, norm2, w_up, conv_ffn, w_down):
    c_act = jax.nn.silu(c)
    for l in range(DEPTH):
        mod = c_act @ w_ada[l] + b_ada[l]
        x = hybrid_layer(x, mod, norm1[l], w_in[l], conv_qkv[l], a_log[l], dt_bias[l],
                         gdn_norm[l], sb_q_norm[l], sb_k_norm[l], w_out[l], norm2[l],
                         w_up[l], conv_ffn[l], w_down[l])
    return x
```

```cpp
#define REP_S1 2
#include <hip/hip_runtime.h>
#include <hip/hip_cooperative_groups.h>
#include <cstdio>
#include <cstdint>
namespace cg = cooperative_groups;

#define LAS __attribute__((address_space(3)))
#define GAS __attribute__((address_space(1)))
typedef unsigned short bf16_t;
typedef short bf16x8 __attribute__((ext_vector_type(8)));
typedef short s16x4 __attribute__((ext_vector_type(4)));
typedef float f32x4 __attribute__((ext_vector_type(4)));
typedef float f32x2 __attribute__((ext_vector_type(2)));
typedef unsigned u32x4 __attribute__((ext_vector_type(4)));
typedef unsigned u32x2 __attribute__((ext_vector_type(2)));

constexpr int T_ = 16384, D_ = 2048, DIN = 7184, NIN = 7424, DFF = 5632, NUP = 11264, NH = 8;
constexpr int PQ_A = 0, PK_A = 1024, PV_A = 2048, PZ_A = 3072, PQ_B = 4096, PK_B = 5120, PV_B = 6144, PBETA = 7168, PALPHA = 7176;
constexpr int KS_MOD = 16;
constexpr float EPS_ = 1e-6f;
constexpr size_t MiB = 1024ull * 1024ull;
constexpr size_t WS_MODF = 0;
constexpr size_t WS_MODP = 131072;
constexpr size_t WS_EGL = 1835008;
constexpr size_t WS_PROG = 1900544;
constexpr size_t WS_BAR = 1904640;
constexpr size_t WS_W = 2 * MiB;
constexpr size_t W_IN_OFF = 0, W_OUT_OFF = 29 * MiB, W_UP_OFF = 37 * MiB, W_DN_OFF = 81 * MiB, W_LAYER = 103 * MiB;
constexpr size_t WS_H = 208 * MiB;
constexpr size_t WS_PROJ = 272 * MiB;
constexpr size_t WS_G = 272 * MiB, WS_V = 448 * MiB;
constexpr size_t WS_OCAT = 504 * MiB;
constexpr size_t WS_GDN = 568 * MiB;
constexpr size_t WS_END = 712 * MiB;
constexpr int LDS_BYTES = 131072 + 256;

struct Params {
    const float *x, *c, *w_ada, *b_ada, *norm1, *w_in, *conv_qkv, *a_log, *dt_bias, *gdn_norm, *sbq, *sbk, *w_out, *norm2, *w_up, *conv_ffn, *w_down;
    GAS float* out; GAS unsigned char* ws; int ph_lo, ph_hi;
};

typedef __bf16 bf16v2 __attribute__((ext_vector_type(2)));
__device__ __forceinline__ unsigned pk2(float lo, float hi) { const f32x2 v = {lo, hi}; union { bf16v2 b; unsigned u; } x; x.b = __builtin_convertvector(v, bf16v2); return x.u; }
__device__ __forceinline__ float bf2f(bf16_t b) { return __uint_as_float(((unsigned)b) << 16); }
__device__ __forceinline__ float bflo(unsigned w) { return __uint_as_float(w << 16); }
__device__ __forceinline__ float bfhi(unsigned w) { return __uint_as_float(w & 0xffff0000u); }
__device__ __forceinline__ void unpack8(const u32x4 v, float* f) { f[0] = bflo(v.x); f[1] = bfhi(v.x); f[2] = bflo(v.y); f[3] = bfhi(v.y); f[4] = bflo(v.z); f[5] = bfhi(v.z); f[6] = bflo(v.w); f[7] = bfhi(v.w); }
__device__ __forceinline__ u32x4 pack8(const float* f) { u32x4 o; o.x = pk2(f[0], f[1]); o.y = pk2(f[2], f[3]); o.z = pk2(f[4], f[5]); o.w = pk2(f[6], f[7]); return o; }
__device__ __forceinline__ float silu_f(float y) { return y * __builtin_amdgcn_rcpf(1.0f + __expf(-y)); }
__device__ __forceinline__ float softplus_f(float z) { return fmaxf(z, 0.f) + log1pf(__expf(-fabsf(z))); }
__device__ __forceinline__ float softplus_fast(float z) { return fmaxf(z, 0.f) + __logf(1.0f + __expf(-fabsf(z))); }
__device__ __forceinline__ float wave_sum(float v) {
#pragma unroll
    for (int o = 1; o < 64; o <<= 1) v += __shfl_xor(v, o);
    return v;
}
__device__ __forceinline__ bf16x8 as_bf8(u32x4 v) { union { u32x4 u; bf16x8 b; } x; x.u = v; return x.b; }
#define MFMA16(a, b, c) __builtin_amdgcn_mfma_f32_16x16x32_bf16((a), (b), (c), 0, 0, 0)
#define LDS_WAIT() asm volatile("s_waitcnt lgkmcnt(0)" ::: "memory")
__device__ __forceinline__ int lane_id_hw() { return (int)__builtin_amdgcn_mbcnt_hi(~0u, __builtin_amdgcn_mbcnt_lo(~0u, 0u)); }
__device__ __forceinline__ int opaque_bid() { int b = (int)blockIdx.x; asm volatile("" : "+s"(b)); return b; }


#define XB_TMO      128
#define XB_XCNT(j)  (256  + 64 * (j))
#define XB_XSUB(j)  (1280 + 64 * (j))
#define XB_XGEN(j)  (2304 + 64 * (j))
#define XB_TOP      3328
#define XB_TOPGEN   3392
#define XCD_BAR_WORDS 3456
#define XB_SPIN_CAP (1u << 18)
__device__ __forceinline__ unsigned xb_ld(unsigned* p)              { return __hip_atomic_load(p, __ATOMIC_RELAXED, __HIP_MEMORY_SCOPE_AGENT); }
__device__ __forceinline__ unsigned xb_add(unsigned* p, unsigned v) { return __hip_atomic_fetch_add(p, v, __ATOMIC_RELAXED, __HIP_MEMORY_SCOPE_AGENT); }
__device__ __forceinline__ unsigned xb_xcc_id() { return (unsigned)__builtin_amdgcn_s_getreg((3 << 11) | 20) & 0xFu; }
#define XB_SPIN(cond, bar) do { unsigned _sp = 0; while (cond) { __builtin_amdgcn_s_sleep(1); \
    if ((++_sp & 255u) == 0u) { if (xb_ld(&(bar)[XB_TMO])) break; if (_sp > XB_SPIN_CAP) { atomicAdd(&(bar)[XB_TMO], 1u); break; } } } } while (0)
struct XcdBarrier { unsigned* bar; unsigned x; volatile LAS unsigned* st; };
__device__ __forceinline__ XcdBarrier xcd_barrier_post(unsigned* bar, volatile LAS unsigned* st) {
    XcdBarrier b; b.bar = bar; b.x = xb_xcc_id(); b.st = st;
    if (threadIdx.x == 0) (void)xb_add(&bar[XB_XCNT(b.x)], 1u);
    return b;
}
__device__ __forceinline__ void xcd_barrier_complete(unsigned* bar, unsigned x, unsigned& nloc, unsigned& nx) {
    const unsigned G = gridDim.x * gridDim.y * gridDim.z;
    unsigned sum, cnt, mine, sp = 0u;
    for (;;) {
        sum = 0u; cnt = 0u; mine = 0u;
#pragma unroll
        for (unsigned j = 0; j < 16; ++j) { const unsigned c = xb_ld(&bar[XB_XCNT(j)]); sum += c; cnt += (c > 0u) ? 1u : 0u; mine = (j == x) ? c : mine; }
        if (sum == G) break;
        __builtin_amdgcn_s_sleep(1);
        if ((++sp & 255u) == 0u) { if (xb_ld(&bar[XB_TMO])) break; if (sp > XB_SPIN_CAP) { atomicAdd(&bar[XB_TMO], 1u); break; } }
    }
    nloc = mine > 0u ? mine : 1u; nx = cnt > 0u ? cnt : 1u;
}
__device__ __forceinline__ void xcd_barrier(unsigned* bar, volatile LAS unsigned* st, const bool is_t0) {
    asm volatile("s_waitcnt vmcnt(0)" ::: "memory");
    __syncthreads();
    if (is_t0) {
        const unsigned x = xb_xcc_id();
        __builtin_amdgcn_s_waitcnt(0);
        unsigned nloc = st[0], nx = st[1];
        if (nloc == 0u) { xcd_barrier_complete(bar, x, nloc, nx); st[0] = nloc; st[1] = nx; }
        const unsigned old = xb_add(&bar[XB_XSUB(x)], 1u);
        const unsigned gen = old / nloc;
        if (old + 1u == (gen + 1u) * nloc) {
            __builtin_amdgcn_fence(__ATOMIC_RELEASE, "agent");
            asm volatile("s_waitcnt vmcnt(0)" ::: "memory");
            const unsigned og = xb_add(&bar[XB_TOP], 1u);
            const unsigned tg = og / nx;
            if (og + 1u == (tg + 1u) * nx) xb_add(&bar[XB_TOPGEN], 1u);
            else XB_SPIN(xb_ld(&bar[XB_TOPGEN]) == tg, bar);
            __builtin_amdgcn_fence(__ATOMIC_ACQUIRE, "agent");
            xb_add(&bar[XB_XGEN(x)], 1u);
            asm volatile("s_waitcnt vmcnt(0)" ::: "memory");
        } else {
            XB_SPIN(xb_ld(&bar[XB_XGEN(x)]) == gen, bar);
            __builtin_amdgcn_fence(__ATOMIC_ACQUIRE, "agent");
            asm volatile("s_waitcnt vmcnt(0)" ::: "memory");
        }
    }
    __syncthreads();
}

namespace pg8 {
constexpr int BM = 256, BK = 64, HALF = 128, HTB = HALF * BK * 2, STAGE_BYTES = 8 * HTB, NXCD = 8, WGM = 8;
__host__ __device__ __forceinline__ int lds_byte(int r, int c) { const int st = (r >> 4) * 2 + (c >> 5), rr = r & 15, cc = c & 31, ob = rr * 64 + cc * 2; return st * 1024 + (ob ^ (((ob >> 9) & 1) << 5)); }
__host__ __device__ __forceinline__ void stage_rc(int b, int& R, int& C) { const int st = b / 1024, sb = b % 1024, swz = sb ^ (((sb >> 9) & 1) << 5); R = (st >> 1) * 16 + swz / 64; C = (st & 1) * 32 + (swz % 64) / 2; }
__host__ __device__ __forceinline__ int perm32(int rho) { const int n = rho >> 4, i = rho & 15; return 8 * (i >> 2) + 4 * n + (i & 3); }
struct Unit { int pm, pn; };
struct Gemm { const bf16_t* A; const bf16_t* Bt; int M, N, K; };
struct StaticOrder {
    int nM, nN, nwg, G, c;
    __device__ __forceinline__ void init(int M, int N, int G_, int c_) { nM = M / BM; nN = N / BM; nwg = nM * nN; G = G_; c = c_; }
    __device__ __forceinline__ bool next(int i, Unit& u) const {
        const long L = (long)i * G + c; if (L >= nwg) return false;
        int wgid = (int)L; { const int q = nwg / NXCD, r = nwg % NXCD, xcd = wgid % NXCD, off = wgid / NXCD; wgid = (xcd < r ? xcd * (q + 1) : r * (q + 1) + (xcd - r) * q) + off; }
        const int nig = WGM * nN, gid = wgid / nig, fm = gid * WGM, gsz = (nM - fm) < WGM ? (nM - fm) : WGM;
        u.pm = fm + ((wgid % nig) % gsz); u.pn = (wgid % nig) / gsz; return true;
    }
};
struct EpiBf16 {
    static constexpr bool PERM = true;
    bf16_t* O; int ldc; int split_cols; size_t split_stride;
    __device__ __forceinline__ void operator()(const f32x4 (&acc)[2][2][4][2], const Unit& u, int wr, int wc, int fr, int fq) const {
        const int row0 = u.pm * BM + wr * 64 + fr; int colt = u.pn * BM; bf16_t* base = O;
        if (split_cols) { const int t = colt / split_cols; base += (size_t)t * split_stride; colt -= t * split_cols; }
        const int col0 = colt + wc * 32 + 8 * fq;
#pragma unroll
        for (int ai = 0; ai < 2; ++ai)
#pragma unroll
            for (int m = 0; m < 4; ++m) { bf16_t* rowp = base + (size_t)(row0 + ai * HALF + m * 16) * ldc + col0;
#pragma unroll
                for (int bj = 0; bj < 2; ++bj) { const f32x4 v0 = acc[ai][bj][m][0], v1 = acc[ai][bj][m][1];
                    u32x4 w; w.x = pk2(v0[0], v0[1]); w.y = pk2(v0[2], v0[3]); w.z = pk2(v1[0], v1[1]); w.w = pk2(v1[2], v1[3]);
                    *(u32x4*)(rowp + bj * HALF) = w; } }
    }
};
struct EpiRes {
    static constexpr bool PERM = false;
    const float* xin; float* out; int ldc; const float* gate;
    __device__ __forceinline__ void operator()(const f32x4 (&acc)[2][2][4][2], const Unit& u, int wr, int wc, int fr, int fq) const {
        const int row0 = u.pm * BM + wr * 64 + fr, col0 = u.pn * BM + wc * 32 + 4 * fq;
        f32x4 gv[2][2];
#pragma unroll
        for (int bj = 0; bj < 2; ++bj)
#pragma unroll
            for (int n = 0; n < 2; ++n) gv[bj][n] = *(const f32x4*)(gate + col0 + bj * HALF + n * 16);
#pragma unroll
        for (int ai = 0; ai < 2; ++ai)
#pragma unroll
            for (int m = 0; m < 4; ++m) { const size_t off = (size_t)(row0 + ai * HALF + m * 16) * ldc + col0;
#pragma unroll
                for (int bj = 0; bj < 2; ++bj)
#pragma unroll
                    for (int n = 0; n < 2; ++n) { const f32x4 xv = *(const f32x4*)(xin + off + bj * HALF + n * 16);
                        *(f32x4*)(out + off + bj * HALF + n * 16) = xv + gv[bj][n] * acc[ai][bj][m][n]; }
                asm volatile("" ::: "memory"); }
    }
};

struct EpiAct {
    static constexpr bool PERM = true;
    bf16_t* V; bf16_t* Gh; bf16_t* Gt; bf16_t* Vh; const float* cw;
    __device__ __forceinline__ void operator()(const f32x4 (&acc)[2][2][4][2], const Unit& u, int wr, int wc, int fr, int fq) const {
        const int lane = fr + 16 * fq, ff0 = u.pn * HALF + wc * 32 + 8 * fq;
        float w0[8], w1[8], w2[8];
#pragma unroll
        for (int e = 0; e < 8; ++e) { w0[e] = cw[ff0 + e]; w1[e] = cw[DFF + ff0 + e]; w2[e] = cw[2 * DFF + ff0 + e]; }
        const int src1 = (fr >= 1) ? lane - 1 : lane + 15, src2 = (fr >= 2) ? lane - 2 : lane + 14;
#pragma unroll
        for (int ai = 0; ai < 2; ++ai) { const int strip = 4 * u.pm + 2 * ai + wr; const size_t row_base = (size_t)u.pm * BM + ai * HALF + wr * 64;
#pragma unroll
            for (int m = 0; m < 4; ++m) { float o[8], gr[8];
#pragma unroll
                for (int n = 0; n < 2; ++n)
#pragma unroll
                    for (int j = 0; j < 4; ++j) { const int e = 4 * n + j; const float g0 = acc[ai][0][m][n][j], v = acc[ai][1][m][n][j], gp = (m > 0) ? acc[ai][0][m > 0 ? m - 1 : 0][n][j] : 0.f;
                        const float s1_ = (fr == 15) ? gp : g0, s2_ = (fr >= 14) ? gp : g0;
                        const float g1 = __int_as_float(__builtin_amdgcn_update_dpp(0, __float_as_int(s1_), 0x121, 0xf, 0xf, false)), g2 = __int_as_float(__builtin_amdgcn_update_dpp(0, __float_as_int(s2_), 0x122, 0xf, 0xf, false));
                        const float y = w0[e] * g2 + w1[e] * g1 + w2[e] * g0; const float a = y * __builtin_amdgcn_rcpf(1.0f + __expf(-y)) * v;
                        o[e] = (m == 0 && fr < 2) ? v : a; gr[e] = g0; }
                { u32x4 w; w.x = pk2(o[0], o[1]); w.y = pk2(o[2], o[3]); w.z = pk2(o[4], o[5]); w.w = pk2(o[6], o[7]);
                  *(u32x4*)(V + (row_base + 16 * m + fr) * DFF + ff0) = w;
                  if (m == 0 && fr < 2) *(u32x4*)(Vh + (size_t)(strip * 2 + fr) * DFF + ff0) = w; }
                if (m == 0 && fr < 2) { u32x4 w; w.x = pk2(gr[0], gr[1]); w.y = pk2(gr[2], gr[3]); w.z = pk2(gr[4], gr[5]); w.w = pk2(gr[6], gr[7]); *(u32x4*)(Gh + (size_t)(strip * 2 + fr) * DFF + ff0) = w; }
                if (m == 3 && fr >= 14) { u32x4 w; w.x = pk2(gr[0], gr[1]); w.y = pk2(gr[2], gr[3]); w.z = pk2(gr[4], gr[5]); w.w = pk2(gr[6], gr[7]); *(u32x4*)(Gt + (size_t)(strip * 2 + fr - 14) * DFF + ff0) = w; } } }
    }
};

template <class Epi>
__device__ __forceinline__ void gemm_phase(LAS unsigned char* lds, const Gemm g, const StaticOrder& S, const Epi& E, const int tid_in) {
    const int tid = tid_in, wid = __builtin_amdgcn_readfirstlane(tid >> 6), lane = tid & 63, wr = wid >> 2, wc = wid & 3, fr = lane & 15, fq = lane >> 4;
    const int K = g.K, nt = K / BK;
    unsigned voffA[2], voffB[2];
#pragma unroll
    for (int i = 0; i < 2; ++i) { int R, C; stage_rc(tid * 16 + i * 8192, R, C); const int Rb = Epi::PERM ? ((R & ~31) + perm32(R & 31)) : R;
        voffA[i] = (unsigned)(R * K + C) * 2u; voffB[i] = (unsigned)(Rb * K + C) * 2u; }
    const size_t kstep = (size_t)(BK * 2);
    const size_t hstep = (size_t)HALF * K * 2;
    const size_t tstep = 2 * hstep;
    const unsigned ldsw = (unsigned)wid * 1024u;
    const int aoff = lds_byte(wr * 64 + fr, fq * 8), boff = lds_byte(wc * 32 + fr, fq * 8);
#define PG8_SA(b, h) (((b) * 2 + (h)) * HTB)
#define PG8_SB(b, h) ((4 + (b) * 2 + (h)) * HTB)
#define PG8_STAGE(bufoff, gbase, voff) do { _Pragma("unroll") for (int _i = 0; _i < 2; ++_i) \
        __builtin_amdgcn_global_load_lds((const unsigned*)((const char*)(gbase) + (voff)[_i]), (LAS unsigned*)(lds + (bufoff) + ldsw + _i * 8192), 16, 0, 0); } while (0)
#define PG8_LDA(dst, b, h) do { _Pragma("unroll") for (int m = 0; m < 4; ++m) _Pragma("unroll") for (int k = 0; k < 2; ++k) dst[m][k] = *(const LAS bf16x8*)(lds + PG8_SA(b, h) + aoff + m * 2048 + k * 1024); } while (0)
#define PG8_LDB(dst, b, h) do { _Pragma("unroll") for (int n = 0; n < 2; ++n) _Pragma("unroll") for (int k = 0; k < 2; ++k) dst[n][k] = *(const LAS bf16x8*)(lds + PG8_SB(b, h) + boff + n * 2048 + k * 1024); } while (0)
#define PG8_MMA(ai, bj, At, Bt) do { __builtin_amdgcn_s_setprio(1); _Pragma("unroll") for (int m = 0; m < 4; ++m) _Pragma("unroll") for (int n = 0; n < 2; ++n) _Pragma("unroll") for (int k = 0; k < 2; ++k) \
        acc[ai][bj][m][n] = __builtin_amdgcn_mfma_f32_16x16x32_bf16(Bt[n][k], At[m][k], acc[ai][bj][m][n], 0, 0, 0); __builtin_amdgcn_s_setprio(0); } while (0)
#define PG8_WAIT_V(n) asm volatile("s_waitcnt vmcnt(" #n ")" ::: "memory")
#define PG8_WAIT_L(n) asm volatile("s_waitcnt lgkmcnt(" #n ")" ::: "memory")
#define PG8_BAR __builtin_amdgcn_s_barrier()
#define PG8_SCHED __builtin_amdgcn_sched_barrier(0)
    Unit cur, nxt; int ui = 0;
    if (!S.next(0, cur)) return;
    f32x4 acc[2][2][4][2];
#pragma unroll
    for (int a = 0; a < 2; ++a)
#pragma unroll
        for (int b = 0; b < 2; ++b)
#pragma unroll
            for (int m = 0; m < 4; ++m)
#pragma unroll
                for (int n = 0; n < 2; ++n) acc[a][b][m][n] = (f32x4){0.f, 0.f, 0.f, 0.f};
    bf16x8 At[4][2], B0[2][2], B1[2][2];
    const char* cA = (const char*)g.A + (size_t)cur.pm * tstep; const char* cB = (const char*)g.Bt + (size_t)cur.pn * tstep;
    PG8_STAGE(PG8_SB(0, 0), cB, voffB); PG8_STAGE(PG8_SB(0, 1), cB + hstep, voffB); PG8_STAGE(PG8_SA(0, 0), cA, voffA); PG8_STAGE(PG8_SA(0, 1), cA + hstep, voffA);
    if (wr == 1) PG8_BAR;
    PG8_WAIT_V(2); PG8_BAR;
    PG8_STAGE(PG8_SB(1, 0), cB + kstep, voffB); PG8_STAGE(PG8_SA(1, 0), cA + kstep, voffA); PG8_STAGE(PG8_SB(1, 1), cB + hstep + kstep, voffB);
    PG8_WAIT_V(6); PG8_BAR;
    for (;;) {
        const bool has_next = S.next(ui + 1, nxt);
        const char* nA = has_next ? (const char*)g.A + (size_t)nxt.pm * tstep : cA; const char* nB = has_next ? (const char*)g.Bt + (size_t)nxt.pn * tstep : cB;
        for (int t = 0; t < nt; t += 2) {
            const bool last = (t == nt - 2);
            const char* a1 = cA + (size_t)(t + 1) * kstep;
            const char* a2 = last ? nA : cA + (size_t)(t + 2) * kstep; const char* b2 = last ? nB : cB + (size_t)(t + 2) * kstep;
            const char* a3 = a2 + kstep; const char* b3 = b2 + kstep;
            PG8_LDB(B0, 0, 0); PG8_LDB(B1, 0, 1); PG8_SCHED; PG8_LDA(At, 0, 0); PG8_STAGE(PG8_SA(1, 1), a1 + hstep, voffA);
            PG8_WAIT_V(8); PG8_WAIT_L(0); PG8_BAR; PG8_MMA(0, 0, At, B0); PG8_MMA(0, 1, At, B1); PG8_BAR; PG8_SCHED;
            PG8_LDA(At, 0, 1); PG8_STAGE(PG8_SB(0, 0), b2, voffB); PG8_STAGE(PG8_SB(0, 1), b2 + hstep, voffB); PG8_STAGE(PG8_SA(0, 0), a2, voffA);
            PG8_WAIT_V(8); PG8_WAIT_L(0); PG8_BAR; PG8_MMA(1, 0, At, B0); PG8_MMA(1, 1, At, B1); PG8_BAR; PG8_SCHED;
            PG8_LDB(B0, 1, 0); PG8_LDB(B1, 1, 1); PG8_SCHED; PG8_LDA(At, 1, 0); PG8_STAGE(PG8_SA(0, 1), a2 + hstep, voffA);
            PG8_WAIT_V(8); PG8_WAIT_L(0); PG8_BAR; PG8_MMA(0, 0, At, B0); PG8_MMA(0, 1, At, B1); PG8_BAR; PG8_SCHED;
            PG8_LDA(At, 1, 1); PG8_STAGE(PG8_SB(1, 0), b3, voffB); PG8_STAGE(PG8_SB(1, 1), b3 + hstep, voffB); PG8_STAGE(PG8_SA(1, 0), a3, voffA);
            PG8_WAIT_V(8); PG8_WAIT_L(0); PG8_BAR; PG8_MMA(1, 0, At, B0); PG8_MMA(1, 1, At, B1); PG8_BAR; PG8_SCHED;
        }
        if (wr == 0) PG8_BAR;
        E(acc, cur, wr, wc, fr, fq);
        if (!has_next) break;
#pragma unroll
        for (int a = 0; a < 2; ++a)
#pragma unroll
            for (int b = 0; b < 2; ++b)
#pragma unroll
                for (int m = 0; m < 4; ++m)
#pragma unroll
                    for (int n = 0; n < 2; ++n) acc[a][b][m][n] = (f32x4){0.f, 0.f, 0.f, 0.f};
        cur = nxt; cA = nA; cB = nB; ++ui;
        if (wr == 1) PG8_BAR;
    }
    PG8_WAIT_V(0);
    PG8_BAR;
#undef PG8_SA
#undef PG8_SB
#undef PG8_STAGE
#undef PG8_LDA
#undef PG8_LDB
#undef PG8_MMA
#undef PG8_WAIT_V
#undef PG8_WAIT_L
#undef PG8_BAR
#undef PG8_SCHED
}
}

__device__ __forceinline__ void transpose_item(const float* W, int K, int Nsrc, bf16_t* WT, int k0, int ndst0, int nsrc0, int nvalid, LAS float* scr, int lane) {
    float vv[32];
#pragma unroll
    for (int i = 0; i < 32; ++i) { const int kk = 2 * i + (lane >> 5), nn = lane & 31;
        vv[i] = (nn < nvalid) ? W[(size_t)(k0 + kk) * Nsrc + nsrc0 + nn] : 0.f; }
#pragma unroll
    for (int i = 0; i < 32; ++i) { const int kk = 2 * i + (lane >> 5), nn = lane & 31; scr[kk * 33 + nn] = vv[i]; }
    LDS_WAIT();
    const int c = lane & 7;
#pragma unroll
    for (int j = 0; j < 4; ++j) { const int n = (lane >> 3) + 8 * j; const LAS float* s = scr + (8 * c) * 33 + n;
        u32x4 o; o.x = pk2(s[0 * 33], s[1 * 33]); o.y = pk2(s[2 * 33], s[3 * 33]); o.z = pk2(s[4 * 33], s[5 * 33]); o.w = pk2(s[6 * 33], s[7 * 33]);
        *(u32x4*)(WT + (size_t)(ndst0 + n) * K + k0 + 8 * c) = o; }
    LDS_WAIT();
}
__device__ __forceinline__ void weight_transposes(const Params& p, LAS unsigned char* lds, const int tid_in, const int l, const int mask, const int gwv, const int NGW);
__device__ __forceinline__ void p0_phase(const Params& p, LAS unsigned char* lds, const int tid_in) {
    const int tid = tid_in, lane = tid & 63, wave = tid >> 6;
    LAS float* sc = (LAS float*)(lds + 8 * 8448);
    for (int k = tid; k < D_; k += 512) sc[k] = silu_f(p.c[k]);
    __syncthreads();
    { const int gw = wave * 256 + (int)blockIdx.x;
      if (gw < 1536) { const int g = gw * 64 + lane; const int l = g / 49152, rem = g % 49152, ks = rem / 3072, c4 = rem % 3072;
          const float* wp = p.w_ada + ((size_t)l * D_ + (size_t)ks * 128) * 12288 + 4 * c4;
          f32x4 a0 = {0.f, 0.f, 0.f, 0.f}, a1 = a0;
#pragma unroll 4
          for (int k = 0; k < 128; k += 2) { const f32x4 w0 = *(const f32x4*)(wp + (size_t)k * 12288), w1 = *(const f32x4*)(wp + (size_t)(k + 1) * 12288);
              a0 += w0 * sc[ks * 128 + k]; a1 += w1 * sc[ks * 128 + k + 1]; }
          *(f32x4*)((float*)(p.ws + WS_MODP) + ((size_t)(ks * 2 + l) * 12288 + 4 * c4)) = a0 + a1; } }
    weight_transposes(p, lds, tid_in, 0, 1, (int)blockIdx.x * 8 + wave, (int)gridDim.x * 8);
}
__device__ __forceinline__ void weight_transposes(const Params& p, LAS unsigned char* lds, const int tid_in, const int l, const int mask, const int gwv, const int NGW) {
    const int lane = tid_in & 63, wave = tid_in >> 6;
    LAS float* scr = (LAS float*)(lds + wave * 8448);
    constexpr int I_IN = 32 * 232, I_OUT = 32 * 64, I_UP = 32 * 352, I_DN = 88 * 64;
    const int n_in = (mask & 1) ? I_IN : 0, n_out = (mask & 2) ? I_OUT : 0, n_up = (mask & 4) ? I_UP : 0, n_dn = (mask & 8) ? I_DN : 0;
    GAS unsigned char* wl = p.ws + WS_W + (size_t)l * W_LAYER;
    for (int it = gwv; it < n_in + n_out + n_up + n_dn; it += NGW) {
        int r = it;
        if (r < n_in) { const int kb = r / 232, nb = r % 232, nd = 32 * nb; int ns, nv;
            if (nd < 4096) { ns = nd; nv = 32; } else if (nd < 7168) { ns = nd + 16; nv = 32; } else if (nd == 7168) { ns = 4096; nv = 16; } else { ns = 0; nv = 0; }
            transpose_item(p.w_in + (size_t)l * D_ * DIN, D_, DIN, (bf16_t*)(wl + W_IN_OFF), 64 * kb, nd, ns, nv, scr, lane); continue; }
        r -= n_in;
        if (r < n_out) { const int kb = r / 64, nb = r % 64; transpose_item(p.w_out + (size_t)l * D_ * D_, D_, D_, (bf16_t*)(wl + W_OUT_OFF), 64 * kb, 32 * nb, 32 * nb, 32, scr, lane); continue; }
        r -= n_out;
        if (r < n_up) { const int kb = r / 352, nb = r % 352, nd = 32 * nb, pn = nd >> 8, x0 = nd & 255;
            transpose_item(p.w_up + (size_t)l * D_ * NUP, D_, NUP, (bf16_t*)(wl + W_UP_OFF), 64 * kb, nd, (x0 < 128) ? 128 * pn + x0 : DFF + 128 * pn + (x0 - 128), 32, scr, lane); continue; }
        r -= n_up;
        { const int kb = r / 64, nb = r % 64; transpose_item(p.w_down + (size_t)l * DFF * D_, DFF, D_, (bf16_t*)(wl + W_DN_OFF), 64 * kb, 32 * nb, 32 * nb, 32, scr, lane); }
    }
}

__device__ __forceinline__ float mod_from_partials(const Params& p, int l, int j) {
    const float* mp = (const float*)(p.ws + WS_MODP);
    float v = p.b_ada[l * 12288 + j];
#pragma unroll
    for (int ks = 0; ks < KS_MOD; ++ks) v += mp[(size_t)(ks * 2 + l) * 12288 + j];
    return v;
}
__device__ __forceinline__ void norm_phase(const Params& p, LAS unsigned char* lds, const float* xin, const float* normw, int l, int off_shift, int off_scale, bool from_partials, const int tid_in) {
    const int tid = tid_in, lane = tid & 63, wave = tid >> 6;
    LAS float* cA = (LAS float*)lds; LAS float* cB = cA + D_;
    float* modf = (float*)(p.ws + WS_MODF);
    if (from_partials) {
        for (int idx = (int)blockIdx.x * 512 + tid; idx < 2 * 12288; idx += (int)gridDim.x * 512) modf[idx] = mod_from_partials(p, idx / 12288, idx % 12288);
        for (int j = tid; j < D_; j += 512) { const float sh = mod_from_partials(p, l, off_shift + j), scv = mod_from_partials(p, l, off_scale + j);
            cA[j] = normw[j] * (1.f + scv); cB[j] = sh; }
    } else {
        for (int j = tid; j < D_; j += 512) { cA[j] = normw[j] * (1.f + modf[l * 12288 + off_scale + j]); cB[j] = modf[l * 12288 + off_shift + j]; }
    }
    __syncthreads();
    f32x4 a[8], b[8];
#pragma unroll
    for (int j = 0; j < 8; ++j) { a[j] = *(const LAS f32x4*)(cA + 4 * lane + 256 * j); b[j] = *(const LAS f32x4*)(cB + 4 * lane + 256 * j); }
    bf16_t* H = (bf16_t*)(p.ws + WS_H);
    const int m0 = (int)blockIdx.x * 8 + wave, mstep = (int)gridDim.x * 8;
    f32x4 v[8], vn[8];
    if (m0 < T_) { const f32x4* xr = (const f32x4*)(xin + (size_t)m0 * D_) + lane;
#pragma unroll
        for (int j = 0; j < 8; ++j) v[j] = xr[64 * j]; }
    for (int m = m0; m < T_; m += mstep) {
        const int mn = m + mstep;
        if (mn < T_) { const f32x4* xr = (const f32x4*)(xin + (size_t)mn * D_) + lane;
#pragma unroll
            for (int j = 0; j < 8; ++j) vn[j] = xr[64 * j]; }
        float s = 0.f;
#pragma unroll
        for (int j = 0; j < 8; ++j) s += (v[j].x * v[j].x + v[j].y * v[j].y) + (v[j].z * v[j].z + v[j].w * v[j].w);
        const float rstd = rsqrtf(wave_sum(s) * (1.f / D_) + EPS_);
        u32x2* o8 = (u32x2*)(H + (size_t)m * D_) + lane;
#pragma unroll
        for (int j = 0; j < 8; ++j) { const f32x4 y = v[j] * rstd * a[j] + b[j]; u32x2 w; w.x = pk2(y.x, y.y); w.y = pk2(y.z, y.w); o8[64 * j] = w; }
#pragma unroll
        for (int j = 0; j < 8; ++j) v[j] = vn[j];
    }
}


__device__ __forceinline__ void win_small_cols(const Params& p, LAS unsigned char* lds, int l, const int tid_in) {
    const int lane = tid_in & 63, wave = tid_in >> 6, r16 = lane & 15, q4 = lane >> 4;
    const int tw = wave & 3, kh = wave >> 2;
    const int m0 = ((int)blockIdx.x * 4 + tw) * 16;
    const bf16_t* H = (const bf16_t*)(p.ws + WS_H) + (size_t)(m0 + r16) * D_ + 8 * q4 + 1024 * kh;
    const bf16_t* Wt = (const bf16_t*)(p.ws + WS_W + (size_t)l * W_LAYER + W_IN_OFF) + (size_t)(7168 + r16) * D_ + 8 * q4 + 1024 * kh;
    f32x4 acc0 = {0.f, 0.f, 0.f, 0.f}, acc1 = acc0;
#pragma unroll 8
    for (int s = 0; s < 32; s += 2) {
        const bf16x8 a0 = *(const bf16x8*)(H + 32 * s), b0 = *(const bf16x8*)(Wt + 32 * s), a1 = *(const bf16x8*)(H + 32 * s + 32), b1 = *(const bf16x8*)(Wt + 32 * s + 32);
        acc0 = MFMA16(a0, b0, acc0); acc1 = MFMA16(a1, b1, acc1); }
    acc0 += acc1;
    LAS f32x4* xch = (LAS f32x4*)lds;
    if (kh) xch[tw * 64 + lane] = acc0;
    __syncthreads();
    if (!kh) { acc0 += xch[tw * 64 + lane];
        bf16_t* proj = (bf16_t*)(p.ws + WS_PROJ);
#pragma unroll
        for (int rg = 0; rg < 4; ++rg) proj[(size_t)(m0 + 4 * q4 + rg) * NIN + 7168 + r16] = (bf16_t)(pk2(acc0[rg], 0.f) & 0xffffu); }
    __syncthreads();
}

__device__ __forceinline__ void gdn_prep_phase(const Params& p, LAS unsigned char* lds, int l, const int tid_in) {
    const int tid0 = tid_in, wave = __builtin_amdgcn_readfirstlane(tid0 >> 6);
    LAS float* Lslot = (LAS float*)lds;
    LAS bf16_t* Qn = (LAS bf16_t*)(lds + 65536); LAS bf16_t* Kn = (LAS bf16_t*)(lds + 82944); LAS bf16_t* KdTs = (LAS bf16_t*)(lds + 100352);
    LAS float* betaS = (LAS float*)(lds + 118784); LAS float* gcS = (LAS float*)(lds + 119808); LAS float* gS = (LAS float*)(lds + 120832);
    LAS bf16_t* VbT = (LAS bf16_t*)(lds + 65536); LAS bf16_t* KbgT = (LAS bf16_t*)(lds + 82944);
    const bf16_t* proj = (const bf16_t*)(p.ws + WS_PROJ);
    bf16_t* Wg = (bf16_t*)(p.ws + WS_GDN); bf16_t* UTg = (bf16_t*)(p.ws + WS_GDN + 32 * MiB); bf16_t* KdTg = (bf16_t*)(p.ws + WS_GDN + 64 * MiB);
    bf16_t* Qgg = (bf16_t*)(p.ws + WS_GDN + 96 * MiB); bf16_t* Ag = (bf16_t*)(p.ws + WS_GDN + 128 * MiB);
    float* egl = (float*)(p.ws + WS_EGL);
    const float* convw = p.conv_qkv + (size_t)l * 4 * 3072;
#pragma unroll 1
    for (int batch = 0; batch < 2; ++batch) {
        { int tid = tid0; asm volatile("" : "+v"(tid));
          const int kk = tid >> 6, row = tid & 63;
          if (tid < 256) { const int I = (int)blockIdx.x * 8 + batch * 4 + kk, h = I >> 8, c = I & 255; const size_t t = (size_t)64 * c + row;
              const float braw = bf2f(proj[t * NIN + PBETA + h]), araw = bf2f(proj[t * NIN + PALPHA + h]);
              betaS[kk * 64 + row] = 1.f / (1.f + __expf(-braw));
              float g = -__expf(p.a_log[l * NH + h]) * softplus_f(araw + p.dt_bias[l * NH + h]);
#pragma unroll
              for (int o = 1; o < 64; o <<= 1) { const float u = __shfl_up(g, o); if (row >= o) g += u; }
              gcS[kk * 64 + row] = g; if (row == 63) egl[I] = __expf(g); }
          __syncthreads(); }
        u32x4 raw[3][4][2];
#define PREP_LOADRAW(kq) do { const int I_ = (int)blockIdx.x * 8 + batch * 4 + (kq), h_ = I_ >> 8, c_ = I_ & 255; \
            _Pragma("unroll") for (int X = 0; X < 3; ++X) _Pragma("unroll") for (int r = 0; r < 4; ++r) { int tt_ = 64 * c_ + (tid0 >> 3) - 3 + r; tt_ = tt_ < 0 ? 0 : tt_; \
                const u32x4* pp_ = (const u32x4*)(proj + (size_t)tt_ * NIN + X * 1024 + h_ * 128 + 16 * (tid0 & 7)); raw[X][r][0] = pp_[0]; raw[X][r][1] = pp_[1]; } } while (0)
        PREP_LOADRAW(0);
#pragma unroll 1
        for (int k = 0; k < 4; ++k) {
            int tid = tid0; asm volatile("" : "+v"(tid));
            const int lane = tid & 63, r16 = lane & 15, q4 = lane >> 4, i = tid >> 3, sub = tid & 7;
            const int I = (int)blockIdx.x * 8 + batch * 4 + k, h = I >> 8, c = I & 255, t = 64 * c + i;
            const float gci = gcS[k * 64 + i], glast = gcS[k * 64 + 63];
#pragma unroll
            for (int X = 0; X < 3; ++X) {
                const int col = X * 1024 + h * 128 + 16 * sub;
                float y[16];
#pragma unroll
                for (int e = 0; e < 16; ++e) y[e] = 0.f;
#pragma unroll
                for (int r = 0; r < 4; ++r) { const int tt = t - 3 + r;
                    if (tt >= 0) { float xv[16]; unpack8(raw[X][r][0], xv); unpack8(raw[X][r][1], xv + 8);
                        const f32x4* wp = (const f32x4*)(convw + r * 3072 + col);
#pragma unroll
                        for (int e4 = 0; e4 < 4; ++e4) { const f32x4 w = wp[e4]; y[4 * e4] += w.x * xv[4 * e4]; y[4 * e4 + 1] += w.y * xv[4 * e4 + 1]; y[4 * e4 + 2] += w.z * xv[4 * e4 + 2]; y[4 * e4 + 3] += w.w * xv[4 * e4 + 3]; } } }
                float ss = 0.f;
#pragma unroll
                for (int e = 0; e < 16; ++e) { y[e] = silu_f(y[e]); ss += y[e] * y[e]; }
                if (X < 2) { ss += __shfl_xor(ss, 1); ss += __shfl_xor(ss, 2); ss += __shfl_xor(ss, 4);
                    const float scl = rsqrtf(ss + EPS_) * (X == 0 ? 0.08838834764831845f : 1.f);
#pragma unroll
                    for (int e = 0; e < 16; ++e) y[e] *= scl; }
                if (X == 0) { *(LAS u32x4*)(Qn + i * 136 + 16 * sub) = pack8(y); *(LAS u32x4*)(Qn + i * 136 + 16 * sub + 8) = pack8(y + 8);
                    const float eg = __expf(gci); float z[16];
#pragma unroll
                    for (int e = 0; e < 16; ++e) z[e] = y[e] * eg;
                    { const int c8a = 2 * sub, c8b = 2 * sub + 1;
                      *(u32x4*)(Qgg + (size_t)I * 8192 + ((((i >> 4) * 4 + (c8a >> 2)) * 64 + (c8a & 3) * 16 + (i & 15)) * 8)) = pack8(z);
                      *(u32x4*)(Qgg + (size_t)I * 8192 + ((((i >> 4) * 4 + (c8b >> 2)) * 64 + (c8b & 3) * 16 + (i & 15)) * 8)) = pack8(z + 8); }
                } else if (X == 1) { const u32x4 k0 = pack8(y), k1 = pack8(y + 8);
                    *(LAS u32x4*)(Kn + i * 136 + 16 * sub) = k0; *(LAS u32x4*)(Kn + i * 136 + 16 * sub + 8) = k1;
                    u32x4* dst = (u32x4*)(Wg + ((size_t)I * 64 + i) * 128 + 16 * sub); dst[0] = k0; dst[1] = k1;
                    const float ed = __expf(glast - gci);
#pragma unroll
                    for (int e = 0; e < 16; e += 2) { const unsigned w = pk2(y[e] * ed, y[e + 1] * ed); KdTs[(16 * sub + e) * 72 + i] = (bf16_t)(w & 0xffffu); KdTs[(16 * sub + e + 1) * 72 + i] = (bf16_t)(w >> 16); }
                } else { u32x4* dst = (u32x4*)(UTg + ((size_t)I * 64 + i) * 128 + 16 * sub); dst[0] = pack8(y); dst[1] = pack8(y + 8); }
            }
            __syncthreads();
            if (k < 3) PREP_LOADRAW(k + 1);
#pragma unroll
            for (int u = 0; u < 2; ++u) { const int ch = tid + 512 * u, d = ch >> 3, part = ch & 7;
                *(u32x4*)(KdTg + (size_t)I * 8192 + ((((d >> 4) * 2 + (part >> 2)) * 64 + (part & 3) * 16 + (d & 15)) * 8)) = *(const LAS u32x4*)(KdTs + d * 72 + 8 * part); }
            { const int pr = wave >> 2, ti = wave & 3;
              for (int tj = 0; tj < 4; ++tj) {
                  f32x4 acc = {0.f, 0.f, 0.f, 0.f};
                  if (tj <= ti) {
#pragma unroll
                      for (int s = 0; s < 4; ++s) {
                          if (pr == 0) { const bf16x8 a = *(const LAS bf16x8*)(Kn + (16 * ti + r16) * 136 + 32 * s + 8 * q4), b = *(const LAS bf16x8*)(Kn + (16 * tj + r16) * 136 + 32 * s + 8 * q4); acc = MFMA16(a, b, acc); }
                          else { const bf16x8 a = *(const LAS bf16x8*)(Kn + (16 * tj + r16) * 136 + 32 * s + 8 * q4), b = *(const LAS bf16x8*)(Qn + (16 * ti + r16) * 136 + 32 * s + 8 * q4); acc = MFMA16(a, b, acc); }
                      }
                  }
                  if (pr == 0) {
                      if (tj <= ti) { const int jj = 16 * tj + r16; const float gj = gcS[k * 64 + jj];
#pragma unroll
                          for (int rg = 0; rg < 4; ++rg) { const int ii = 16 * ti + 4 * q4 + rg; const float v = (ii > jj) ? betaS[k * 64 + ii] * acc[rg] * __expf(gcS[k * 64 + ii] - gj) : 0.f;
                              Lslot[k * 4096 + ii * 64 + jj] = v; } }
                  } else {
                      const int ii = 16 * ti + r16; const float gi = gcS[k * 64 + ii]; float o[4];
#pragma unroll
                      for (int rg = 0; rg < 4; ++rg) { const int jj = 16 * tj + 4 * q4 + rg; o[rg] = (tj <= ti && ii >= jj) ? acc[rg] * __expf(gi - gcS[k * 64 + jj]) : 0.f; }
                      u32x2 w; w.x = pk2(o[0], o[1]); w.y = pk2(o[2], o[3]);
                      *(u32x2*)(Ag + (size_t)I * 4096 + (((ti * 2 + (tj >> 1)) * 64 + ((2 * tj + (q4 >> 1)) & 3) * 16 + r16) * 8) + 4 * (q4 & 1)) = w;
                  }
              } }
            __syncthreads();
        }
        if (wave < 4) {
            const int lane = tid0 & 63;
            LAS float* L = Lslot + wave * 4096; float tc[64];
#pragma unroll
            for (int ii = 0; ii < 64; ++ii) { float a = (lane == ii) ? 1.f : 0.f;
#pragma unroll
                for (int jj = 0; jj < ii; ++jj) a -= L[ii * 64 + jj] * tc[jj];
                tc[ii] = a;
                if ((ii & 3) == 3) asm volatile("" ::: "memory"); }
            LDS_WAIT();
#pragma unroll
            for (int ii = 0; ii < 64; ++ii) L[ii * 64 + lane] = tc[ii];
        }
        __syncthreads();
#pragma unroll 1
        for (int k = 0; k < 4; ++k) {
            int tid = tid0; asm volatile("" : "+v"(tid));
            const int lane = tid & 63, r16 = lane & 15, q4 = lane >> 4, i = tid >> 3, sub = tid & 7;
            const int I = (int)blockIdx.x * 8 + batch * 4 + k;
            { const float be = betaS[k * 64 + i], beg = be * __expf(gcS[k * 64 + i]);
              const u32x4* pk = (const u32x4*)(Wg + ((size_t)I * 64 + i) * 128 + 16 * sub); const u32x4* pv = (const u32x4*)(UTg + ((size_t)I * 64 + i) * 128 + 16 * sub);
              float kv[16], vv[16]; unpack8(pk[0], kv); unpack8(pk[1], kv + 8); unpack8(pv[0], vv); unpack8(pv[1], vv + 8);
#pragma unroll
              for (int e = 0; e < 16; ++e) { vv[e] *= be; kv[e] *= beg; }
              *(LAS u32x4*)(VbT + i * 136 + 16 * sub) = pack8(vv); *(LAS u32x4*)(VbT + i * 136 + 16 * sub + 8) = pack8(vv + 8);
              *(LAS u32x4*)(KbgT + i * 136 + 16 * sub) = pack8(kv); *(LAS u32x4*)(KbgT + i * 136 + 16 * sub + 8) = pack8(kv + 8); }
            __syncthreads();
            { const int pr = wave >> 2, ti = wave & 3; bf16x8 aT[2];
#pragma unroll
              for (int s = 0; s < 2; ++s) { const LAS float* tp = Lslot + k * 4096 + (16 * ti + r16) * 64 + 32 * s + 8 * q4; const f32x4 t0 = *(const LAS f32x4*)tp, t1 = *(const LAS f32x4*)(tp + 4);
                  u32x4 w; w.x = pk2(t0.x, t0.y); w.y = pk2(t0.z, t0.w); w.z = pk2(t1.x, t1.y); w.w = pk2(t1.z, t1.w); aT[s] = as_bf8(w); }
#pragma unroll 2
              for (int tn = 0; tn < 8; ++tn) { f32x4 acc = {0.f, 0.f, 0.f, 0.f};
                  if (pr == 0) {
#pragma unroll
                      for (int s = 0; s < 2; ++s) { const LAS bf16_t* bp = VbT + (32 * s + 8 * q4 + (r16 >> 2)) * 136 + 16 * tn + 4 * (r16 & 3);
                          const s16x4 t0 = __builtin_amdgcn_ds_read_tr16_b64_v4i16((LAS s16x4*)bp), t1 = __builtin_amdgcn_ds_read_tr16_b64_v4i16((LAS s16x4*)(bp + 4 * 136));
                          const bf16x8 b = {t0[0], t0[1], t0[2], t0[3], t1[0], t1[1], t1[2], t1[3]}; acc = MFMA16(aT[s], b, acc); }
                      u32x2 w; w.x = pk2(acc[0], acc[1]); w.y = pk2(acc[2], acc[3]);
                      *(u32x2*)(UTg + (size_t)I * 8192 + (((tn * 4 + ti) * 64 + lane) * 4)) = w;
                  } else {
#pragma unroll
                      for (int s = 0; s < 2; ++s) { const LAS bf16_t* bp = KbgT + (32 * s + 8 * q4 + (r16 >> 2)) * 136 + 16 * tn + 4 * (r16 & 3);
                          const s16x4 t0 = __builtin_amdgcn_ds_read_tr16_b64_v4i16((LAS s16x4*)bp), t1 = __builtin_amdgcn_ds_read_tr16_b64_v4i16((LAS s16x4*)(bp + 4 * 136));
                          const bf16x8 b = {t0[0], t0[1], t0[2], t0[3], t1[0], t1[1], t1[2], t1[3]}; acc = MFMA16(b, aT[s], acc); }
                      u32x2 w; w.x = pk2(acc[0], acc[1]); w.y = pk2(acc[2], acc[3]);
                      *(u32x2*)(Wg + (size_t)I * 8192 + (((ti * 4 + (tn >> 1)) * 64 + ((2 * tn + (q4 >> 1)) & 3) * 16 + r16) * 8) + 4 * (q4 & 1)) = w;
                  } } }
            __syncthreads();
        }
    }
}

struct ScanBuf { bf16x8 a4[4]; bf16x8 a2[2]; bf16x8 kd[2]; u32x2 u[2]; float eg; };
template <int ROLE, int HOT>
__device__ __forceinline__ void scan_loop(const Params& p, LAS bf16_t* ST, LAS bf16_t* VT, int h, int vs, int wave, int lane) {
    const int r16 = lane & 15, q4 = lane >> 4, tm = wave & 3;
    const bf16_t* Wg = (const bf16_t*)(p.ws + WS_GDN); const bf16_t* UTg = (const bf16_t*)(p.ws + WS_GDN + 32 * MiB); const bf16_t* KdTg = (const bf16_t*)(p.ws + WS_GDN + 64 * MiB);
    const bf16_t* Qgg = (const bf16_t*)(p.ws + WS_GDN + 96 * MiB); const bf16_t* Ag = (const bf16_t*)(p.ws + WS_GDN + 128 * MiB);
    const float* egl = (const float*)(p.ws + WS_EGL);
    bf16_t* ocat = (bf16_t*)(p.ws + (HOT ? WS_H : WS_OCAT));
    const bf16_t* p4 = ROLE ? Qgg : Wg;
    f32x4 accS[2] = {{0.f, 0.f, 0.f, 0.f}, {0.f, 0.f, 0.f, 0.f}};
    ScanBuf B[4];
#define SCAN_LOAD(buf, cc) do { const size_t I_ = (size_t)h * 256 + (HOT ? ((cc) & 3) : (cc)); \
        _Pragma("unroll") for (int s = 0; s < 4; ++s) (buf).a4[s] = *(const bf16x8*)(p4 + I_ * 8192 + ((tm * 4 + s) * 64 + lane) * 8); \
        _Pragma("unroll") for (int s = 0; s < 2; ++s) (buf).kd[s] = *(const bf16x8*)(KdTg + I_ * 8192 + ((wave * 2 + s) * 64 + lane) * 8); \
        if (ROLE) { _Pragma("unroll") for (int s = 0; s < 2; ++s) (buf).a2[s] = *(const bf16x8*)(Ag + I_ * 4096 + ((tm * 2 + s) * 64 + lane) * 8); } \
        else { _Pragma("unroll") for (int tn = 0; tn < 2; ++tn) (buf).u[tn] = *(const u32x2*)(UTg + I_ * 8192 + (((vs * 2 + tn) * 4 + tm) * 64 + lane) * 4); } \
        (buf).eg = egl[I_]; } while (0)
#pragma unroll
    for (int u = 0; u < 4; ++u) SCAN_LOAD(B[u], u);
    for (int c0 = 0; c0 < 256; c0 += 4) {
#pragma unroll
        for (int u = 0; u < 4; ++u) {
            const int c = c0 + u, pb = u & 1;
            const LAS bf16_t* STc = ST + pb * (32 * 136); LAS bf16_t* STn = ST + (pb ^ 1) * (32 * 136);
            if (ROLE == 0) asm volatile("" : "+v"(B[u].u[0].x), "+v"(B[u].u[0].y), "+v"(B[u].u[1].x), "+v"(B[u].u[1].y), "+v"(B[u].eg));
            else asm volatile("" : "+v"(B[u].eg));
            bf16x8 sf[2][4];
#pragma unroll
            for (int tn = 0; tn < 2; ++tn)
#pragma unroll
                for (int s = 0; s < 4; ++s) sf[tn][s] = *(const LAS bf16x8*)(STc + (16 * tn + r16) * 136 + 32 * s + 8 * q4);
            f32x4 o[2] = {{0.f, 0.f, 0.f, 0.f}, {0.f, 0.f, 0.f, 0.f}};
            if (ROLE == 0) {
#pragma unroll
                for (int tn = 0; tn < 2; ++tn) { f32x4 t1 = {0.f, 0.f, 0.f, 0.f};
#pragma unroll
                    for (int s = 0; s < 4; ++s) t1 = MFMA16(B[u].a4[s], sf[tn][s], t1);
                    const float v0 = bflo(B[u].u[tn].x) - t1[0], v1 = bfhi(B[u].u[tn].x) - t1[1], v2 = bflo(B[u].u[tn].y) - t1[2], v3 = bfhi(B[u].u[tn].y) - t1[3];
                    u32x2 w; w.x = pk2(v0, v1); w.y = pk2(v2, v3);
                    *(LAS u32x2*)(VT + (16 * tn + r16) * 72 + 16 * tm + 4 * q4) = w; }
            } else {
#pragma unroll
                for (int tn = 0; tn < 2; ++tn)
#pragma unroll
                    for (int s = 0; s < 4; ++s) o[tn] = MFMA16(sf[tn][s], B[u].a4[s], o[tn]);
            }
            accS[0] *= B[u].eg; accS[1] *= B[u].eg;
            LDS_WAIT(); __builtin_amdgcn_s_barrier(); asm volatile("" ::: "memory");
            bf16x8 vf[2][2];
#pragma unroll
            for (int tn = 0; tn < 2; ++tn)
#pragma unroll
                for (int s = 0; s < 2; ++s) vf[tn][s] = *(const LAS bf16x8*)(VT + (16 * tn + r16) * 72 + 32 * s + 8 * q4);
#pragma unroll
            for (int tn = 0; tn < 2; ++tn) {
#pragma unroll
                for (int s = 0; s < 2; ++s) accS[tn] = MFMA16(B[u].kd[s], vf[tn][s], accS[tn]);
                u32x2 w; w.x = pk2(accS[tn][0], accS[tn][1]); w.y = pk2(accS[tn][2], accS[tn][3]);
                *(LAS u32x2*)(STn + (16 * tn + r16) * 136 + 16 * wave + 4 * q4) = w; }
            if (ROLE) {
#pragma unroll
                for (int tn = 0; tn < 2; ++tn) {
#pragma unroll
                    for (int s = 0; s < 2; ++s) o[tn] = MFMA16(vf[tn][s], B[u].a2[s], o[tn]);
                    u32x2 w; w.x = pk2(o[tn][0], o[tn][1]); w.y = pk2(o[tn][2], o[tn][3]);
                    if (HOT < 2) *(u32x2*)(ocat + (size_t)(64 * c + 16 * tm + r16) * D_ + h * 128 + vs * 32 + 16 * tn + 4 * q4) = w; else asm volatile("" :: "v"(w.x), "v"(w.y)); }
            }
            { const int cn = (c + 4 < 256) ? c + 4 : 255; SCAN_LOAD(B[u], cn); }
            LDS_WAIT(); __builtin_amdgcn_s_barrier(); asm volatile("" ::: "memory");
        }
    }
#undef SCAN_LOAD
}
template <int HOT>
__device__ __forceinline__ void scan_phase(const Params& p, LAS unsigned char* lds, const int tid_in) {
    const int tid = tid_in, lane = tid & 63, wave = __builtin_amdgcn_readfirstlane(tid >> 6);
    const int h = (int)blockIdx.x & 7, vs = (int)blockIdx.x >> 3;
    LAS bf16_t* ST = (LAS bf16_t*)lds;
    LAS bf16_t* VT = (LAS bf16_t*)(lds + 17408);
    for (int u = tid; u < 2 * 32 * 136 / 2; u += 512) ((LAS unsigned*)ST)[u] = 0u;
    __syncthreads();
    if (wave < 4) scan_loop<0, HOT>(p, ST, VT, h, vs, wave, lane); else scan_loop<1, HOT>(p, ST, VT, h, vs, wave, lane);
    __syncthreads();
}


__device__ __forceinline__ void sb_attn_phase(const Params& p, LAS unsigned char* lds, int l, int first_blk, int nblk, const int tid_in) {
    const int tid = tid_in, lane = tid & 63, wave = __builtin_amdgcn_readfirstlane(tid >> 6);
    const int r16 = lane & 15, q4 = lane >> 4;
    LAS bf16_t* Qs = (LAS bf16_t*)lds; LAS bf16_t* Ks = (LAS bf16_t*)(lds + 34816); LAS bf16_t* Vs = (LAS bf16_t*)(lds + 52224);
    LAS float* Z = (LAS float*)(lds + 70656); LAS bf16_t* As = (LAS bf16_t*)(lds + 103936); LAS float* SegTot = (LAS float*)(lds + 122368);
    const bf16_t* proj = (const bf16_t*)(p.ws + WS_PROJ);
    bf16_t* ocat = (bf16_t*)(p.ws + WS_OCAT);
    const float* gq = p.sbq + l * 128; const float* gk = p.sbk + l * 128;
    const int q = tid & 127, seg = tid >> 7;
    for (int item = (int)blockIdx.x - first_blk; item < 1024; item += nblk) {
        const int h = item & 7, qb = 127 - (item >> 3);
#pragma unroll
        for (int u = 0; u < 4; ++u) { const int ch = tid + 512 * u, row = ch >> 4, c8 = ch & 15;
            float xv[8]; unpack8(*(const u32x4*)(proj + (size_t)(128 * qb + row) * NIN + PQ_B + h * 128 + 8 * c8), xv);
            float ss = 0.f;
#pragma unroll
            for (int e = 0; e < 8; ++e) ss += xv[e] * xv[e];
            ss += __shfl_xor(ss, 1); ss += __shfl_xor(ss, 2); ss += __shfl_xor(ss, 4); ss += __shfl_xor(ss, 8);
            const float sc = rsqrtf(ss * (1.f / 128.f) + EPS_) * 0.08838834764831845f;
#pragma unroll
            for (int e = 0; e < 8; ++e) xv[e] *= sc * gq[8 * c8 + e];
            *(LAS u32x4*)(Qs + row * 136 + 8 * c8) = pack8(xv); }
        f32x4 oacc[8];
#pragma unroll
        for (int tn = 0; tn < 8; ++tn) oacc[tn] = (f32x4){0.f, 0.f, 0.f, 0.f};
        float Rq = 0.f;
        const int tq = 128 * qb + q;
        u32x4 kreg[2], vreg[2];
#pragma unroll
        for (int u = 0; u < 2; ++u) { const int ch = tid + 512 * u, row = ch >> 4, c8 = ch & 15; const size_t rb = (size_t)(64 * (2 * qb + 1) + row) * NIN + h * 128 + 8 * c8;
            kreg[u] = *(const u32x4*)(proj + rb + PK_B); vreg[u] = *(const u32x4*)(proj + rb + PV_B); }
        for (int j = 2 * qb + 1; j >= 0; --j) {
#pragma unroll
            for (int u = 0; u < 2; ++u) { const int ch = tid + 512 * u, row = ch >> 4, c8 = ch & 15;
                float xv[8]; unpack8(kreg[u], xv);
                float ss = 0.f;
#pragma unroll
                for (int e = 0; e < 8; ++e) ss += xv[e] * xv[e];
                ss += __shfl_xor(ss, 1); ss += __shfl_xor(ss, 2); ss += __shfl_xor(ss, 4); ss += __shfl_xor(ss, 8);
                const float sc = rsqrtf(ss * (1.f / 128.f) + EPS_);
#pragma unroll
                for (int e = 0; e < 8; ++e) xv[e] *= sc * gk[8 * c8 + e];
                *(LAS u32x4*)(Ks + row * 136 + 8 * c8) = pack8(xv);
                *(LAS u32x4*)(Vs + row * 136 + 8 * c8) = vreg[u]; }
            { const int jn = j > 0 ? j - 1 : 0;
#pragma unroll
              for (int u = 0; u < 2; ++u) { const int ch = tid + 512 * u, row = ch >> 4, c8 = ch & 15; const size_t rb = (size_t)(64 * jn + row) * NIN + h * 128 + 8 * c8;
                  kreg[u] = *(const u32x4*)(proj + rb + PK_B); vreg[u] = *(const u32x4*)(proj + rb + PV_B); } }
            __syncthreads();
            { bf16x8 qf[4];
#pragma unroll
              for (int s = 0; s < 4; ++s) qf[s] = *(const LAS bf16x8*)(Qs + (16 * wave + r16) * 136 + 32 * s + 8 * q4);
#pragma unroll
              for (int tn = 0; tn < 4; ++tn) { f32x4 acc = {0.f, 0.f, 0.f, 0.f};
#pragma unroll
                  for (int s = 0; s < 4; ++s) { const bf16x8 kf = *(const LAS bf16x8*)(Ks + (16 * tn + r16) * 136 + 32 * s + 8 * q4); acc = MFMA16(qf[s], kf, acc); }
#pragma unroll
                  for (int rg = 0; rg < 4; ++rg) Z[(16 * wave + 4 * q4 + rg) * 65 + 16 * tn + r16] = acc[rg]; } }
            __syncthreads();
            float zz[16], ls[16], suf[16]; const int s0 = 64 * j + 16 * seg;
#pragma unroll
            for (int e = 0; e < 16; ++e) { zz[e] = Z[q * 65 + 16 * seg + e]; ls[e] = (s0 + e < tq) ? -softplus_fast(zz[e]) : 0.f; }
            float run = 0.f;
#pragma unroll
            for (int e = 15; e >= 0; --e) { suf[e] = run; run += ls[e]; }
            SegTot[seg * 128 + q] = run;
            __syncthreads();
            float hi = 0.f, all = 0.f;
#pragma unroll
            for (int sg = 0; sg < 4; ++sg) { const float tv = SegTot[sg * 128 + q]; all += tv; if (sg > seg) hi += tv; }
            const float base = Rq + hi; float av[16];
#pragma unroll
            for (int e = 0; e < 16; ++e) av[e] = (s0 + e < tq) ? __expf(zz[e] + ls[e] + base + suf[e]) : 0.f;
            Rq += all;
            *(LAS u32x4*)(As + q * 72 + 16 * seg) = pack8(av); *(LAS u32x4*)(As + q * 72 + 16 * seg + 8) = pack8(av + 8);
            __syncthreads();
            { bf16x8 af[2];
#pragma unroll
              for (int s = 0; s < 2; ++s) af[s] = *(const LAS bf16x8*)(As + (16 * wave + r16) * 72 + 32 * s + 8 * q4);
#pragma unroll
              for (int tn = 0; tn < 8; ++tn)
#pragma unroll
                  for (int s = 0; s < 2; ++s) {
                      const LAS bf16_t* vp = Vs + (32 * s + 8 * q4 + (r16 >> 2)) * 136 + 16 * tn + 4 * (r16 & 3);
                      const s16x4 t0 = __builtin_amdgcn_ds_read_tr16_b64_v4i16((LAS s16x4*)vp), t1 = __builtin_amdgcn_ds_read_tr16_b64_v4i16((LAS s16x4*)(vp + 4 * 136));
                      const bf16x8 vf = {t0[0], t0[1], t0[2], t0[3], t1[0], t1[1], t1[2], t1[3]};
                      oacc[tn] = MFMA16(vf, af[s], oacc[tn]); } }
            if (!__syncthreads_or(Rq >= -104.f)) break;
        }
        __syncthreads();
#pragma unroll
        for (int tn = 0; tn < 8; ++tn) { u32x2 w; w.x = pk2(oacc[tn][0], oacc[tn][1]); w.y = pk2(oacc[tn][2], oacc[tn][3]);
            *(u32x2*)(ocat + (size_t)(128 * qb + 16 * wave + r16) * D_ + 1024 + h * 128 + 16 * tn + 4 * q4) = w; }
    }
}

__device__ __forceinline__ void gdn_finalize_phase(const Params& p, int l, const int tid_in) {
    const int g = opaque_bid() * 512 + tid_in, l16 = g & 15;
    bf16_t* ocat = (bf16_t*)(p.ws + WS_OCAT); const bf16_t* proj = (const bf16_t*)(p.ws + WS_PROJ);
    float gn[8];
#pragma unroll
    for (int e = 0; e < 8; ++e) gn[e] = p.gdn_norm[l * 128 + 8 * l16 + e];
#pragma unroll 4
    for (int R = g >> 4; R < T_ * NH; R += ((int)gridDim.x * 512) >> 4) {
        const int t = R >> 3, h = R & 7;
        u32x4* op = (u32x4*)(ocat + (size_t)t * D_ + h * 128 + 8 * l16);
        float ov[8], zv[8]; unpack8(*op, ov); unpack8(*(const u32x4*)(proj + (size_t)t * NIN + PZ_A + h * 128 + 8 * l16), zv);
        float ss = 0.f;
#pragma unroll
        for (int e = 0; e < 8; ++e) ss += ov[e] * ov[e];
        ss += __shfl_xor(ss, 1); ss += __shfl_xor(ss, 2); ss += __shfl_xor(ss, 4); ss += __shfl_xor(ss, 8);
        const float rs = rsqrtf(ss * (1.f / 128.f) + EPS_);
#pragma unroll
        for (int e = 0; e < 8; ++e) ov[e] = ov[e] * rs * gn[e] * silu_f(zv[e]);
        *op = pack8(ov);
    }
}

__device__ __forceinline__ void act_fix_rows(const Params& p, int l, const int tid_in, const int pm) {
    bf16_t* V = (bf16_t*)(p.ws + WS_V); const bf16_t* Gh = (const bf16_t*)(p.ws + WS_G); const bf16_t* Gt = (const bf16_t*)(p.ws + WS_G + 8 * MiB); const bf16_t* Vh = (const bf16_t*)(p.ws + WS_G + 16 * MiB);
    const float* cw = p.conv_ffn + (size_t)l * 3 * DFF;
    for (int it = tid_in; it < 8 * 704; it += 512) {
        const int q = it / 704, cc = it % 704, col = 8 * cc, sp = 4 * pm + (q >> 1), rs = q & 1;
        float w0[8], w1[8], w2[8], ga[8], gb[8], gc[8], vv[8], o[8];
#pragma unroll
        for (int e = 0; e < 8; ++e) { w0[e] = cw[col + e]; w1[e] = cw[DFF + col + e]; w2[e] = cw[2 * DFF + col + e]; }
        const int spm = sp > 0 ? sp - 1 : 0;
        const bf16_t* pa = rs ? Gt + (size_t)(spm * 2 + 1) * DFF + col : Gt + (size_t)(spm * 2) * DFF + col;
        const bf16_t* pb = rs ? Gh + (size_t)(sp * 2) * DFF + col : Gt + (size_t)(spm * 2 + 1) * DFF + col;
        const bf16_t* pc = rs ? Gh + (size_t)(sp * 2 + 1) * DFF + col : Gh + (size_t)(sp * 2) * DFF + col;
        unpack8(*(const u32x4*)pa, ga); unpack8(*(const u32x4*)pb, gb); unpack8(*(const u32x4*)pc, gc);
        const float za = (sp > 0) ? 1.f : 0.f, zb = (sp > 0 || rs) ? 1.f : 0.f;
#pragma unroll
        for (int e = 0; e < 8; ++e) { ga[e] *= za; gb[e] *= zb; }
        unpack8(*(const u32x4*)(Vh + (size_t)(sp * 2 + rs) * DFF + col), vv);
#pragma unroll
        for (int e = 0; e < 8; ++e) o[e] = silu_f(w0[e] * ga[e] + w1[e] * gb[e] + w2[e] * gc[e]) * vv[e];
        *(u32x4*)(V + ((size_t)64 * sp + rs) * DFF + col) = pack8(o);
    }
}

__global__ void __launch_bounds__(512) fwd_megakernel(Params p) {
    extern __shared__ __attribute__((aligned(16))) unsigned char lds_raw[];
    LAS unsigned char* lds = (LAS unsigned char*)lds_raw;
    cg::grid_group grid = cg::this_grid();
    const int wave_sg = __builtin_amdgcn_readfirstlane((int)threadIdx.x >> 6);
    if (threadIdx.x < 4) ((volatile LAS unsigned*)(lds + 131072))[threadIdx.x] = 0u;
    __syncthreads();
    (void)xcd_barrier_post((unsigned*)(p.ws + WS_BAR), (volatile LAS unsigned*)(lds + 131072));
    if (p.ph_hi < 0) grid.sync();
#if defined(__HIP_DEVICE_COMPILE__)
#define GRID_BARRIER() xcd_barrier((unsigned*)(((const __attribute__((address_space(4))) Params*)__builtin_amdgcn_kernarg_segment_ptr())->ws + WS_BAR), (volatile LAS unsigned*)(lds + 131072), wave_sg == 0 && lane_id_hw() == 0)
#else
#define GRID_BARRIER() xcd_barrier((unsigned*)(p.ws + WS_BAR), (volatile LAS unsigned*)(lds + 131072), wave_sg == 0 && lane_id_hw() == 0)
#endif
    const int lo = p.ph_lo, hi = p.ph_hi;
    int ph = 0;
#ifndef REP_MASK
#define REP_MASK 0
#endif
#if defined(__HIP_DEVICE_COMPILE__)
#define LOAD_ARGS const __attribute__((address_space(4))) Params* kp_ = (const __attribute__((address_space(4))) Params*)__builtin_amdgcn_kernarg_segment_ptr(); asm volatile("" : "+s"(kp_)); Params pp = *kp_;
#else
#define LOAD_ARGS Params pp = p;
#endif
#define PHASE_BEGIN if (ph >= lo && ph < hi) { const int nrep_ = 1 + ((REP_MASK >> ph) & 1); for (int rep_ = 0; rep_ < nrep_; ++rep_) { if (rep_) GRID_BARRIER(); LOAD_ARGS int ll = l; int tid_ = (wave_sg << 6) | lane_id_hw(); asm volatile("" : "+v"(tid_)); asm volatile("" : "+s"(pp.ws), "+s"(ll)); asm volatile("" : "+s"(pp.out));
#define PHASE_END } } ++ph; if (ph > lo && ph < hi) GRID_BARRIER();
    { const int l = 0; PHASE_BEGIN p0_phase(pp, lds, tid_); PHASE_END }
#ifdef REP_SCAN
#define REP_SCAN_N REP_SCAN
#else
#define REP_SCAN_N 0
#endif
#ifdef REP_ATTN
#define REP_ATTN_N 1
#else
#define REP_ATTN_N 0
#endif
#define LAYER_BODY(l)  \
        PHASE_BEGIN norm_phase(pp, lds, (ll == 0) ? pp.x : (const float*)pp.out, pp.norm1 + ll * D_, ll, 0, 2048, ll == 0, tid_); PHASE_END \
        PHASE_BEGIN { GAS unsigned char* wl = pp.ws + WS_W + (size_t)ll * W_LAYER; \
            win_small_cols(pp, lds, ll, tid_); pg8::Gemm g{(const bf16_t*)(pp.ws + WS_H), (const bf16_t*)(wl + W_IN_OFF), T_, 7168, D_}; pg8::StaticOrder S; S.init(T_, 7168, (int)gridDim.x, (int)blockIdx.x); \
            pg8::EpiBf16 E{(bf16_t*)(pp.ws + WS_PROJ), NIN, 0, 0}; pg8::gemm_phase(lds, g, S, E, tid_); } PHASE_END \
        PHASE_BEGIN gdn_prep_phase(pp, lds, ll, tid_); PHASE_END \
        PHASE_BEGIN if ((int)blockIdx.x < 32) { scan_phase<0>(pp, lds, tid_); \
            if (REP_SCAN_N) { __syncthreads(); scan_phase<(REP_SCAN_N > 0 ? REP_SCAN_N - 1 : 0)>(pp, lds, tid_); } \
            } else { sb_attn_phase(pp, lds, ll, 32, (int)gridDim.x - 32, tid_); \
            if (REP_ATTN_N) { __syncthreads(); sb_attn_phase(pp, lds, ll, 32, (int)gridDim.x - 32, tid_); } \
            { __syncthreads(); const int gw_ = ((int)blockIdx.x - 32) * 8 + (tid_ >> 6), ng_ = ((int)gridDim.x - 32) * 8;        \
              weight_transposes(pp, lds, tid_, l, 2 | 4 | 8, gw_, ng_); if (l == 0) weight_transposes(pp, lds, tid_, 1, 1, gw_, ng_); } \
            } PHASE_END \
        PHASE_BEGIN gdn_finalize_phase(pp, ll, tid_); PHASE_END \
        PHASE_BEGIN { GAS unsigned char* wl = pp.ws + WS_W + (size_t)ll * W_LAYER; const float* modf = (const float*)(pp.ws + WS_MODF) + ll * 12288; \
            pg8::Gemm g{(const bf16_t*)(pp.ws + WS_OCAT), (const bf16_t*)(wl + W_OUT_OFF), T_, D_, D_}; pg8::StaticOrder S; S.init(T_, D_, (int)gridDim.x, (int)blockIdx.x); \
            pg8::EpiRes E{(ll == 0) ? pp.x : (const float*)pp.out, (float*)pp.out, D_, modf + 4096}; pg8::gemm_phase(lds, g, S, E, tid_); } PHASE_END \
        PHASE_BEGIN norm_phase(pp, lds, (const float*)pp.out, pp.norm2 + ll * D_, ll, 6144, 8192, false, tid_); PHASE_END \
        PHASE_BEGIN { GAS unsigned char* wl = pp.ws + WS_W + (size_t)ll * W_LAYER; \
            pg8::Gemm g{(const bf16_t*)(pp.ws + WS_H), (const bf16_t*)(wl + W_UP_OFF), T_, NUP, D_}; pg8::StaticOrder S; S.init(T_, NUP, (int)gridDim.x, (int)blockIdx.x); \
            pg8::EpiAct E{(bf16_t*)(pp.ws + WS_V), (bf16_t*)(pp.ws + WS_G), (bf16_t*)(pp.ws + WS_G + 8 * MiB), (bf16_t*)(pp.ws + WS_G + 16 * MiB), pp.conv_ffn + (size_t)ll * 3 * DFF}; pg8::gemm_phase(lds, g, S, E, tid_); } PHASE_END \
        PHASE_BEGIN { GAS unsigned char* wl = pp.ws + WS_W + (size_t)ll * W_LAYER; const float* modf = (const float*)(pp.ws + WS_MODF) + ll * 12288; \
            pg8::Gemm g{(const bf16_t*)(pp.ws + WS_V), (const bf16_t*)(wl + W_DN_OFF), T_, D_, DFF}; pg8::StaticOrder S; S.init(T_, D_, (int)gridDim.x, (int)blockIdx.x); \
            { pg8::Unit uu_; int last_ = -1; for (int i_ = 0; S.next(i_, uu_); ++i_) if (uu_.pm != last_) { act_fix_rows(pp, ll, tid_, uu_.pm); last_ = uu_.pm; } asm volatile("s_waitcnt vmcnt(0)" ::: "memory"); __syncthreads(); } \
            pg8::EpiRes E{(const float*)pp.out, (float*)pp.out, D_, modf + 10240}; pg8::gemm_phase(lds, g, S, E, tid_); } PHASE_END \

    { const int l = 0; LAYER_BODY(l) }
    { const int l = 1; LAYER_BODY(l) }
#undef LAYER_BODY
#undef PHASE_BEGIN
#undef PHASE_END
#ifdef EXTRA_SYNCS
    for (int e = 0; e < EXTRA_SYNCS; ++e) GRID_BARRIER();
#endif
#ifdef DBG_OFF
    GRID_BARRIER();
    { const bf16_t* src = (const bf16_t*)(p.ws + (size_t)DBG_OFF);
      for (size_t i = (size_t)blockIdx.x * 512 + ((wave_sg << 6) | lane_id_hw()); i < (size_t)T_ * D_; i += (size_t)gridDim.x * 512) p.out[i] = bf2f(src[i]); }
#endif
}

extern "C" void kernel_launch(void* const* d_in, const int* in_sizes, int n_in, void* d_out, int out_size, void* d_ws, size_t ws_size, hipStream_t stream) {
    static int grid = 0;
    if (grid == 0) {
        if (n_in != 17 || ws_size < WS_END) { fprintf(stderr, "kernel_launch: expected 17 inputs and >= %zu bytes of workspace; got %d, %zu\n", (size_t)WS_END, n_in, ws_size); grid = -1; return; }
        int dev = 0, cus = 0, per_cu = 0;
        hipGetDevice(&dev); hipDeviceGetAttribute(&cus, hipDeviceAttributeMultiprocessorCount, dev);
        if (hipFuncSetAttribute((const void*)fwd_megakernel, hipFuncAttributeMaxDynamicSharedMemorySize, LDS_BYTES) != hipSuccess) { fprintf(stderr, "kernel_launch: hipFuncSetAttribute failed\n"); grid = -1; return; }
        hipOccupancyMaxActiveBlocksPerMultiprocessor(&per_cu, (const void*)fwd_megakernel, 512, LDS_BYTES);
        if (per_cu < 1) { fprintf(stderr, "kernel_launch: occupancy query says %d blocks/CU\n", per_cu); per_cu = 1; }
        (void)hipGetLastError();
        grid = cus;
        if (grid > 256) grid = 256;
    }
    if (grid < 0) return;
    Params p{};
    p.x = (const float*)d_in[0]; p.c = (const float*)d_in[1]; p.w_ada = (const float*)d_in[2]; p.b_ada = (const float*)d_in[3]; p.norm1 = (const float*)d_in[4];
    p.w_in = (const float*)d_in[5]; p.conv_qkv = (const float*)d_in[6]; p.a_log = (const float*)d_in[7]; p.dt_bias = (const float*)d_in[8]; p.gdn_norm = (const float*)d_in[9];
    p.sbq = (const float*)d_in[10]; p.sbk = (const float*)d_in[11]; p.w_out = (const float*)d_in[12]; p.norm2 = (const float*)d_in[13]; p.w_up = (const float*)d_in[14];
    p.conv_ffn = (const float*)d_in[15]; p.w_down = (const float*)d_in[16];
    p.out = (GAS float*)d_out; p.ws = (GAS unsigned char*)d_ws; p.ph_lo = 0; p.ph_hi = 19;
#ifdef DBG_HI
    p.ph_hi = DBG_HI;
#endif
    if (hipMemsetAsync((char*)d_ws + WS_BAR, 0, XCD_BAR_WORDS * 4, stream) != hipSuccess) { fprintf(stderr, "kernel_launch: hipMemsetAsync failed\n"); return; }
    void* args[] = {&p};
    hipError_t e = hipLaunchCooperativeKernel((const void*)fwd_megakernel, dim3(grid), dim3(512), args, LDS_BYTES, stream);
    if (e != hipSuccess) fprintf(stderr, "cooperative launch failed: %s (grid %d)\n", hipGetErrorString(e), grid);
}
```

```cpp
#define REP_S1 2
#include <hip/hip_runtime.h>
#include <hip/hip_cooperative_groups.h>
#include <cstdio>
#include <cstdint>
namespace cg = cooperative_groups;

#define LAS __attribute__((address_space(3)))
#define GAS __attribute__((address_space(1)))
typedef unsigned short bf16_t;
typedef short bf16x8 __attribute__((ext_vector_type(8)));
typedef short s16x4 __attribute__((ext_vector_type(4)));
typedef float f32x4 __attribute__((ext_vector_type(4)));
typedef float f32x2 __attribute__((ext_vector_type(2)));
typedef unsigned u32x4 __attribute__((ext_vector_type(4)));
typedef unsigned u32x2 __attribute__((ext_vector_type(2)));

constexpr int T_ = 16384, D_ = 2048, DIN = 7184, NIN = 7424, DFF = 5632, NUP = 11264, NH = 8;
constexpr int PQ_A = 0, PK_A = 1024, PV_A = 2048, PZ_A = 3072, PQ_B = 4096, PK_B = 5120, PV_B = 6144, PBETA = 7168, PALPHA = 7176;
constexpr int KS_MOD = 16;
constexpr float EPS_ = 1e-6f;
constexpr size_t MiB = 1024ull * 1024ull;
constexpr size_t WS_MODF = 0;
constexpr size_t WS_MODP = 131072;
constexpr size_t WS_EGL = 1835008;
constexpr size_t WS_PROG = 1900544;
constexpr size_t WS_BAR = 1904640;
constexpr size_t WS_W = 2 * MiB;
constexpr size_t W_IN_OFF = 0, W_OUT_OFF = 29 * MiB, W_UP_OFF = 37 * MiB, W_DN_OFF = 81 * MiB, W_LAYER = 103 * MiB;
constexpr size_t WS_H = 208 * MiB;
constexpr size_t WS_PROJ = 272 * MiB;
constexpr size_t WS_G = 272 * MiB, WS_V = 448 * MiB;
constexpr size_t WS_OCAT = 504 * MiB;
constexpr size_t WS_GDN = 568 * MiB;
constexpr size_t WS_END = 712 * MiB;
constexpr int LDS_BYTES = 131072 + 256;

struct Params {
    const float *x, *c, *w_ada, *b_ada, *norm1, *w_in, *conv_qkv, *a_log, *dt_bias, *gdn_norm, *sbq, *sbk, *w_out, *norm2, *w_up, *conv_ffn, *w_down;
    GAS float* out; GAS unsigned char* ws; int ph_lo, ph_hi;
};

typedef __bf16 bf16v2 __attribute__((ext_vector_type(2)));
__device__ __forceinline__ unsigned pk2(float lo, float hi) { const f32x2 v = {lo, hi}; union { bf16v2 b; unsigned u; } x; x.b = __builtin_convertvector(v, bf16v2); return x.u; }
__device__ __forceinline__ float bf2f(bf16_t b) { return __uint_as_float(((unsigned)b) << 16); }
__device__ __forceinline__ float bflo(unsigned w) { return __uint_as_float(w << 16); }
__device__ __forceinline__ float bfhi(unsigned w) { return __uint_as_float(w & 0xffff0000u); }
__device__ __forceinline__ void unpack8(const u32x4 v, float* f) { f[0] = bflo(v.x); f[1] = bfhi(v.x); f[2] = bflo(v.y); f[3] = bfhi(v.y); f[4] = bflo(v.z); f[5] = bfhi(v.z); f[6] = bflo(v.w); f[7] = bfhi(v.w); }
__device__ __forceinline__ u32x4 pack8(const float* f) { u32x4 o; o.x = pk2(f[0], f[1]); o.y = pk2(f[2], f[3]); o.z = pk2(f[4], f[5]); o.w = pk2(f[6], f[7]); return o; }
__device__ __forceinline__ float silu_f(float y) { return y * __builtin_amdgcn_rcpf(1.0f + __expf(-y)); }
__device__ __forceinline__ float softplus_f(float z) { return fmaxf(z, 0.f) + log1pf(__expf(-fabsf(z))); }
__device__ __forceinline__ float softplus_fast(float z) { return fmaxf(z, 0.f) + __logf(1.0f + __expf(-fabsf(z))); }
__device__ __forceinline__ float wave_sum(float v) {
#pragma unroll
    for (int o = 1; o < 64; o <<= 1) v += __shfl_xor(v, o);
    return v;
}
__device__ __forceinline__ bf16x8 as_bf8(u32x4 v) { union { u32x4 u; bf16x8 b; } x; x.u = v; return x.b; }
#define MFMA16(a, b, c) __builtin_amdgcn_mfma_f32_16x16x32_bf16((a), (b), (c), 0, 0, 0)
#define LDS_WAIT() asm volatile("s_waitcnt lgkmcnt(0)" ::: "memory")
__device__ __forceinline__ int lane_id_hw() { return (int)__builtin_amdgcn_mbcnt_hi(~0u, __builtin_amdgcn_mbcnt_lo(~0u, 0u)); }
__device__ __forceinline__ int opaque_bid() { int b = (int)blockIdx.x; asm volatile("" : "+s"(b)); return b; }


#define XB_TMO      128
#define XB_XCNT(j)  (256  + 64 * (j))
#define XB_XSUB(j)  (1280 + 64 * (j))
#define XB_XGEN(j)  (2304 + 64 * (j))
#define XB_TOP      3328
#define XB_TOPGEN   3392
#define XCD_BAR_WORDS 3456
#define XB_SPIN_CAP (1u << 18)
__device__ __forceinline__ unsigned xb_ld(unsigned* p)              { return __hip_atomic_load(p, __ATOMIC_RELAXED, __HIP_MEMORY_SCOPE_AGENT); }
__device__ __forceinline__ unsigned xb_add(unsigned* p, unsigned v) { return __hip_atomic_fetch_add(p, v, __ATOMIC_RELAXED, __HIP_MEMORY_SCOPE_AGENT); }
__device__ __forceinline__ unsigned xb_xcc_id() { return (unsigned)__builtin_amdgcn_s_getreg((3 << 11) | 20) & 0xFu; }
#define XB_SPIN(cond, bar) do { unsigned _sp = 0; while (cond) { __builtin_amdgcn_s_sleep(1); \
    if ((++_sp & 255u) == 0u) { if (xb_ld(&(bar)[XB_TMO])) break; if (_sp > XB_SPIN_CAP) { atomicAdd(&(bar)[XB_TMO], 1u); break; } } } } while (0)
struct XcdBarrier { unsigned* bar; unsigned x; volatile LAS unsigned* st; };
__device__ __forceinline__ XcdBarrier xcd_barrier_post(unsigned* bar, volatile LAS unsigned* st) {
    XcdBarrier b; b.bar = bar; b.x = xb_xcc_id(); b.st = st;
    if (threadIdx.x == 0) (void)xb_add(&bar[XB_XCNT(b.x)], 1u);
    return b;
}
__device__ __forceinline__ void xcd_barrier_complete(unsigned* bar, unsigned x, unsigned& nloc, unsigned& nx) {
    const unsigned G = gridDim.x * gridDim.y * gridDim.z;
    unsigned sum, cnt, mine, sp = 0u;
    for (;;) {
        sum = 0u; cnt = 0u; mine = 0u;
#pragma unroll
        for (unsigned j = 0; j < 16; ++j) { const unsigned c = xb_ld(&bar[XB_XCNT(j)]); sum += c; cnt += (c > 0u) ? 1u : 0u; mine = (j == x) ? c : mine; }
        if (sum == G) break;
        __builtin_amdgcn_s_sleep(1);
        if ((++sp & 255u) == 0u) { if (xb_ld(&bar[XB_TMO])) break; if (sp > XB_SPIN_CAP) { atomicAdd(&bar[XB_TMO], 1u); break; } }
    }
    nloc = mine > 0u ? mine : 1u; nx = cnt > 0u ? cnt : 1u;
}
__device__ __forceinline__ void xcd_barrier(unsigned* bar, volatile LAS unsigned* st, const bool is_t0) {
    asm volatile("s_waitcnt vmcnt(0)" ::: "memory");
    __syncthreads();
    if (is_t0) {
        const unsigned x = xb_xcc_id();
        __builtin_amdgcn_s_waitcnt(0);
        unsigned nloc = st[0], nx = st[1];
        if (nloc == 0u) { xcd_barrier_complete(bar, x, nloc, nx); st[0] = nloc; st[1] = nx; }
        const unsigned old = xb_add(&bar[XB_XSUB(x)], 1u);
        const unsigned gen = old / nloc;
        if (old + 1u == (gen + 1u) * nloc) {
            __builtin_amdgcn_fence(__ATOMIC_RELEASE, "agent");
            asm volatile("s_waitcnt vmcnt(0)" ::: "memory");
            const unsigned og = xb_add(&bar[XB_TOP], 1u);
            const unsigned tg = og / nx;
            if (og + 1u == (tg + 1u) * nx) xb_add(&bar[XB_TOPGEN], 1u);
            else XB_SPIN(xb_ld(&bar[XB_TOPGEN]) == tg, bar);
            __builtin_amdgcn_fence(__ATOMIC_ACQUIRE, "agent");
            xb_add(&bar[XB_XGEN(x)], 1u);
            asm volatile("s_waitcnt vmcnt(0)" ::: "memory");
        } else {
            XB_SPIN(xb_ld(&bar[XB_XGEN(x)]) == gen, bar);
            __builtin_amdgcn_fence(__ATOMIC_ACQUIRE, "agent");
            asm volatile("s_waitcnt vmcnt(0)" ::: "memory");
        }
    }
    __syncthreads();
}

namespace pg8 {
constexpr int BM = 256, BK = 64, HALF = 128, HTB = HALF * BK * 2, STAGE_BYTES = 8 * HTB, NXCD = 8, WGM = 8;
__host__ __device__ __forceinline__ int lds_byte(int r, int c) { const int st = (r >> 4) * 2 + (c >> 5), rr = r & 15, cc = c & 31, ob = rr * 64 + cc * 2; return st * 1024 + (ob ^ (((ob >> 9) & 1) << 5)); }
__host__ __device__ __forceinline__ void stage_rc(int b, int& R, int& C) { const int st = b / 1024, sb = b % 1024, swz = sb ^ (((sb >> 9) & 1) << 5); R = (st >> 1) * 16 + swz / 64; C = (st & 1) * 32 + (swz % 64) / 2; }
__host__ __device__ __forceinline__ int perm32(int rho) { const int n = rho >> 4, i = rho & 15; return 8 * (i >> 2) + 4 * n + (i & 3); }
struct Unit { int pm, pn; };
struct Gemm { const bf16_t* A; const bf16_t* Bt; int M, N, K; };
struct StaticOrder {
    int nM, nN, nwg, G, c;
    __device__ __forceinline__ void init(int M, int N, int G_, int c_) { nM = M / BM; nN = N / BM; nwg = nM * nN; G = G_; c = c_; }
    __device__ __forceinline__ bool next(int i, Unit& u) const {
        const long L = (long)i * G + c; if (L >= nwg) return false;
        int wgid = (int)L; { const int q = nwg / NXCD, r = nwg % NXCD, xcd = wgid % NXCD, off = wgid / NXCD; wgid = (xcd < r ? xcd * (q + 1) : r * (q + 1) + (xcd - r) * q) + off; }
        const int nig = WGM * nN, gid = wgid / nig, fm = gid * WGM, gsz = (nM - fm) < WGM ? (nM - fm) : WGM;
        u.pm = fm + ((wgid % nig) % gsz); u.pn = (wgid % nig) / gsz; return true;
    }
};
struct EpiBf16 {
    static constexpr bool PERM = true;
    bf16_t* O; int ldc; int split_cols; size_t split_stride;
    __device__ __forceinline__ void operator()(const f32x4 (&acc)[2][2][4][2], const Unit& u, int wr, int wc, int fr, int fq) const {
        const int row0 = u.pm * BM + wr * 64 + fr; int colt = u.pn * BM; bf16_t* base = O;
        if (split_cols) { const int t = colt / split_cols; base += (size_t)t * split_stride; colt -= t * split_cols; }
        const int col0 = colt + wc * 32 + 8 * fq;
#pragma unroll
        for (int ai = 0; ai < 2; ++ai)
#pragma unroll
            for (int m = 0; m < 4; ++m) { bf16_t* rowp = base + (size_t)(row0 + ai * HALF + m * 16) * ldc + col0;
#pragma unroll
                for (int bj = 0; bj < 2; ++bj) { const f32x4 v0 = acc[ai][bj][m][0], v1 = acc[ai][bj][m][1];
                    u32x4 w; w.x = pk2(v0[0], v0[1]); w.y = pk2(v0[2], v0[3]); w.z = pk2(v1[0], v1[1]); w.w = pk2(v1[2], v1[3]);
                    *(u32x4*)(rowp + bj * HALF) = w; } }
    }
};
struct EpiRes {
    static constexpr bool PERM = false;
    const float* xin; float* out; int ldc; const float* gate;
    __device__ __forceinline__ void operator()(const f32x4 (&acc)[2][2][4][2], const Unit& u, int wr, int wc, int fr, int fq) const {
        const int row0 = u.pm * BM + wr * 64 + fr, col0 = u.pn * BM + wc * 32 + 4 * fq;
        f32x4 gv[2][2];
#pragma unroll
        for (int bj = 0; bj < 2; ++bj)
#pragma unroll
            for (int n = 0; n < 2; ++n) gv[bj][n] = *(const f32x4*)(gate + col0 + bj * HALF + n * 16);
#pragma unroll
        for (int ai = 0; ai < 2; ++ai)
#pragma unroll
            for (int m = 0; m < 4; ++m) { const size_t off = (size_t)(row0 + ai * HALF + m * 16) * ldc + col0;
#pragma unroll
                for (int bj = 0; bj < 2; ++bj)
#pragma unroll
                    for (int n = 0; n < 2; ++n) { const f32x4 xv = *(const f32x4*)(xin + off + bj * HALF + n * 16);
                        *(f32x4*)(out + off + bj * HALF + n * 16) = xv + gv[bj][n] * acc[ai][bj][m][n]; }
                asm volatile("" ::: "memory"); }
    }
};

struct EpiAct {
    static constexpr bool PERM = true;
    bf16_t* V; bf16_t* Gh; bf16_t* Gt; bf16_t* Vh; const float* cw;
    __device__ __forceinline__ void operator()(const f32x4 (&acc)[2][2][4][2], const Unit& u, int wr, int wc, int fr, int fq) const {
        const int lane = fr + 16 * fq, ff0 = u.pn * HALF + wc * 32 + 8 * fq;
        float w0[8], w1[8], w2[8];
#pragma unroll
        for (int e = 0; e < 8; ++e) { w0[e] = cw[ff0 + e]; w1[e] = cw[DFF + ff0 + e]; w2[e] = cw[2 * DFF + ff0 + e]; }
        const int src1 = (fr >= 1) ? lane - 1 : lane + 15, src2 = (fr >= 2) ? lane - 2 : lane + 14;
#pragma unroll
        for (int ai = 0; ai < 2; ++ai) { const int strip = 4 * u.pm + 2 * ai + wr; const size_t row_base = (size_t)u.pm * BM + ai * HALF + wr * 64;
#pragma unroll
            for (int m = 0; m < 4; ++m) { float o[8], gr[8];
#pragma unroll
                for (int n = 0; n < 2; ++n)
#pragma unroll
                    for (int j = 0; j < 4; ++j) { const int e = 4 * n + j; const float g0 = acc[ai][0][m][n][j], v = acc[ai][1][m][n][j], gp = (m > 0) ? acc[ai][0][m > 0 ? m - 1 : 0][n][j] : 0.f;
                        const float s1_ = (fr == 15) ? gp : g0, s2_ = (fr >= 14) ? gp : g0;
                        const float g1 = __int_as_float(__builtin_amdgcn_update_dpp(0, __float_as_int(s1_), 0x121, 0xf, 0xf, false)), g2 = __int_as_float(__builtin_amdgcn_update_dpp(0, __float_as_int(s2_), 0x122, 0xf, 0xf, false));
                        const float y = w0[e] * g2 + w1[e] * g1 + w2[e] * g0; const float a = y * __builtin_amdgcn_rcpf(1.0f + __expf(-y)) * v;
                        o[e] = (m == 0 && fr < 2) ? v : a; gr[e] = g0; }
                { u32x4 w; w.x = pk2(o[0], o[1]); w.y = pk2(o[2], o[3]); w.z = pk2(o[4], o[5]); w.w = pk2(o[6], o[7]);
                  *(u32x4*)(V + (row_base + 16 * m + fr) * DFF + ff0) = w;
                  if (m == 0 && fr < 2) *(u32x4*)(Vh + (size_t)(strip * 2 + fr) * DFF + ff0) = w; }
                if (m == 0 && fr < 2) { u32x4 w; w.x = pk2(gr[0], gr[1]); w.y = pk2(gr[2], gr[3]); w.z = pk2(gr[4], gr[5]); w.w = pk2(gr[6], gr[7]); *(u32x4*)(Gh + (size_t)(strip * 2 + fr) * DFF + ff0) = w; }
                if (m == 3 && fr >= 14) { u32x4 w; w.x = pk2(gr[0], gr[1]); w.y = pk2(gr[2], gr[3]); w.z = pk2(gr[4], gr[5]); w.w = pk2(gr[6], gr[7]); *(u32x4*)(Gt + (size_t)(strip * 2 + fr - 14) * DFF + ff0) = w; } } }
    }
};

template <class Epi>
__device__ __forceinline__ void gemm_phase(LAS unsigned char* lds, const Gemm g, const StaticOrder& S, const Epi& E, const int tid_in) {
    const int tid = tid_in, wid = __builtin_amdgcn_readfirstlane(tid >> 6), lane = tid & 63, wr = wid >> 2, wc = wid & 3, fr = lane & 15, fq = lane >> 4;
    const int K = g.K, nt = K / BK;
    unsigned voffA[2], voffB[2];
#pragma unroll
    for (int i = 0; i < 2; ++i) { int R, C; stage_rc(tid * 16 + i * 8192, R, C); const int Rb = Epi::PERM ? ((R & ~31) + perm32(R & 31)) : R;
        voffA[i] = (unsigned)(R * K + C) * 2u; voffB[i] = (unsigned)(Rb * K + C) * 2u; }
    const size_t kstep = (size_t)(BK * 2);
    const size_t hstep = (size_t)HALF * K * 2;
    const size_t tstep = 2 * hstep;
    const unsigned ldsw = (unsigned)wid * 1024u;
    const int aoff = lds_byte(wr * 64 + fr, fq * 8), boff = lds_byte(wc * 32 + fr, fq * 8);
#define PG8_SA(b, h) (((b) * 2 + (h)) * HTB)
#define PG8_SB(b, h) ((4 + (b) * 2 + (h)) * HTB)
#define PG8_STAGE(bufoff, gbase, voff) do { _Pragma("unroll") for (int _i = 0; _i < 2; ++_i) \
        __builtin_amdgcn_global_load_lds((const unsigned*)((const char*)(gbase) + (voff)[_i]), (LAS unsigned*)(lds + (bufoff) + ldsw + _i * 8192), 16, 0, 0); } while (0)
#define PG8_LDA(dst, b, h) do { _Pragma("unroll") for (int m = 0; m < 4; ++m) _Pragma("unroll") for (int k = 0; k < 2; ++k) dst[m][k] = *(const LAS bf16x8*)(lds + PG8_SA(b, h) + aoff + m * 2048 + k * 1024); } while (0)
#define PG8_LDB(dst, b, h) do { _Pragma("unroll") for (int n = 0; n < 2; ++n) _Pragma("unroll") for (int k = 0; k < 2; ++k) dst[n][k] = *(const LAS bf16x8*)(lds + PG8_SB(b, h) + boff + n * 2048 + k * 1024); } while (0)
#define PG8_MMA(ai, bj, At, Bt) do { __builtin_amdgcn_s_setprio(1); _Pragma("unroll") for (int m = 0; m < 4; ++m) _Pragma("unroll") for (int n = 0; n < 2; ++n) _Pragma("unroll") for (int k = 0; k < 2; ++k) \
        acc[ai][bj][m][n] = __builtin_amdgcn_mfma_f32_16x16x32_bf16(Bt[n][k], At[m][k], acc[ai][bj][m][n], 0, 0, 0); __builtin_amdgcn_s_setprio(0); } while (0)
#define PG8_WAIT_V(n) asm volatile("s_waitcnt vmcnt(" #n ")" ::: "memory")
#define PG8_WAIT_L(n) asm volatile("s_waitcnt lgkmcnt(" #n ")" ::: "memory")
#define PG8_BAR __builtin_amdgcn_s_barrier()
#define PG8_SCHED __builtin_amdgcn_sched_barrier(0)
    Unit cur, nxt; int ui = 0;
    if (!S.next(0, cur)) return;
    f32x4 acc[2][2][4][2];
#pragma unroll
    for (int a = 0; a < 2; ++a)
#pragma unroll
        for (int b = 0; b < 2; ++b)
#pragma unroll
            for (int m = 0; m < 4; ++m)
#pragma unroll
                for (int n = 0; n < 2; ++n) acc[a][b][m][n] = (f32x4){0.f, 0.f, 0.f, 0.f};
    bf16x8 At[4][2], B0[2][2], B1[2][2];
    const char* cA = (const char*)g.A + (size_t)cur.pm * tstep; const char* cB = (const char*)g.Bt + (size_t)cur.pn * tstep;
    PG8_STAGE(PG8_SB(0, 0), cB, voffB); PG8_STAGE(PG8_SB(0, 1), cB + hstep, voffB); PG8_STAGE(PG8_SA(0, 0), cA, voffA); PG8_STAGE(PG8_SA(0, 1), cA + hstep, voffA);
    if (wr == 1) PG8_BAR;
    PG8_WAIT_V(2); PG8_BAR;
    PG8_STAGE(PG8_SB(1, 0), cB + kstep, voffB); PG8_STAGE(PG8_SA(1, 0), cA + kstep, voffA); PG8_STAGE(PG8_SB(1, 1), cB + hstep + kstep, voffB);
    PG8_WAIT_V(6); PG8_BAR;
    for (;;) {
        const bool has_next = S.next(ui + 1, nxt);
        const char* nA = has_next ? (const char*)g.A + (size_t)nxt.pm * tstep : cA; const char* nB = has_next ? (const char*)g.Bt + (size_t)nxt.pn * tstep : cB;
        for (int t = 0; t < nt; t += 2) {
            const bool last = (t == nt - 2);
            const char* a1 = cA + (size_t)(t + 1) * kstep;
            const char* a2 = last ? nA : cA + (size_t)(t + 2) * kstep; const char* b2 = last ? nB : cB + (size_t)(t + 2) * kstep;
            const char* a3 = a2 + kstep; const char* b3 = b2 + kstep;
            PG8_LDB(B0, 0, 0); PG8_LDB(B1, 0, 1); PG8_SCHED; PG8_LDA(At, 0, 0); PG8_STAGE(PG8_SA(1, 1), a1 + hstep, voffA);
            PG8_WAIT_V(8); PG8_WAIT_L(0); PG8_BAR; PG8_MMA(0, 0, At, B0); PG8_MMA(0, 1, At, B1); PG8_BAR; PG8_SCHED;
            PG8_LDA(At, 0, 1); PG8_STAGE(PG8_SB(0, 0), b2, voffB); PG8_STAGE(PG8_SB(0, 1), b2 + hstep, voffB); PG8_STAGE(PG8_SA(0, 0), a2, voffA);
            PG8_WAIT_V(8); PG8_WAIT_L(0); PG8_BAR; PG8_MMA(1, 0, At, B0); PG8_MMA(1, 1, At, B1); PG8_BAR; PG8_SCHED;
            PG8_LDB(B0, 1, 0); PG8_LDB(B1, 1, 1); PG8_SCHED; PG8_LDA(At, 1, 0); PG8_STAGE(PG8_SA(0, 1), a2 + hstep, voffA);
            PG8_WAIT_V(8); PG8_WAIT_L(0); PG8_BAR; PG8_MMA(0, 0, At, B0); PG8_MMA(0, 1, At, B1); PG8_BAR; PG8_SCHED;
            PG8_LDA(At, 1, 1); PG8_STAGE(PG8_SB(1, 0), b3, voffB); PG8_STAGE(PG8_SB(1, 1), b3 + hstep, voffB); PG8_STAGE(PG8_SA(1, 0), a3, voffA);
            PG8_WAIT_V(8); PG8_WAIT_L(0); PG8_BAR; PG8_MMA(1, 0, At, B0); PG8_MMA(1, 1, At, B1); PG8_BAR; PG8_SCHED;
        }
        if (wr == 0) PG8_BAR;
        E(acc, cur, wr, wc, fr, fq);
        if (!has_next) break;
#pragma unroll
        for (int a = 0; a < 2; ++a)
#pragma unroll
            for (int b = 0; b < 2; ++b)
#pragma unroll
                for (int m = 0; m < 4; ++m)
#pragma unroll
                    for (int n = 0; n < 2; ++n) acc[a][b][m][n] = (f32x4){0.f, 0.f, 0.f, 0.f};
        cur = nxt; cA = nA; cB = nB; ++ui;
        if (wr == 1) PG8_BAR;
    }
    PG8_WAIT_V(0);
    PG8_BAR;
#undef PG8_SA
#undef PG8_SB
#undef PG8_STAGE
#undef PG8_LDA
#undef PG8_LDB
#undef PG8_MMA
#undef PG8_WAIT_V
#undef PG8_WAIT_L
#undef PG8_BAR
#undef PG8_SCHED
}
}

__device__ __forceinline__ void transpose_item(const float* W, int K, int Nsrc, bf16_t* WT, int k0, int ndst0, int nsrc0, int nvalid, LAS float* scr, int lane) {
    float vv[32];
#pragma unroll
    for (int i = 0; i < 32; ++i) { const int kk = 2 * i + (lane >> 5), nn = lane & 31;
        vv[i] = (nn < nvalid) ? W[(size_t)(k0 + kk) * Nsrc + nsrc0 + nn] : 0.f; }
#pragma unroll
    for (int i = 0; i < 32; ++i) { const int kk = 2 * i + (lane >> 5), nn = lane & 31; scr[kk * 33 + nn] = vv[i]; }
    LDS_WAIT();
    const int c = lane & 7;
#pragma unroll
    for (int j = 0; j < 4; ++j) { const int n = (lane >> 3) + 8 * j; const LAS float* s = scr + (8 * c) * 33 + n;
        u32x4 o; o.x = pk2(s[0 * 33], s[1 * 33]); o.y = pk2(s[2 * 33], s[3 * 33]); o.z = pk2(s[4 * 33], s[5 * 33]); o.w = pk2(s[6 * 33], s[7 * 33]);
        *(u32x4*)(WT + (size_t)(ndst0 + n) * K + k0 + 8 * c) = o; }
    LDS_WAIT();
}
__device__ __forceinline__ void weight_transposes(const Params& p, LAS unsigned char* lds, const int tid_in, const int l, const int mask, const int gwv, const int NGW);
__device__ __forceinline__ void p0_phase(const Params& p, LAS unsigned char* lds, const int tid_in) {
    const int tid = tid_in, lane = tid & 63, wave = tid >> 6;
    LAS float* sc = (LAS float*)(lds + 8 * 8448);
    for (int k = tid; k < D_; k += 512) sc[k] = silu_f(p.c[k]);
    __syncthreads();
    { const int gw = wave * 256 + (int)blockIdx.x;
      if (gw < 1536) { const int g = gw * 64 + lane; const int l = g / 49152, rem = g % 49152, ks = rem / 3072, c4 = rem % 3072;
          const float* wp = p.w_ada + ((size_t)l * D_ + (size_t)ks * 128) * 12288 + 4 * c4;
          f32x4 a0 = {0.f, 0.f, 0.f, 0.f}, a1 = a0;
#pragma unroll 4
          for (int k = 0; k < 128; k += 2) { const f32x4 w0 = *(const f32x4*)(wp + (size_t)k * 12288), w1 = *(const f32x4*)(wp + (size_t)(k + 1) * 12288);
              a0 += w0 * sc[ks * 128 + k]; a1 += w1 * sc[ks * 128 + k + 1]; }
          *(f32x4*)((float*)(p.ws + WS_MODP) + ((size_t)(ks * 2 + l) * 12288 + 4 * c4)) = a0 + a1; } }
    weight_transposes(p, lds, tid_in, 0, 1, (int)blockIdx.x * 8 + wave, (int)gridDim.x * 8);
}
__device__ __forceinline__ void weight_transposes(const Params& p, LAS unsigned char* lds, const int tid_in, const int l, const int mask, const int gwv, const int NGW) {
    const int lane = tid_in & 63, wave = tid_in >> 6;
    LAS float* scr = (LAS float*)(lds + wave * 8448);
    constexpr int I_IN = 32 * 232, I_OUT = 32 * 64, I_UP = 32 * 352, I_DN = 88 * 64;
    const int n_in = (mask & 1) ? I_IN : 0, n_out = (mask & 2) ? I_OUT : 0, n_up = (mask & 4) ? I_UP : 0, n_dn = (mask & 8) ? I_DN : 0;
    GAS unsigned char* wl = p.ws + WS_W + (size_t)l * W_LAYER;
    for (int it = gwv; it < n_in + n_out + n_up + n_dn; it += NGW) {
        int r = it;
        if (r < n_in) { const int kb = r / 232, nb = r % 232, nd = 32 * nb; int ns, nv;
            if (nd < 4096) { ns = nd; nv = 32; } else if (nd < 7168) { ns = nd + 16; nv = 32; } else if (nd == 7168) { ns = 4096; nv = 16; } else { ns = 0; nv = 0; }
            transpose_item(p.w_in + (size_t)l * D_ * DIN, D_, DIN, (bf16_t*)(wl + W_IN_OFF), 64 * kb, nd, ns, nv, scr, lane); continue; }
        r -= n_in;
        if (r < n_out) { const int kb = r / 64, nb = r % 64; transpose_item(p.w_out + (size_t)l * D_ * D_, D_, D_, (bf16_t*)(wl + W_OUT_OFF), 64 * kb, 32 * nb, 32 * nb, 32, scr, lane); continue; }
        r -= n_out;
        if (r < n_up) { const int kb = r / 352, nb = r % 352, nd = 32 * nb, pn = nd >> 8, x0 = nd & 255;
            transpose_item(p.w_up + (size_t)l * D_ * NUP, D_, NUP, (bf16_t*)(wl + W_UP_OFF), 64 * kb, nd, (x0 < 128) ? 128 * pn + x0 : DFF + 128 * pn + (x0 - 128), 32, scr, lane); continue; }
        r -= n_up;
        { const int kb = r / 64, nb = r % 64; transpose_item(p.w_down + (size_t)l * DFF * D_, DFF, D_, (bf16_t*)(wl + W_DN_OFF), 64 * kb, 32 * nb, 32 * nb, 32, scr, lane); }
    }
}

__device__ __forceinline__ float mod_from_partials(const Params& p, int l, int j) {
    const float* mp = (const float*)(p.ws + WS_MODP);
    float v = p.b_ada[l * 12288 + j];
#pragma unroll
    for (int ks = 0; ks < KS_MOD; ++ks) v += mp[(size_t)(ks * 2 + l) * 12288 + j];
    return v;
}
__device__ __forceinline__ void norm_phase(const Params& p, LAS unsigned char* lds, const float* xin, const float* normw, int l, int off_shift, int off_scale, bool from_partials, const int tid_in) {
    const int tid = tid_in, lane = tid & 63, wave = tid >> 6;
    LAS float* cA = (LAS float*)lds; LAS float* cB = cA + D_;
    float* modf = (float*)(p.ws + WS_MODF);
    if (from_partials) {
        for (int idx = (int)blockIdx.x * 512 + tid; idx < 2 * 12288; idx += (int)gridDim.x * 512) modf[idx] = mod_from_partials(p, idx / 12288, idx % 12288);
        for (int j = tid; j < D_; j += 512) { const float sh = mod_from_partials(p, l, off_shift + j), scv = mod_from_partials(p, l, off_scale + j);
            cA[j] = normw[j] * (1.f + scv); cB[j] = sh; }
    } else {
        for (int j = tid; j < D_; j += 512) { cA[j] = normw[j] * (1.f + modf[l * 12288 + off_scale + j]); cB[j] = modf[l * 12288 + off_shift + j]; }
    }
    __syncthreads();
    f32x4 a[8], b[8];
#pragma unroll
    for (int j = 0; j < 8; ++j) { a[j] = *(const LAS f32x4*)(cA + 4 * lane + 256 * j); b[j] = *(const LAS f32x4*)(cB + 4 * lane + 256 * j); }
    bf16_t* H = (bf16_t*)(p.ws + WS_H);
    for (int m = (int)blockIdx.x * 8 + wave; m < T_; m += (int)gridDim.x * 8) {
        const f32x4* xr = (const f32x4*)(xin + (size_t)m * D_) + lane;
        f32x4 v[8]; float s = 0.f;
#pragma unroll
        for (int j = 0; j < 8; ++j) { v[j] = xr[64 * j]; s += (v[j].x * v[j].x + v[j].y * v[j].y) + (v[j].z * v[j].z + v[j].w * v[j].w); }
        const float rstd = rsqrtf(wave_sum(s) * (1.f / D_) + EPS_);
        u32x2* o8 = (u32x2*)(H + (size_t)m * D_) + lane;
#pragma unroll
        for (int j = 0; j < 8; ++j) { const f32x4 y = v[j] * rstd * a[j] + b[j]; u32x2 w; w.x = pk2(y.x, y.y); w.y = pk2(y.z, y.w); o8[64 * j] = w; }
    }
}


__device__ __forceinline__ void win_small_cols(const Params& p, LAS unsigned char* lds, int l, const int tid_in) {
    const int lane = tid_in & 63, wave = tid_in >> 6, r16 = lane & 15, q4 = lane >> 4;
    const int tw = wave & 3, kh = wave >> 2;
    const int m0 = ((int)blockIdx.x * 4 + tw) * 16;
    const bf16_t* H = (const bf16_t*)(p.ws + WS_H) + (size_t)(m0 + r16) * D_ + 8 * q4 + 1024 * kh;
    const bf16_t* Wt = (const bf16_t*)(p.ws + WS_W + (size_t)l * W_LAYER + W_IN_OFF) + (size_t)(7168 + r16) * D_ + 8 * q4 + 1024 * kh;
    f32x4 acc0 = {0.f, 0.f, 0.f, 0.f}, acc1 = acc0;
#pragma unroll 8
    for (int s = 0; s < 32; s += 2) {
        const bf16x8 a0 = *(const bf16x8*)(H + 32 * s), b0 = *(const bf16x8*)(Wt + 32 * s), a1 = *(const bf16x8*)(H + 32 * s + 32), b1 = *(const bf16x8*)(Wt + 32 * s + 32);
        acc0 = MFMA16(a0, b0, acc0); acc1 = MFMA16(a1, b1, acc1); }
    acc0 += acc1;
    LAS f32x4* xch = (LAS f32x4*)lds;
    if (kh) xch[tw * 64 + lane] = acc0;
    __syncthreads();
    if (!kh) { acc0 += xch[tw * 64 + lane];
        bf16_t* proj = (bf16_t*)(p.ws + WS_PROJ);
#pragma unroll
        for (int rg = 0; rg < 4; ++rg) proj[(size_t)(m0 + 4 * q4 + rg) * NIN + 7168 + r16] = (bf16_t)(pk2(acc0[rg], 0.f) & 0xffffu); }
    __syncthreads();
}

__device__ __forceinline__ void gdn_prep_phase(const Params& p, LAS unsigned char* lds, int l, const int tid_in) {
    const int tid0 = tid_in, wave = __builtin_amdgcn_readfirstlane(tid0 >> 6);
    LAS float* Lslot = (LAS float*)lds;
    LAS bf16_t* Qn = (LAS bf16_t*)(lds + 65536); LAS bf16_t* Kn = (LAS bf16_t*)(lds + 82944); LAS bf16_t* KdTs = (LAS bf16_t*)(lds + 100352);
    LAS float* betaS = (LAS float*)(lds + 118784); LAS float* gcS = (LAS float*)(lds + 120832);
    LAS bf16_t* VbT = (LAS bf16_t*)(lds + 65536); LAS bf16_t* KbgT = (LAS bf16_t*)(lds + 82944);
    const bf16_t* proj = (const bf16_t*)(p.ws + WS_PROJ);
    bf16_t* Wg = (bf16_t*)(p.ws + WS_GDN); bf16_t* UTg = (bf16_t*)(p.ws + WS_GDN + 32 * MiB); bf16_t* KdTg = (bf16_t*)(p.ws + WS_GDN + 64 * MiB);
    bf16_t* Qgg = (bf16_t*)(p.ws + WS_GDN + 96 * MiB); bf16_t* Ag = (bf16_t*)(p.ws + WS_GDN + 128 * MiB);
    float* egl = (float*)(p.ws + WS_EGL);
    const float* convw = p.conv_qkv + (size_t)l * 4 * 3072;
    { int tid = tid0; asm volatile("" : "+v"(tid));
      const int kk = tid >> 6, row = tid & 63;
      const int I = (int)blockIdx.x * 8 + kk, h = I >> 8, c = I & 255; const size_t t = (size_t)64 * c + row;
      const float braw = bf2f(proj[t * NIN + PBETA + h]), araw = bf2f(proj[t * NIN + PALPHA + h]);
      betaS[kk * 64 + row] = 1.f / (1.f + __expf(-braw));
      float g = -__expf(p.a_log[l * NH + h]) * softplus_f(araw + p.dt_bias[l * NH + h]);
#pragma unroll
      for (int o = 1; o < 64; o <<= 1) { const float u = __shfl_up(g, o); if (row >= o) g += u; }
      gcS[kk * 64 + row] = g; if (row == 63) egl[I] = __expf(g);
      __syncthreads(); }
#pragma unroll 1
    for (int batch = 0; batch < 2; ++batch) {
        u32x4 raw[3][4][2];
#define PREP_LOADRAW(kq) do { const int I_ = (int)blockIdx.x * 8 + batch * 4 + (kq), h_ = I_ >> 8, c_ = I_ & 255; \
            _Pragma("unroll") for (int X = 0; X < 3; ++X) _Pragma("unroll") for (int r = 0; r < 4; ++r) { int tt_ = 64 * c_ + (tid0 >> 3) - 3 + r; tt_ = tt_ < 0 ? 0 : tt_; \
                const u32x4* pp_ = (const u32x4*)(proj + (size_t)tt_ * NIN + X * 1024 + h_ * 128 + 16 * (tid0 & 7)); raw[X][r][0] = pp_[0]; raw[X][r][1] = pp_[1]; } } while (0)
        PREP_LOADRAW(0);
#pragma unroll 1
        for (int k = 0; k < 4; ++k) {
            int tid = tid0; asm volatile("" : "+v"(tid));
            const int lane = tid & 63, r16 = lane & 15, q4 = lane >> 4, i = tid >> 3, sub = tid & 7;
            const int I = (int)blockIdx.x * 8 + batch * 4 + k, h = I >> 8, c = I & 255, t = 64 * c + i;
            const float gci = gcS[(batch * 4 + k) * 64 + i], glast = gcS[(batch * 4 + k) * 64 + 63];
#pragma unroll
            for (int X = 0; X < 3; ++X) {
                const int col = X * 1024 + h * 128 + 16 * sub;
                float y[16];
#pragma unroll
                for (int e = 0; e < 16; ++e) y[e] = 0.f;
#pragma unroll
                for (int r = 0; r < 4; ++r) { const int tt = t - 3 + r;
                    if (tt >= 0) { float xv[16]; unpack8(raw[X][r][0], xv); unpack8(raw[X][r][1], xv + 8);
                        const f32x4* wp = (const f32x4*)(convw + r * 3072 + col);
#pragma unroll
                        for (int e4 = 0; e4 < 4; ++e4) { const f32x4 w = wp[e4]; y[4 * e4] += w.x * xv[4 * e4]; y[4 * e4 + 1] += w.y * xv[4 * e4 + 1]; y[4 * e4 + 2] += w.z * xv[4 * e4 + 2]; y[4 * e4 + 3] += w.w * xv[4 * e4 + 3]; } } }
                float ss = 0.f;
#pragma unroll
                for (int e = 0; e < 16; ++e) { y[e] = silu_f(y[e]); ss += y[e] * y[e]; }
                if (X < 2) { ss += __shfl_xor(ss, 1); ss += __shfl_xor(ss, 2); ss += __shfl_xor(ss, 4);
                    const float scl = rsqrtf(ss + EPS_) * (X == 0 ? 0.08838834764831845f : 1.f);
#pragma unroll
                    for (int e = 0; e < 16; ++e) y[e] *= scl; }
                if (X == 0) { *(LAS u32x4*)(Qn + i * 136 + 16 * sub) = pack8(y); *(LAS u32x4*)(Qn + i * 136 + 16 * sub + 8) = pack8(y + 8);
                    const float eg = __expf(gci); float z[16];
#pragma unroll
                    for (int e = 0; e < 16; ++e) z[e] = y[e] * eg;
                    { const int c8a = 2 * sub, c8b = 2 * sub + 1;
                      *(u32x4*)(Qgg + (size_t)I * 8192 + ((((i >> 4) * 4 + (c8a >> 2)) * 64 + (c8a & 3) * 16 + (i & 15)) * 8)) = pack8(z);
                      *(u32x4*)(Qgg + (size_t)I * 8192 + ((((i >> 4) * 4 + (c8b >> 2)) * 64 + (c8b & 3) * 16 + (i & 15)) * 8)) = pack8(z + 8); }
                } else if (X == 1) { const u32x4 k0 = pack8(y), k1 = pack8(y + 8);
                    *(LAS u32x4*)(Kn + i * 136 + 16 * sub) = k0; *(LAS u32x4*)(Kn + i * 136 + 16 * sub + 8) = k1;
                    u32x4* dst = (u32x4*)(Wg + ((size_t)I * 64 + i) * 128 + 16 * sub); dst[0] = k0; dst[1] = k1;
                    const float ed = __expf(glast - gci);
#pragma unroll
                    for (int e = 0; e < 16; e += 2) { const unsigned w = pk2(y[e] * ed, y[e + 1] * ed); KdTs[(16 * sub + e) * 72 + i] = (bf16_t)(w & 0xffffu); KdTs[(16 * sub + e + 1) * 72 + i] = (bf16_t)(w >> 16); }
                } else { u32x4* dst = (u32x4*)(UTg + ((size_t)I * 64 + i) * 128 + 16 * sub); dst[0] = pack8(y); dst[1] = pack8(y + 8); }
            }
            __syncthreads();
            if (k < 3) PREP_LOADRAW(k + 1);
#pragma unroll
            for (int u = 0; u < 2; ++u) { const int ch = tid + 512 * u, d = ch >> 3, part = ch & 7;
                *(u32x4*)(KdTg + (size_t)I * 8192 + ((((d >> 4) * 2 + (part >> 2)) * 64 + (part & 3) * 16 + (d & 15)) * 8)) = *(const LAS u32x4*)(KdTs + d * 72 + 8 * part); }
            { const int pr = wave >> 2, ti = wave & 3;
              for (int tj = 0; tj < 4; ++tj) {
                  f32x4 acc = {0.f, 0.f, 0.f, 0.f};
                  if (tj <= ti) {
#pragma unroll
                      for (int s = 0; s < 4; ++s) {
                          if (pr == 0) { const bf16x8 a = *(const LAS bf16x8*)(Kn + (16 * ti + r16) * 136 + 32 * s + 8 * q4), b = *(const LAS bf16x8*)(Kn + (16 * tj + r16) * 136 + 32 * s + 8 * q4); acc = MFMA16(a, b, acc); }
                          else { const bf16x8 a = *(const LAS bf16x8*)(Kn + (16 * tj + r16) * 136 + 32 * s + 8 * q4), b = *(const LAS bf16x8*)(Qn + (16 * ti + r16) * 136 + 32 * s + 8 * q4); acc = MFMA16(a, b, acc); }
                      }
                  }
                  if (pr == 0) {
                      if (tj <= ti) { const int jj = 16 * tj + r16; const float gj = gcS[(batch * 4 + k) * 64 + jj];
#pragma unroll
                          for (int rg = 0; rg < 4; ++rg) { const int ii = 16 * ti + 4 * q4 + rg; const float v = (ii > jj) ? betaS[(batch * 4 + k) * 64 + ii] * acc[rg] * __expf(gcS[(batch * 4 + k) * 64 + ii] - gj) : 0.f;
                              Lslot[k * 4096 + ii * 64 + jj] = v; } }
                  } else {
                      const int ii = 16 * ti + r16; const float gi = gcS[(batch * 4 + k) * 64 + ii]; float o[4];
#pragma unroll
                      for (int rg = 0; rg < 4; ++rg) { const int jj = 16 * tj + 4 * q4 + rg; o[rg] = (tj <= ti && ii >= jj) ? acc[rg] * __expf(gi - gcS[(batch * 4 + k) * 64 + jj]) : 0.f; }
                      u32x2 w; w.x = pk2(o[0], o[1]); w.y = pk2(o[2], o[3]);
                      *(u32x2*)(Ag + (size_t)I * 4096 + (((ti * 2 + (tj >> 1)) * 64 + ((2 * tj + (q4 >> 1)) & 3) * 16 + r16) * 8) + 4 * (q4 & 1)) = w;
                  }
              } }
            __syncthreads();
        }
        if (wave < 4) {
            const int lane = tid0 & 63;
            LAS float* L = Lslot + wave * 4096; float tc[64];
#pragma unroll
            for (int ii = 0; ii < 64; ++ii) { float a = (lane == ii) ? 1.f : 0.f;
#pragma unroll
                for (int jj = 0; jj < ii; ++jj) a -= L[ii * 64 + jj] * tc[jj];
                tc[ii] = a;
                if ((ii & 3) == 3) asm volatile("" ::: "memory"); }
            LDS_WAIT();
#pragma unroll
            for (int ii = 0; ii < 64; ++ii) L[ii * 64 + lane] = tc[ii];
        }
        __syncthreads();
#pragma unroll 1
        for (int k = 0; k < 4; ++k) {
            int tid = tid0; asm volatile("" : "+v"(tid));
            const int lane = tid & 63, r16 = lane & 15, q4 = lane >> 4, i = tid >> 3, sub = tid & 7;
            const int I = (int)blockIdx.x * 8 + batch * 4 + k;
            { const float be = betaS[(batch * 4 + k) * 64 + i], beg = be * __expf(gcS[(batch * 4 + k) * 64 + i]);
              const u32x4* pk = (const u32x4*)(Wg + ((size_t)I * 64 + i) * 128 + 16 * sub); const u32x4* pv = (const u32x4*)(UTg + ((size_t)I * 64 + i) * 128 + 16 * sub);
              float kv[16], vv[16]; unpack8(pk[0], kv); unpack8(pk[1], kv + 8); unpack8(pv[0], vv); unpack8(pv[1], vv + 8);
#pragma unroll
              for (int e = 0; e < 16; ++e) { vv[e] *= be; kv[e] *= beg; }
              *(LAS u32x4*)(VbT + i * 136 + 16 * sub) = pack8(vv); *(LAS u32x4*)(VbT + i * 136 + 16 * sub + 8) = pack8(vv + 8);
              *(LAS u32x4*)(KbgT + i * 136 + 16 * sub) = pack8(kv); *(LAS u32x4*)(KbgT + i * 136 + 16 * sub + 8) = pack8(kv + 8); }
            __syncthreads();
            { const int pr = wave >> 2, ti = wave & 3; bf16x8 aT[2];
#pragma unroll
              for (int s = 0; s < 2; ++s) { const LAS float* tp = Lslot + k * 4096 + (16 * ti + r16) * 64 + 32 * s + 8 * q4; const f32x4 t0 = *(const LAS f32x4*)tp, t1 = *(const LAS f32x4*)(tp + 4);
                  u32x4 w; w.x = pk2(t0.x, t0.y); w.y = pk2(t0.z, t0.w); w.z = pk2(t1.x, t1.y); w.w = pk2(t1.z, t1.w); aT[s] = as_bf8(w); }
#pragma unroll 2
              for (int tn = 0; tn < 8; ++tn) { f32x4 acc = {0.f, 0.f, 0.f, 0.f};
                  if (pr == 0) {
#pragma unroll
                      for (int s = 0; s < 2; ++s) { const LAS bf16_t* bp = VbT + (32 * s + 8 * q4 + (r16 >> 2)) * 136 + 16 * tn + 4 * (r16 & 3);
                          const s16x4 t0 = __builtin_amdgcn_ds_read_tr16_b64_v4i16((LAS s16x4*)bp), t1 = __builtin_amdgcn_ds_read_tr16_b64_v4i16((LAS s16x4*)(bp + 4 * 136));
                          const bf16x8 b = {t0[0], t0[1], t0[2], t0[3], t1[0], t1[1], t1[2], t1[3]}; acc = MFMA16(aT[s], b, acc); }
                      u32x2 w; w.x = pk2(acc[0], acc[1]); w.y = pk2(acc[2], acc[3]);
                      *(u32x2*)(UTg + (size_t)I * 8192 + (((tn * 4 + ti) * 64 + lane) * 4)) = w;
                  } else {
#pragma unroll
                      for (int s = 0; s < 2; ++s) { const LAS bf16_t* bp = KbgT + (32 * s + 8 * q4 + (r16 >> 2)) * 136 + 16 * tn + 4 * (r16 & 3);
                          const s16x4 t0 = __builtin_amdgcn_ds_read_tr16_b64_v4i16((LAS s16x4*)bp), t1 = __builtin_amdgcn_ds_read_tr16_b64_v4i16((LAS s16x4*)(bp + 4 * 136));
                          const bf16x8 b = {t0[0], t0[1], t0[2], t0[3], t1[0], t1[1], t1[2], t1[3]}; acc = MFMA16(b, aT[s], acc); }
                      u32x2 w; w.x = pk2(acc[0], acc[1]); w.y = pk2(acc[2], acc[3]);
                      *(u32x2*)(Wg + (size_t)I * 8192 + (((ti * 4 + (tn >> 1)) * 64 + ((2 * tn + (q4 >> 1)) & 3) * 16 + r16) * 8) + 4 * (q4 & 1)) = w;
                  } } }
            __syncthreads();
        }
    }
}

struct ScanBuf { bf16x8 a4[4]; bf16x8 a2[2]; bf16x8 kd[2]; u32x2 u[2]; float eg; };
template <int ROLE, int HOT>
__device__ __forceinline__ void scan_loop(const Params& p, LAS bf16_t* ST, LAS bf16_t* VT, int h, int vs, int wave, int lane) {
    const int r16 = lane & 15, q4 = lane >> 4, tm = wave & 3;
    const bf16_t* Wg = (const bf16_t*)(p.ws + WS_GDN); const bf16_t* UTg = (const bf16_t*)(p.ws + WS_GDN + 32 * MiB); const bf16_t* KdTg = (const bf16_t*)(p.ws + WS_GDN + 64 * MiB);
    const bf16_t* Qgg = (const bf16_t*)(p.ws + WS_GDN + 96 * MiB); const bf16_t* Ag = (const bf16_t*)(p.ws + WS_GDN + 128 * MiB);
    const float* egl = (const float*)(p.ws + WS_EGL);
    bf16_t* ocat = (bf16_t*)(p.ws + (HOT ? WS_H : WS_OCAT));
    const bf16_t* p4 = ROLE ? Qgg : Wg;
    f32x4 accS[2] = {{0.f, 0.f, 0.f, 0.f}, {0.f, 0.f, 0.f, 0.f}};
    ScanBuf B[4];
#define SCAN_LOAD(buf, cc) do { const size_t I_ = (size_t)h * 256 + (HOT ? ((cc) & 3) : (cc)); \
        _Pragma("unroll") for (int s = 0; s < 4; ++s) (buf).a4[s] = *(const bf16x8*)(p4 + I_ * 8192 + ((tm * 4 + s) * 64 + lane) * 8); \
        _Pragma("unroll") for (int s = 0; s < 2; ++s) (buf).kd[s] = *(const bf16x8*)(KdTg + I_ * 8192 + ((wave * 2 + s) * 64 + lane) * 8); \
        if (ROLE) { _Pragma("unroll") for (int s = 0; s < 2; ++s) (buf).a2[s] = *(const bf16x8*)(Ag + I_ * 4096 + ((tm * 2 + s) * 64 + lane) * 8); } \
        else { _Pragma("unroll") for (int tn = 0; tn < 2; ++tn) (buf).u[tn] = *(const u32x2*)(UTg + I_ * 8192 + (((vs * 2 + tn) * 4 + tm) * 64 + lane) * 4); } \
        (buf).eg = egl[I_]; } while (0)
#pragma unroll
    for (int u = 0; u < 4; ++u) SCAN_LOAD(B[u], u);
    for (int c0 = 0; c0 < 256; c0 += 4) {
#pragma unroll
        for (int u = 0; u < 4; ++u) {
            const int c = c0 + u, pb = u & 1;
            const LAS bf16_t* STc = ST + pb * (32 * 136); LAS bf16_t* STn = ST + (pb ^ 1) * (32 * 136);
            if (ROLE == 0) asm volatile("" : "+v"(B[u].u[0].x), "+v"(B[u].u[0].y), "+v"(B[u].u[1].x), "+v"(B[u].u[1].y), "+v"(B[u].eg));
            else asm volatile("" : "+v"(B[u].eg));
            bf16x8 sf[2][4];
#pragma unroll
            for (int tn = 0; tn < 2; ++tn)
#pragma unroll
                for (int s = 0; s < 4; ++s) sf[tn][s] = *(const LAS bf16x8*)(STc + (16 * tn + r16) * 136 + 32 * s + 8 * q4);
            f32x4 o[2] = {{0.f, 0.f, 0.f, 0.f}, {0.f, 0.f, 0.f, 0.f}};
            if (ROLE == 0) {
#pragma unroll
                for (int tn = 0; tn < 2; ++tn) { f32x4 t1 = {0.f, 0.f, 0.f, 0.f};
#pragma unroll
                    for (int s = 0; s < 4; ++s) t1 = MFMA16(B[u].a4[s], sf[tn][s], t1);
                    const float v0 = bflo(B[u].u[tn].x) - t1[0], v1 = bfhi(B[u].u[tn].x) - t1[1], v2 = bflo(B[u].u[tn].y) - t1[2], v3 = bfhi(B[u].u[tn].y) - t1[3];
                    u32x2 w; w.x = pk2(v0, v1); w.y = pk2(v2, v3);
                    *(LAS u32x2*)(VT + (16 * tn + r16) * 72 + 16 * tm + 4 * q4) = w; }
            } else {
#pragma unroll
                for (int tn = 0; tn < 2; ++tn)
#pragma unroll
                    for (int s = 0; s < 4; ++s) o[tn] = MFMA16(sf[tn][s], B[u].a4[s], o[tn]);
            }
            accS[0] *= B[u].eg; accS[1] *= B[u].eg;
            LDS_WAIT(); __builtin_amdgcn_s_barrier(); asm volatile("" ::: "memory");
            bf16x8 vf[2][2];
#pragma unroll
            for (int tn = 0; tn < 2; ++tn)
#pragma unroll
                for (int s = 0; s < 2; ++s) vf[tn][s] = *(const LAS bf16x8*)(VT + (16 * tn + r16) * 72 + 32 * s + 8 * q4);
#pragma unroll
            for (int tn = 0; tn < 2; ++tn) {
#pragma unroll
                for (int s = 0; s < 2; ++s) accS[tn] = MFMA16(B[u].kd[s], vf[tn][s], accS[tn]);
                u32x2 w; w.x = pk2(accS[tn][0], accS[tn][1]); w.y = pk2(accS[tn][2], accS[tn][3]);
                *(LAS u32x2*)(STn + (16 * tn + r16) * 136 + 16 * wave + 4 * q4) = w; }
            if (ROLE) {
#pragma unroll
                for (int tn = 0; tn < 2; ++tn) {
#pragma unroll
                    for (int s = 0; s < 2; ++s) o[tn] = MFMA16(vf[tn][s], B[u].a2[s], o[tn]);
                    u32x2 w; w.x = pk2(o[tn][0], o[tn][1]); w.y = pk2(o[tn][2], o[tn][3]);
                    if (HOT < 2) *(u32x2*)(ocat + (size_t)(64 * c + 16 * tm + r16) * D_ + h * 128 + vs * 32 + 16 * tn + 4 * q4) = w; else asm volatile("" :: "v"(w.x), "v"(w.y)); }
            }
            { const int cn = (c + 4 < 256) ? c + 4 : 255; SCAN_LOAD(B[u], cn); }
            LDS_WAIT(); __builtin_amdgcn_s_barrier(); asm volatile("" ::: "memory");
        }
    }
#undef SCAN_LOAD
}
template <int HOT>
__device__ __forceinline__ void scan_phase(const Params& p, LAS unsigned char* lds, const int tid_in) {
    const int tid = tid_in, lane = tid & 63, wave = __builtin_amdgcn_readfirstlane(tid >> 6);
    const int h = (int)blockIdx.x & 7, vs = (int)blockIdx.x >> 3;
    LAS bf16_t* ST = (LAS bf16_t*)lds;
    LAS bf16_t* VT = (LAS bf16_t*)(lds + 17408);
    for (int u = tid; u < 2 * 32 * 136 / 2; u += 512) ((LAS unsigned*)ST)[u] = 0u;
    __syncthreads();
    if (wave < 4) scan_loop<0, HOT>(p, ST, VT, h, vs, wave, lane); else scan_loop<1, HOT>(p, ST, VT, h, vs, wave, lane);
    __syncthreads();
}


__device__ __forceinline__ void sb_attn_phase(const Params& p, LAS unsigned char* lds, int l, int first_blk, int nblk, const int tid_in) {
    const int tid = tid_in, lane = tid & 63, wave = __builtin_amdgcn_readfirstlane(tid >> 6);
    const int r16 = lane & 15, q4 = lane >> 4;
    LAS bf16_t* Qs = (LAS bf16_t*)lds; LAS bf16_t* Ks = (LAS bf16_t*)(lds + 34816); LAS bf16_t* Vs = (LAS bf16_t*)(lds + 52224);
    LAS float* Z = (LAS float*)(lds + 70656); LAS bf16_t* As = (LAS bf16_t*)(lds + 103936); LAS float* SegTot = (LAS float*)(lds + 122368);
    const bf16_t* proj = (const bf16_t*)(p.ws + WS_PROJ);
    bf16_t* ocat = (bf16_t*)(p.ws + WS_OCAT);
    const float* gq = p.sbq + l * 128; const float* gk = p.sbk + l * 128;
    const int q = tid & 127, seg = tid >> 7;
    for (int item = (int)blockIdx.x - first_blk; item < 1024; item += nblk) {
        const int h = item & 7, qb = 127 - (item >> 3);
#pragma unroll
        for (int u = 0; u < 4; ++u) { const int ch = tid + 512 * u, row = ch >> 4, c8 = ch & 15;
            float xv[8]; unpack8(*(const u32x4*)(proj + (size_t)(128 * qb + row) * NIN + PQ_B + h * 128 + 8 * c8), xv);
            float ss = 0.f;
#pragma unroll
            for (int e = 0; e < 8; ++e) ss += xv[e] * xv[e];
            ss += __shfl_xor(ss, 1); ss += __shfl_xor(ss, 2); ss += __shfl_xor(ss, 4); ss += __shfl_xor(ss, 8);
            const float sc = rsqrtf(ss * (1.f / 128.f) + EPS_) * 0.08838834764831845f;
#pragma unroll
            for (int e = 0; e < 8; ++e) xv[e] *= sc * gq[8 * c8 + e];
            *(LAS u32x4*)(Qs + row * 136 + 8 * c8) = pack8(xv); }
        f32x4 oacc[8];
#pragma unroll
        for (int tn = 0; tn < 8; ++tn) oacc[tn] = (f32x4){0.f, 0.f, 0.f, 0.f};
        float Rq = 0.f;
        const int tq = 128 * qb + q;
        u32x4 kreg[2], vreg[2];
#pragma unroll
        for (int u = 0; u < 2; ++u) { const int ch = tid + 512 * u, row = ch >> 4, c8 = ch & 15; const size_t rb = (size_t)(64 * (2 * qb + 1) + row) * NIN + h * 128 + 8 * c8;
            kreg[u] = *(const u32x4*)(proj + rb + PK_B); vreg[u] = *(const u32x4*)(proj + rb + PV_B); }
        for (int j = 2 * qb + 1; j >= 0; --j) {
#pragma unroll
            for (int u = 0; u < 2; ++u) { const int ch = tid + 512 * u, row = ch >> 4, c8 = ch & 15;
                float xv[8]; unpack8(kreg[u], xv);
                float ss = 0.f;
#pragma unroll
                for (int e = 0; e < 8; ++e) ss += xv[e] * xv[e];
                ss += __shfl_xor(ss, 1); ss += __shfl_xor(ss, 2); ss += __shfl_xor(ss, 4); ss += __shfl_xor(ss, 8);
                const float sc = rsqrtf(ss * (1.f / 128.f) + EPS_);
#pragma unroll
                for (int e = 0; e < 8; ++e) xv[e] *= sc * gk[8 * c8 + e];
                *(LAS u32x4*)(Ks + row * 136 + 8 * c8) = pack8(xv);
                *(LAS u32x4*)(Vs + row * 136 + 8 * c8) = vreg[u]; }
            { const int jn = j > 0 ? j - 1 : 0;
#pragma unroll
              for (int u = 0; u < 2; ++u) { const int ch = tid + 512 * u, row = ch >> 4, c8 = ch & 15; const size_t rb = (size_t)(64 * jn + row) * NIN + h * 128 + 8 * c8;
                  kreg[u] = *(const u32x4*)(proj + rb + PK_B); vreg[u] = *(const u32x4*)(proj + rb + PV_B); } }
            __syncthreads();
            { bf16x8 qf[4];
#pragma unroll
              for (int s = 0; s < 4; ++s) qf[s] = *(const LAS bf16x8*)(Qs + (16 * wave + r16) * 136 + 32 * s + 8 * q4);
#pragma unroll
              for (int tn = 0; tn < 4; ++tn) { f32x4 acc = {0.f, 0.f, 0.f, 0.f};
#pragma unroll
                  for (int s = 0; s < 4; ++s) { const bf16x8 kf = *(const LAS bf16x8*)(Ks + (16 * tn + r16) * 136 + 32 * s + 8 * q4); acc = MFMA16(qf[s], kf, acc); }
#pragma unroll
                  for (int rg = 0; rg < 4; ++rg) Z[(16 * wave + 4 * q4 + rg) * 65 + 16 * tn + r16] = acc[rg]; } }
            __syncthreads();
            float zz[16], ls[16], suf[16]; const int s0 = 64 * j + 16 * seg;
#pragma unroll
            for (int e = 0; e < 16; ++e) { zz[e] = Z[q * 65 + 16 * seg + e]; ls[e] = (s0 + e < tq) ? -softplus_fast(zz[e]) : 0.f; }
            float run = 0.f;
#pragma unroll
            for (int e = 15; e >= 0; --e) { suf[e] = run; run += ls[e]; }
            SegTot[seg * 128 + q] = run;
            __syncthreads();
            float hi = 0.f, all = 0.f;
#pragma unroll
            for (int sg = 0; sg < 4; ++sg) { const float tv = SegTot[sg * 128 + q]; all += tv; if (sg > seg) hi += tv; }
            const float base = Rq + hi; float av[16];
#pragma unroll
            for (int e = 0; e < 16; ++e) av[e] = (s0 + e < tq) ? __expf(zz[e] + ls[e] + base + suf[e]) : 0.f;
            Rq += all;
            *(LAS u32x4*)(As + q * 72 + 16 * seg) = pack8(av); *(LAS u32x4*)(As + q * 72 + 16 * seg + 8) = pack8(av + 8);
            __syncthreads();
            { bf16x8 af[2];
#pragma unroll
              for (int s = 0; s < 2; ++s) af[s] = *(const LAS bf16x8*)(As + (16 * wave + r16) * 72 + 32 * s + 8 * q4);
#pragma unroll
              for (int tn = 0; tn < 8; ++tn)
#pragma unroll
                  for (int s = 0; s < 2; ++s) {
                      const LAS bf16_t* vp = Vs + (32 * s + 8 * q4 + (r16 >> 2)) * 136 + 16 * tn + 4 * (r16 & 3);
                      const s16x4 t0 = __builtin_amdgcn_ds_read_tr16_b64_v4i16((LAS s16x4*)vp), t1 = __builtin_amdgcn_ds_read_tr16_b64_v4i16((LAS s16x4*)(vp + 4 * 136));
                      const bf16x8 vf = {t0[0], t0[1], t0[2], t0[3], t1[0], t1[1], t1[2], t1[3]};
                      oacc[tn] = MFMA16(vf, af[s], oacc[tn]); } }
            if (!__syncthreads_or(Rq >= -104.f)) break;
        }
        __syncthreads();
#pragma unroll
        for (int tn = 0; tn < 8; ++tn) { u32x2 w; w.x = pk2(oacc[tn][0], oacc[tn][1]); w.y = pk2(oacc[tn][2], oacc[tn][3]);
            *(u32x2*)(ocat + (size_t)(128 * qb + 16 * wave + r16) * D_ + 1024 + h * 128 + 16 * tn + 4 * q4) = w; }
    }
}

__device__ __forceinline__ void gdn_finalize_phase(const Params& p, int l, const int tid_in) {
    const int g = opaque_bid() * 512 + tid_in, l16 = g & 15;
    bf16_t* ocat = (bf16_t*)(p.ws + WS_OCAT); const bf16_t* proj = (const bf16_t*)(p.ws + WS_PROJ);
    float gn[8];
#pragma unroll
    for (int e = 0; e < 8; ++e) gn[e] = p.gdn_norm[l * 128 + 8 * l16 + e];
#pragma unroll 4
    for (int R = g >> 4; R < T_ * NH; R += ((int)gridDim.x * 512) >> 4) {
        const int t = R >> 3, h = R & 7;
        u32x4* op = (u32x4*)(ocat + (size_t)t * D_ + h * 128 + 8 * l16);
        float ov[8], zv[8]; unpack8(*op, ov); unpack8(*(const u32x4*)(proj + (size_t)t * NIN + PZ_A + h * 128 + 8 * l16), zv);
        float ss = 0.f;
#pragma unroll
        for (int e = 0; e < 8; ++e) ss += ov[e] * ov[e];
        ss += __shfl_xor(ss, 1); ss += __shfl_xor(ss, 2); ss += __shfl_xor(ss, 4); ss += __shfl_xor(ss, 8);
        const float rs = rsqrtf(ss * (1.f / 128.f) + EPS_);
#pragma unroll
        for (int e = 0; e < 8; ++e) ov[e] = ov[e] * rs * gn[e] * silu_f(zv[e]);
        *op = pack8(ov);
    }
}

__device__ __forceinline__ void act_fix_rows(const Params& p, int l, const int tid_in, const int pm) {
    bf16_t* V = (bf16_t*)(p.ws + WS_V); const bf16_t* Gh = (const bf16_t*)(p.ws + WS_G); const bf16_t* Gt = (const bf16_t*)(p.ws + WS_G + 8 * MiB); const bf16_t* Vh = (const bf16_t*)(p.ws + WS_G + 16 * MiB);
    const float* cw = p.conv_ffn + (size_t)l * 3 * DFF;
    for (int it = tid_in; it < 8 * 704; it += 512) {
        const int q = it / 704, cc = it % 704, col = 8 * cc, sp = 4 * pm + (q >> 1), rs = q & 1;
        float w0[8], w1[8], w2[8], ga[8], gb[8], gc[8], vv[8], o[8];
#pragma unroll
        for (int e = 0; e < 8; ++e) { w0[e] = cw[col + e]; w1[e] = cw[DFF + col + e]; w2[e] = cw[2 * DFF + col + e]; }
        const int spm = sp > 0 ? sp - 1 : 0;
        const bf16_t* pa = rs ? Gt + (size_t)(spm * 2 + 1) * DFF + col : Gt + (size_t)(spm * 2) * DFF + col;
        const bf16_t* pb = rs ? Gh + (size_t)(sp * 2) * DFF + col : Gt + (size_t)(spm * 2 + 1) * DFF + col;
        const bf16_t* pc = rs ? Gh + (size_t)(sp * 2 + 1) * DFF + col : Gh + (size_t)(sp * 2) * DFF + col;
        unpack8(*(const u32x4*)pa, ga); unpack8(*(const u32x4*)pb, gb); unpack8(*(const u32x4*)pc, gc);
        const float za = (sp > 0) ? 1.f : 0.f, zb = (sp > 0 || rs) ? 1.f : 0.f;
#pragma unroll
        for (int e = 0; e < 8; ++e) { ga[e] *= za; gb[e] *= zb; }
        unpack8(*(const u32x4*)(Vh + (size_t)(sp * 2 + rs) * DFF + col), vv);
#pragma unroll
        for (int e = 0; e < 8; ++e) o[e] = silu_f(w0[e] * ga[e] + w1[e] * gb[e] + w2[e] * gc[e]) * vv[e];
        *(u32x4*)(V + ((size_t)64 * sp + rs) * DFF + col) = pack8(o);
    }
}

__global__ void __launch_bounds__(512) fwd_megakernel(Params p) {
    extern __shared__ __attribute__((aligned(16))) unsigned char lds_raw[];
    LAS unsigned char* lds = (LAS unsigned char*)lds_raw;
    cg::grid_group grid = cg::this_grid();
    const int wave_sg = __builtin_amdgcn_readfirstlane((int)threadIdx.x >> 6);
    if (threadIdx.x < 4) ((volatile LAS unsigned*)(lds + 131072))[threadIdx.x] = 0u;
    __syncthreads();
    (void)xcd_barrier_post((unsigned*)(p.ws + WS_BAR), (volatile LAS unsigned*)(lds + 131072));
    if (p.ph_hi < 0) grid.sync();
#if defined(__HIP_DEVICE_COMPILE__)
#define GRID_BARRIER() xcd_barrier((unsigned*)(((const __attribute__((address_space(4))) Params*)__builtin_amdgcn_kernarg_segment_ptr())->ws + WS_BAR), (volatile LAS unsigned*)(lds + 131072), wave_sg == 0 && lane_id_hw() == 0)
#else
#define GRID_BARRIER() xcd_barrier((unsigned*)(p.ws + WS_BAR), (volatile LAS unsigned*)(lds + 131072), wave_sg == 0 && lane_id_hw() == 0)
#endif
    const int lo = p.ph_lo, hi = p.ph_hi;
    int ph = 0;
#ifndef REP_MASK
#define REP_MASK 0
#endif
#if defined(__HIP_DEVICE_COMPILE__)
#define LOAD_ARGS const __attribute__((address_space(4))) Params* kp_ = (const __attribute__((address_space(4))) Params*)__builtin_amdgcn_kernarg_segment_ptr(); asm volatile("" : "+s"(kp_)); Params pp = *kp_;
#else
#define LOAD_ARGS Params pp = p;
#endif
#define PHASE_BEGIN if (ph >= lo && ph < hi) { const int nrep_ = 1 + ((REP_MASK >> ph) & 1); for (int rep_ = 0; rep_ < nrep_; ++rep_) { if (rep_) GRID_BARRIER(); LOAD_ARGS int ll = l; int tid_ = (wave_sg << 6) | lane_id_hw(); asm volatile("" : "+v"(tid_)); asm volatile("" : "+s"(pp.ws), "+s"(ll)); asm volatile("" : "+s"(pp.out));
#define PHASE_END } } ++ph; if (ph > lo && ph < hi) GRID_BARRIER();
    { const int l = 0; PHASE_BEGIN p0_phase(pp, lds, tid_); PHASE_END }
#ifdef REP_SCAN
#define REP_SCAN_N REP_SCAN
#else
#define REP_SCAN_N 0
#endif
#ifdef REP_ATTN
#define REP_ATTN_N 1
#else
#define REP_ATTN_N 0
#endif
#define LAYER_BODY(l)  \
        PHASE_BEGIN norm_phase(pp, lds, (ll == 0) ? pp.x : (const float*)pp.out, pp.norm1 + ll * D_, ll, 0, 2048, ll == 0, tid_); PHASE_END \
        PHASE_BEGIN { GAS unsigned char* wl = pp.ws + WS_W + (size_t)ll * W_LAYER; \
            win_small_cols(pp, lds, ll, tid_); pg8::Gemm g{(const bf16_t*)(pp.ws + WS_H), (const bf16_t*)(wl + W_IN_OFF), T_, 7168, D_}; pg8::StaticOrder S; S.init(T_, 7168, (int)gridDim.x, (int)blockIdx.x); \
            pg8::EpiBf16 E{(bf16_t*)(pp.ws + WS_PROJ), NIN, 0, 0}; pg8::gemm_phase(lds, g, S, E, tid_); } PHASE_END \
        PHASE_BEGIN gdn_prep_phase(pp, lds, ll, tid_); PHASE_END \
        PHASE_BEGIN if ((int)blockIdx.x < 32) { scan_phase<0>(pp, lds, tid_); \
            if (REP_SCAN_N) { __syncthreads(); scan_phase<(REP_SCAN_N > 0 ? REP_SCAN_N - 1 : 0)>(pp, lds, tid_); } \
            } else { sb_attn_phase(pp, lds, ll, 32, (int)gridDim.x - 32, tid_); \
            if (REP_ATTN_N) { __syncthreads(); sb_attn_phase(pp, lds, ll, 32, (int)gridDim.x - 32, tid_); } \
            { __syncthreads(); const int gw_ = ((int)blockIdx.x - 32) * 8 + (tid_ >> 6), ng_ = ((int)gridDim.x - 32) * 8;        \
              weight_transposes(pp, lds, tid_, l, 2 | 4 | 8, gw_, ng_); if (l == 0) weight_transposes(pp, lds, tid_, 1, 1, gw_, ng_); } \
            } PHASE_END \
        PHASE_BEGIN gdn_finalize_phase(pp, ll, tid_); PHASE_END \
        PHASE_BEGIN { GAS unsigned char* wl = pp.ws + WS_W + (size_t)ll * W_LAYER; const float* modf = (const float*)(pp.ws + WS_MODF) + ll * 12288; \
            pg8::Gemm g{(const bf16_t*)(pp.ws + WS_OCAT), (const bf16_t*)(wl + W_OUT_OFF), T_, D_, D_}; pg8::StaticOrder S; S.init(T_, D_, (int)gridDim.x, (int)blockIdx.x); \
            pg8::EpiRes E{(ll == 0) ? pp.x : (const float*)pp.out, (float*)pp.out, D_, modf + 4096}; pg8::gemm_phase(lds, g, S, E, tid_); } PHASE_END \
        PHASE_BEGIN norm_phase(pp, lds, (const float*)pp.out, pp.norm2 + ll * D_, ll, 6144, 8192, false, tid_); PHASE_END \
        PHASE_BEGIN { GAS unsigned char* wl = pp.ws + WS_W + (size_t)ll * W_LAYER; \
            pg8::Gemm g{(const bf16_t*)(pp.ws + WS_H), (const bf16_t*)(wl + W_UP_OFF), T_, NUP, D_}; pg8::StaticOrder S; S.init(T_, NUP, (int)gridDim.x, (int)blockIdx.x); \
            pg8::EpiAct E{(bf16_t*)(pp.ws + WS_V), (bf16_t*)(pp.ws + WS_G), (bf16_t*)(pp.ws + WS_G + 8 * MiB), (bf16_t*)(pp.ws + WS_G + 16 * MiB), pp.conv_ffn + (size_t)ll * 3 * DFF}; pg8::gemm_phase(lds, g, S, E, tid_); } PHASE_END \
        PHASE_BEGIN { GAS unsigned char* wl = pp.ws + WS_W + (size_t)ll * W_LAYER; const float* modf = (const float*)(pp.ws + WS_MODF) + ll * 12288; \
            pg8::Gemm g{(const bf16_t*)(pp.ws + WS_V), (const bf16_t*)(wl + W_DN_OFF), T_, D_, DFF}; pg8::StaticOrder S; S.init(T_, D_, (int)gridDim.x, (int)blockIdx.x); \
            { pg8::Unit uu_; int last_ = -1; for (int i_ = 0; S.next(i_, uu_); ++i_) if (uu_.pm != last_) { act_fix_rows(pp, ll, tid_, uu_.pm); last_ = uu_.pm; } asm volatile("s_waitcnt vmcnt(0)" ::: "memory"); __syncthreads(); } \
            pg8::EpiRes E{(const float*)pp.out, (float*)pp.out, D_, modf + 10240}; pg8::gemm_phase(lds, g, S, E, tid_); } PHASE_END \

    { const int l = 0; LAYER_BODY(l) }
    { const int l = 1; LAYER_BODY(l) }
#undef LAYER_BODY
#undef PHASE_BEGIN
#undef PHASE_END
#ifdef EXTRA_SYNCS
    for (int e = 0; e < EXTRA_SYNCS; ++e) GRID_BARRIER();
#endif
#ifdef DBG_OFF
    GRID_BARRIER();
    { const bf16_t* src = (const bf16_t*)(p.ws + (size_t)DBG_OFF);
      for (size_t i = (size_t)blockIdx.x * 512 + ((wave_sg << 6) | lane_id_hw()); i < (size_t)T_ * D_; i += (size_t)gridDim.x * 512) p.out[i] = bf2f(src[i]); }
#endif
}

extern "C" void kernel_launch(void* const* d_in, const int* in_sizes, int n_in, void* d_out, int out_size, void* d_ws, size_t ws_size, hipStream_t stream) {
    static int grid = 0;
    if (grid == 0) {
        if (n_in != 17 || ws_size < WS_END) { fprintf(stderr, "kernel_launch: expected 17 inputs and >= %zu bytes of workspace; got %d, %zu\n", (size_t)WS_END, n_in, ws_size); grid = -1; return; }
        int dev = 0, cus = 0, per_cu = 0;
        hipGetDevice(&dev); hipDeviceGetAttribute(&cus, hipDeviceAttributeMultiprocessorCount, dev);
        if (hipFuncSetAttribute((const void*)fwd_megakernel, hipFuncAttributeMaxDynamicSharedMemorySize, LDS_BYTES) != hipSuccess) { fprintf(stderr, "kernel_launch: hipFuncSetAttribute failed\n"); grid = -1; return; }
        hipOccupancyMaxActiveBlocksPerMultiprocessor(&per_cu, (const void*)fwd_megakernel, 512, LDS_BYTES);
        if (per_cu < 1) { fprintf(stderr, "kernel_launch: occupancy query says %d blocks/CU\n", per_cu); per_cu = 1; }
        (void)hipGetLastError();
        grid = cus;
        if (grid > 256) grid = 256;
    }
    if (grid < 0) return;
    Params p{};
    p.x = (const float*)d_in[0]; p.c = (const float*)d_in[1]; p.w_ada = (const float*)d_in[2]; p.b_ada = (const float*)d_in[3]; p.norm1 = (const float*)d_in[4];
    p.w_in = (const float*)d_in[5]; p.conv_qkv = (const float*)d_in[6]; p.a_log = (const float*)d_in[7]; p.dt_bias = (const float*)d_in[8]; p.gdn_norm = (const float*)d_in[9];
    p.sbq = (const float*)d_in[10]; p.sbk = (const float*)d_in[11]; p.w_out = (const float*)d_in[12]; p.norm2 = (const float*)d_in[13]; p.w_up = (const float*)d_in[14];
    p.conv_ffn = (const float*)d_in[15]; p.w_down = (const float*)d_in[16];
    p.out = (GAS float*)d_out; p.ws = (GAS unsigned char*)d_ws; p.ph_lo = 0; p.ph_hi = 19;
#ifdef DBG_HI
    p.ph_hi = DBG_HI;
#endif
    if (hipMemsetAsync((char*)d_ws + WS_BAR, 0, XCD_BAR_WORDS * 4, stream) != hipSuccess) { fprintf(stderr, "kernel_launch: hipMemsetAsync failed\n"); return; }
    void* args[] = {&p};
    hipError_t e = hipLaunchCooperativeKernel((const void*)fwd_megakernel, dim3(grid), dim3(512), args, LDS_BYTES, stream);
    if (e != hipSuccess) fprintf(stderr, "cooperative launch failed: %s (grid %d)\n", hipGetErrorString(e), grid);
}
```

```cpp
#define REP_S1 2
#include <hip/hip_runtime.h>
#include <hip/hip_cooperative_groups.h>
#include <cstdio>
#include <cstdint>
namespace cg = cooperative_groups;

#define LAS __attribute__((address_space(3)))
#define GAS __attribute__((address_space(1)))
typedef unsigned short bf16_t;
typedef short bf16x8 __attribute__((ext_vector_type(8)));
typedef short s16x4 __attribute__((ext_vector_type(4)));
typedef float f32x4 __attribute__((ext_vector_type(4)));
typedef float f32x2 __attribute__((ext_vector_type(2)));
typedef unsigned u32x4 __attribute__((ext_vector_type(4)));
typedef unsigned u32x2 __attribute__((ext_vector_type(2)));

constexpr int T_ = 16384, D_ = 2048, DIN = 7184, NIN = 7424, DFF = 5632, NUP = 11264, NH = 8;
constexpr int PQ_A = 0, PK_A = 1024, PV_A = 2048, PZ_A = 3072, PQ_B = 4096, PK_B = 5120, PV_B = 6144, PBETA = 7168, PALPHA = 7176;
constexpr int KS_MOD = 16;
constexpr float EPS_ = 1e-6f;
constexpr size_t MiB = 1024ull * 1024ull;
constexpr size_t WS_MODF = 0;
constexpr size_t WS_MODP = 131072;
constexpr size_t WS_EGL = 1835008;
constexpr size_t WS_PROG = 1900544;
constexpr size_t WS_BAR = 1904640;
constexpr size_t WS_W = 2 * MiB;
constexpr size_t W_IN_OFF = 0, W_OUT_OFF = 29 * MiB, W_UP_OFF = 37 * MiB, W_DN_OFF = 81 * MiB, W_LAYER = 103 * MiB;
constexpr size_t WS_H = 208 * MiB;
constexpr size_t WS_PROJ = 272 * MiB;
constexpr size_t WS_G = 272 * MiB, WS_V = 448 * MiB;
constexpr size_t WS_OCAT = 504 * MiB;
constexpr size_t WS_GDN = 568 * MiB;
constexpr size_t WS_END = 712 * MiB;
constexpr int LDS_BYTES = 131072 + 256;

struct Params {
    const float *x, *c, *w_ada, *b_ada, *norm1, *w_in, *conv_qkv, *a_log, *dt_bias, *gdn_norm, *sbq, *sbk, *w_out, *norm2, *w_up, *conv_ffn, *w_down;
    GAS float* out; GAS unsigned char* ws; int ph_lo, ph_hi;
};

typedef __bf16 bf16v2 __attribute__((ext_vector_type(2)));
__device__ __forceinline__ unsigned pk2(float lo, float hi) { const f32x2 v = {lo, hi}; union { bf16v2 b; unsigned u; } x; x.b = __builtin_convertvector(v, bf16v2); return x.u; }
__device__ __forceinline__ float bf2f(bf16_t b) { return __uint_as_float(((unsigned)b) << 16); }
__device__ __forceinline__ float bflo(unsigned w) { return __uint_as_float(w << 16); }
__device__ __forceinline__ float bfhi(unsigned w) { return __uint_as_float(w & 0xffff0000u); }
__device__ __forceinline__ void unpack8(const u32x4 v, float* f) { f[0] = bflo(v.x); f[1] = bfhi(v.x); f[2] = bflo(v.y); f[3] = bfhi(v.y); f[4] = bflo(v.z); f[5] = bfhi(v.z); f[6] = bflo(v.w); f[7] = bfhi(v.w); }
__device__ __forceinline__ u32x4 pack8(const float* f) { u32x4 o; o.x = pk2(f[0], f[1]); o.y = pk2(f[2], f[3]); o.z = pk2(f[4], f[5]); o.w = pk2(f[6], f[7]); return o; }
__device__ __forceinline__ float silu_f(float y) { return y * __builtin_amdgcn_rcpf(1.0f + __expf(-y)); }
__device__ __forceinline__ float softplus_f(float z) { return fmaxf(z, 0.f) + log1pf(__expf(-fabsf(z))); }
__device__ __forceinline__ float softplus_fast(float z) { return fmaxf(z, 0.f) + __logf(1.0f + __expf(-fabsf(z))); }
__device__ __forceinline__ float wave_sum(float v) {
#pragma unroll
    for (int o = 1; o < 64; o <<= 1) v += __shfl_xor(v, o);
    return v;
}
__device__ __forceinline__ bf16x8 as_bf8(u32x4 v) { union { u32x4 u; bf16x8 b; } x; x.u = v; return x.b; }
#define MFMA16(a, b, c) __builtin_amdgcn_mfma_f32_16x16x32_bf16((a), (b), (c), 0, 0, 0)
#define LDS_WAIT() asm volatile("s_waitcnt lgkmcnt(0)" ::: "memory")
__device__ __forceinline__ int lane_id_hw() { return (int)__builtin_amdgcn_mbcnt_hi(~0u, __builtin_amdgcn_mbcnt_lo(~0u, 0u)); }
__device__ __forceinline__ int opaque_bid() { int b = (int)blockIdx.x; asm volatile("" : "+s"(b)); return b; }


#define XB_TMO      128
#define XB_XCNT(j)  (256  + 64 * (j))
#define XB_XSUB(j)  (1280 + 64 * (j))
#define XB_XGEN(j)  (2304 + 64 * (j))
#define XB_TOP      3328
#define XB_TOPGEN   3392
#define XCD_BAR_WORDS 3456
#define XB_SPIN_CAP (1u << 18)
__device__ __forceinline__ unsigned xb_ld(unsigned* p)              { return __hip_atomic_load(p, __ATOMIC_RELAXED, __HIP_MEMORY_SCOPE_AGENT); }
__device__ __forceinline__ unsigned xb_add(unsigned* p, unsigned v) { return __hip_atomic_fetch_add(p, v, __ATOMIC_RELAXED, __HIP_MEMORY_SCOPE_AGENT); }
__device__ __forceinline__ unsigned xb_xcc_id() { return (unsigned)__builtin_amdgcn_s_getreg((3 << 11) | 20) & 0xFu; }
#define XB_SPIN(cond, bar) do { unsigned _sp = 0; while (cond) { __builtin_amdgcn_s_sleep(1); \
    if ((++_sp & 255u) == 0u) { if (xb_ld(&(bar)[XB_TMO])) break; if (_sp > XB_SPIN_CAP) { atomicAdd(&(bar)[XB_TMO], 1u); break; } } } } while (0)
struct XcdBarrier { unsigned* bar; unsigned x; volatile LAS unsigned* st; };
__device__ __forceinline__ XcdBarrier xcd_barrier_post(unsigned* bar, volatile LAS unsigned* st) {
    XcdBarrier b; b.bar = bar; b.x = xb_xcc_id(); b.st = st;
    if (threadIdx.x == 0) (void)xb_add(&bar[XB_XCNT(b.x)], 1u);
    return b;
}
__device__ __forceinline__ void xcd_barrier_complete(unsigned* bar, unsigned x, unsigned& nloc, unsigned& nx) {
    const unsigned G = gridDim.x * gridDim.y * gridDim.z;
    unsigned sum, cnt, mine, sp = 0u;
    for (;;) {
        sum = 0u; cnt = 0u; mine = 0u;
#pragma unroll
        for (unsigned j = 0; j < 16; ++j) { const unsigned c = xb_ld(&bar[XB_XCNT(j)]); sum += c; cnt += (c > 0u) ? 1u : 0u; mine = (j == x) ? c : mine; }
        if (sum == G) break;
        __builtin_amdgcn_s_sleep(1);
        if ((++sp & 255u) == 0u) { if (xb_ld(&bar[XB_TMO])) break; if (sp > XB_SPIN_CAP) { atomicAdd(&bar[XB_TMO], 1u); break; } }
    }
    nloc = mine > 0u ? mine : 1u; nx = cnt > 0u ? cnt : 1u;
}
__device__ __forceinline__ void xcd_barrier(unsigned* bar, volatile LAS unsigned* st, const bool is_t0) {
    asm volatile("s_waitcnt vmcnt(0)" ::: "memory");
    __syncthreads();
    if (is_t0) {
        const unsigned x = xb_xcc_id();
        __builtin_amdgcn_s_waitcnt(0);
        unsigned nloc = st[0], nx = st[1];
        if (nloc == 0u) { xcd_barrier_complete(bar, x, nloc, nx); st[0] = nloc; st[1] = nx; }
        const unsigned old = xb_add(&bar[XB_XSUB(x)], 1u);
        const unsigned gen = old / nloc;
        if (old + 1u == (gen + 1u) * nloc) {
            __builtin_amdgcn_fence(__ATOMIC_RELEASE, "agent");
            asm volatile("s_waitcnt vmcnt(0)" ::: "memory");
            const unsigned og = xb_add(&bar[XB_TOP], 1u);
            const unsigned tg = og / nx;
            if (og + 1u == (tg + 1u) * nx) xb_add(&bar[XB_TOPGEN], 1u);
            else XB_SPIN(xb_ld(&bar[XB_TOPGEN]) == tg, bar);
            __builtin_amdgcn_fence(__ATOMIC_ACQUIRE, "agent");
            xb_add(&bar[XB_XGEN(x)], 1u);
            asm volatile("s_waitcnt vmcnt(0)" ::: "memory");
        } else {
            XB_SPIN(xb_ld(&bar[XB_XGEN(x)]) == gen, bar);
            __builtin_amdgcn_fence(__ATOMIC_ACQUIRE, "agent");
            asm volatile("s_waitcnt vmcnt(0)" ::: "memory");
        }
    }
    __syncthreads();
}

namespace pg8 {
constexpr int BM = 256, BK = 64, HALF = 128, HTB = HALF * BK * 2, STAGE_BYTES = 8 * HTB, NXCD = 8, WGM = 8;
__host__ __device__ __forceinline__ int lds_byte(int r, int c) { const int st = (r >> 4) * 2 + (c >> 5), rr = r & 15, cc = c & 31, ob = rr * 64 + cc * 2; return st * 1024 + (ob ^ (((ob >> 9) & 1) << 5)); }
__host__ __device__ __forceinline__ void stage_rc(int b, int& R, int& C) { const int st = b / 1024, sb = b % 1024, swz = sb ^ (((sb >> 9) & 1) << 5); R = (st >> 1) * 16 + swz / 64; C = (st & 1) * 32 + (swz % 64) / 2; }
__host__ __device__ __forceinline__ int perm32(int rho) { const int n = rho >> 4, i = rho & 15; return 8 * (i >> 2) + 4 * n + (i & 3); }
struct Unit { int pm, pn; };
struct Gemm { const bf16_t* A; const bf16_t* Bt; int M, N, K; };
struct StaticOrder {
    int nM, nN, nwg, G, c;
    __device__ __forceinline__ void init(int M, int N, int G_, int c_) { nM = M / BM; nN = N / BM; nwg = nM * nN; G = G_; c = c_; }
    __device__ __forceinline__ bool next(int i, Unit& u) const {
        const long L = (long)i * G + c; if (L >= nwg) return false;
        int wgid = (int)L; { const int q = nwg / NXCD, r = nwg % NXCD, xcd = wgid % NXCD, off = wgid / NXCD; wgid = (xcd < r ? xcd * (q + 1) : r * (q + 1) + (xcd - r) * q) + off; }
        const int nig = WGM * nN, gid = wgid / nig, fm = gid * WGM, gsz = (nM - fm) < WGM ? (nM - fm) : WGM;
        u.pm = fm + ((wgid % nig) % gsz); u.pn = (wgid % nig) / gsz; return true;
    }
};
struct EpiBf16 {
    static constexpr bool PERM = true;
    bf16_t* O; int ldc; int split_cols; size_t split_stride;
    __device__ __forceinline__ void operator()(const f32x4 (&acc)[2][2][4][2], const Unit& u, int wr, int wc, int fr, int fq) const {
        const int row0 = u.pm * BM + wr * 64 + fr; int colt = u.pn * BM; bf16_t* base = O;
        if (split_cols) { const int t = colt / split_cols; base += (size_t)t * split_stride; colt -= t * split_cols; }
        const int col0 = colt + wc * 32 + 8 * fq;
#pragma unroll
        for (int ai = 0; ai < 2; ++ai)
#pragma unroll
            for (int m = 0; m < 4; ++m) { bf16_t* rowp = base + (size_t)(row0 + ai * HALF + m * 16) * ldc + col0;
#pragma unroll
                for (int bj = 0; bj < 2; ++bj) { const f32x4 v0 = acc[ai][bj][m][0], v1 = acc[ai][bj][m][1];
                    u32x4 w; w.x = pk2(v0[0], v0[1]); w.y = pk2(v0[2], v0[3]); w.z = pk2(v1[0], v1[1]); w.w = pk2(v1[2], v1[3]);
                    *(u32x4*)(rowp + bj * HALF) = w; } }
    }
};
struct EpiRes {
    static constexpr bool PERM = false;
    const float* xin; float* out; int ldc; const float* gate;
    __device__ __forceinline__ void operator()(const f32x4 (&acc)[2][2][4][2], const Unit& u, int wr, int wc, int fr, int fq) const {
        const int row0 = u.pm * BM + wr * 64 + fr, col0 = u.pn * BM + wc * 32 + 4 * fq;
        f32x4 gv[2][2];
#pragma unroll
        for (int bj = 0; bj < 2; ++bj)
#pragma unroll
            for (int n = 0; n < 2; ++n) gv[bj][n] = *(const f32x4*)(gate + col0 + bj * HALF + n * 16);
#pragma unroll
        for (int ai = 0; ai < 2; ++ai)
#pragma unroll
            for (int m = 0; m < 4; ++m) { const size_t off = (size_t)(row0 + ai * HALF + m * 16) * ldc + col0;
#pragma unroll
                for (int bj = 0; bj < 2; ++bj)
#pragma unroll
                    for (int n = 0; n < 2; ++n) { const f32x4 xv = *(const f32x4*)(xin + off + bj * HALF + n * 16);
                        *(f32x4*)(out + off + bj * HALF + n * 16) = xv + gv[bj][n] * acc[ai][bj][m][n]; }
                asm volatile("" ::: "memory"); }
    }
};

struct EpiAct {
    static constexpr bool PERM = true;
    bf16_t* V; bf16_t* Gh; bf16_t* Gt; bf16_t* Vh; const float* cw;
    __device__ __forceinline__ void operator()(const f32x4 (&acc)[2][2][4][2], const Unit& u, int wr, int wc, int fr, int fq) const {
        const int lane = fr + 16 * fq, ff0 = u.pn * HALF + wc * 32 + 8 * fq;
        float w0[8], w1[8], w2[8];
#pragma unroll
        for (int e = 0; e < 8; ++e) { w0[e] = cw[ff0 + e]; w1[e] = cw[DFF + ff0 + e]; w2[e] = cw[2 * DFF + ff0 + e]; }
        const int src1 = (fr >= 1) ? lane - 1 : lane + 15, src2 = (fr >= 2) ? lane - 2 : lane + 14;
#pragma unroll
        for (int ai = 0; ai < 2; ++ai) { const int strip = 4 * u.pm + 2 * ai + wr; const size_t row_base = (size_t)u.pm * BM + ai * HALF + wr * 64;
#pragma unroll
            for (int m = 0; m < 4; ++m) { float o[8], gr[8];
#pragma unroll
                for (int n = 0; n < 2; ++n)
#pragma unroll
                    for (int j = 0; j < 4; ++j) { const int e = 4 * n + j; const float g0 = acc[ai][0][m][n][j], v = acc[ai][1][m][n][j], gp = (m > 0) ? acc[ai][0][m > 0 ? m - 1 : 0][n][j] : 0.f;
                        const float s1_ = (fr == 15) ? gp : g0, s2_ = (fr >= 14) ? gp : g0;
                        const float g1 = __int_as_float(__builtin_amdgcn_update_dpp(0, __float_as_int(s1_), 0x121, 0xf, 0xf, false)), g2 = __int_as_float(__builtin_amdgcn_update_dpp(0, __float_as_int(s2_), 0x122, 0xf, 0xf, false));
                        const float y = w0[e] * g2 + w1[e] * g1 + w2[e] * g0; const float a = y * __builtin_amdgcn_rcpf(1.0f + __expf(-y)) * v;
                        o[e] = (m == 0 && fr < 2) ? v : a; gr[e] = g0; }
                { u32x4 w; w.x = pk2(o[0], o[1]); w.y = pk2(o[2], o[3]); w.z = pk2(o[4], o[5]); w.w = pk2(o[6], o[7]);
                  *(u32x4*)(V + (row_base + 16 * m + fr) * DFF + ff0) = w;
                  if (m == 0 && fr < 2) *(u32x4*)(Vh + (size_t)(strip * 2 + fr) * DFF + ff0) = w; }
                if (m == 0 && fr < 2) { u32x4 w; w.x = pk2(gr[0], gr[1]); w.y = pk2(gr[2], gr[3]); w.z = pk2(gr[4], gr[5]); w.w = pk2(gr[6], gr[7]); *(u32x4*)(Gh + (size_t)(strip * 2 + fr) * DFF + ff0) = w; }
                if (m == 3 && fr >= 14) { u32x4 w; w.x = pk2(gr[0], gr[1]); w.y = pk2(gr[2], gr[3]); w.z = pk2(gr[4], gr[5]); w.w = pk2(gr[6], gr[7]); *(u32x4*)(Gt + (size_t)(strip * 2 + fr - 14) * DFF + ff0) = w; } } }
    }
};

template <class Epi>
__device__ __forceinline__ void gemm_phase(LAS unsigned char* lds, const Gemm g, const StaticOrder& S, const Epi& E, const int tid_in) {
    const int tid = tid_in, wid = __builtin_amdgcn_readfirstlane(tid >> 6), lane = tid & 63, wr = wid >> 2, wc = wid & 3, fr = lane & 15, fq = lane >> 4;
    const int K = g.K, nt = K / BK;
    unsigned voffA[2], voffB[2];
#pragma unroll
    for (int i = 0; i < 2; ++i) { int R, C; stage_rc(tid * 16 + i * 8192, R, C); const int Rb = Epi::PERM ? ((R & ~31) + perm32(R & 31)) : R;
        voffA[i] = (unsigned)(R * K + C) * 2u; voffB[i] = (unsigned)(Rb * K + C) * 2u; }
    const size_t kstep = (size_t)(BK * 2);
    const size_t hstep = (size_t)HALF * K * 2;
    const size_t tstep = 2 * hstep;
    const unsigned ldsw = (unsigned)wid * 1024u;
    const int aoff = lds_byte(wr * 64 + fr, fq * 8), boff = lds_byte(wc * 32 + fr, fq * 8);
#define PG8_SA(b, h) (((b) * 2 + (h)) * HTB)
#define PG8_SB(b, h) ((4 + (b) * 2 + (h)) * HTB)
#define PG8_STAGE(bufoff, gbase, voff) do { _Pragma("unroll") for (int _i = 0; _i < 2; ++_i) \
        __builtin_amdgcn_global_load_lds((const unsigned*)((const char*)(gbase) + (voff)[_i]), (LAS unsigned*)(lds + (bufoff) + ldsw + _i * 8192), 16, 0, 0); } while (0)
#define PG8_LDA(dst, b, h) do { _Pragma("unroll") for (int m = 0; m < 4; ++m) _Pragma("unroll") for (int k = 0; k < 2; ++k) dst[m][k] = *(const LAS bf16x8*)(lds + PG8_SA(b, h) + aoff + m * 2048 + k * 1024); } while (0)
#define PG8_LDB(dst, b, h) do { _Pragma("unroll") for (int n = 0; n < 2; ++n) _Pragma("unroll") for (int k = 0; k < 2; ++k) dst[n][k] = *(const LAS bf16x8*)(lds + PG8_SB(b, h) + boff + n * 2048 + k * 1024); } while (0)
#define PG8_MMA(ai, bj, At, Bt) do { __builtin_amdgcn_s_setprio(1); _Pragma("unroll") for (int m = 0; m < 4; ++m) _Pragma("unroll") for (int n = 0; n < 2; ++n) _Pragma("unroll") for (int k = 0; k < 2; ++k) \
        acc[ai][bj][m][n] = __builtin_amdgcn_mfma_f32_16x16x32_bf16(Bt[n][k], At[m][k], acc[ai][bj][m][n], 0, 0, 0); __builtin_amdgcn_s_setprio(0); } while (0)
#define PG8_WAIT_V(n) asm volatile("s_waitcnt vmcnt(" #n ")" ::: "memory")
#define PG8_WAIT_L(n) asm volatile("s_waitcnt lgkmcnt(" #n ")" ::: "memory")
#define PG8_BAR __builtin_amdgcn_s_barrier()
#define PG8_SCHED __builtin_amdgcn_sched_barrier(0)
    Unit cur, nxt; int ui = 0;
    if (!S.next(0, cur)) return;
    f32x4 acc[2][2][4][2];
#pragma unroll
    for (int a = 0; a < 2; ++a)
#pragma unroll
        for (int b = 0; b < 2; ++b)
#pragma unroll
            for (int m = 0; m < 4; ++m)
#pragma unroll
                for (int n = 0; n < 2; ++n) acc[a][b][m][n] = (f32x4){0.f, 0.f, 0.f, 0.f};
    bf16x8 At[4][2], B0[2][2], B1[2][2];
    const char* cA = (const char*)g.A + (size_t)cur.pm * tstep; const char* cB = (const char*)g.Bt + (size_t)cur.pn * tstep;
    PG8_STAGE(PG8_SB(0, 0), cB, voffB); PG8_STAGE(PG8_SB(0, 1), cB + hstep, voffB); PG8_STAGE(PG8_SA(0, 0), cA, voffA); PG8_STAGE(PG8_SA(0, 1), cA + hstep, voffA);
    if (wr == 1) PG8_BAR;
    PG8_WAIT_V(2); PG8_BAR;
    PG8_STAGE(PG8_SB(1, 0), cB + kstep, voffB); PG8_STAGE(PG8_SA(1, 0), cA + kstep, voffA); PG8_STAGE(PG8_SB(1, 1), cB + hstep + kstep, voffB);
    PG8_WAIT_V(6); PG8_BAR;
    for (;;) {
        const bool has_next = S.next(ui + 1, nxt);
        const char* nA = has_next ? (const char*)g.A + (size_t)nxt.pm * tstep : cA; const char* nB = has_next ? (const char*)g.Bt + (size_t)nxt.pn * tstep : cB;
        for (int t = 0; t < nt; t += 2) {
            const bool last = (t == nt - 2);
            const char* a1 = cA + (size_t)(t + 1) * kstep;
            const char* a2 = last ? nA : cA + (size_t)(t + 2) * kstep; const char* b2 = last ? nB : cB + (size_t)(t + 2) * kstep;
            const char* a3 = a2 + kstep; const char* b3 = b2 + kstep;
            PG8_LDB(B0, 0, 0); PG8_LDB(B1, 0, 1); PG8_SCHED; PG8_LDA(At, 0, 0); PG8_STAGE(PG8_SA(1, 1), a1 + hstep, voffA);
            PG8_WAIT_V(8); PG8_WAIT_L(0); PG8_BAR; PG8_MMA(0, 0, At, B0); PG8_MMA(0, 1, At, B1); PG8_BAR; PG8_SCHED;
            PG8_LDA(At, 0, 1); PG8_STAGE(PG8_SB(0, 0), b2, voffB); PG8_STAGE(PG8_SB(0, 1), b2 + hstep, voffB); PG8_STAGE(PG8_SA(0, 0), a2, voffA);
            PG8_WAIT_V(8); PG8_WAIT_L(0); PG8_BAR; PG8_MMA(1, 0, At, B0); PG8_MMA(1, 1, At, B1); PG8_BAR; PG8_SCHED;
            PG8_LDB(B0, 1, 0); PG8_LDB(B1, 1, 1); PG8_SCHED; PG8_LDA(At, 1, 0); PG8_STAGE(PG8_SA(0, 1), a2 + hstep, voffA);
            PG8_WAIT_V(8); PG8_WAIT_L(0); PG8_BAR; PG8_MMA(0, 0, At, B0); PG8_MMA(0, 1, At, B1); PG8_BAR; PG8_SCHED;
            PG8_LDA(At, 1, 1); PG8_STAGE(PG8_SB(1, 0), b3, voffB); PG8_STAGE(PG8_SB(1, 1), b3 + hstep, voffB); PG8_STAGE(PG8_SA(1, 0), a3, voffA);
            PG8_WAIT_V(8); PG8_WAIT_L(0); PG8_BAR; PG8_MMA(1, 0, At, B0); PG8_MMA(1, 1, At, B1); PG8_BAR; PG8_SCHED;
        }
        if (wr == 0) PG8_BAR;
        E(acc, cur, wr, wc, fr, fq);
        if (!has_next) break;
#pragma unroll
        for (int a = 0; a < 2; ++a)
#pragma unroll
            for (int b = 0; b < 2; ++b)
#pragma unroll
                for (int m = 0; m < 4; ++m)
#pragma unroll
                    for (int n = 0; n < 2; ++n) acc[a][b][m][n] = (f32x4){0.f, 0.f, 0.f, 0.f};
        cur = nxt; cA = nA; cB = nB; ++ui;
        if (wr == 1) PG8_BAR;
    }
    PG8_WAIT_V(0);
    PG8_BAR;
#undef PG8_SA
#undef PG8_SB
#undef PG8_STAGE
#undef PG8_LDA
#undef PG8_LDB
#undef PG8_MMA
#undef PG8_WAIT_V
#undef PG8_WAIT_L
#undef PG8_BAR
#undef PG8_SCHED
}
}

__device__ __forceinline__ void transpose_item(const float* W, int K, int Nsrc, bf16_t* WT, int k0, int ndst0, int nsrc0, int nvalid, LAS float* scr, int lane) {
    float vv[32];
#pragma unroll
    for (int i = 0; i < 32; ++i) { const int kk = 2 * i + (lane >> 5), nn = lane & 31;
        vv[i] = (nn < nvalid) ? W[(size_t)(k0 + kk) * Nsrc + nsrc0 + nn] : 0.f; }
#pragma unroll
    for (int i = 0; i < 32; ++i) { const int kk = 2 * i + (lane >> 5), nn = lane & 31; scr[kk * 33 + nn] = vv[i]; }
    LDS_WAIT();
    const int c = lane & 7;
#pragma unroll
    for (int j = 0; j < 4; ++j) { const int n = (lane >> 3) + 8 * j; const LAS float* s = scr + (8 * c) * 33 + n;
        u32x4 o; o.x = pk2(s[0 * 33], s[1 * 33]); o.y = pk2(s[2 * 33], s[3 * 33]); o.z = pk2(s[4 * 33], s[5 * 33]); o.w = pk2(s[6 * 33], s[7 * 33]);
        *(u32x4*)(WT + (size_t)(ndst0 + n) * K + k0 + 8 * c) = o; }
    LDS_WAIT();
}
__device__ __forceinline__ void weight_transposes(const Params& p, LAS unsigned char* lds, const int tid_in, const int l, const int mask, const int gwv, const int NGW);
__device__ __forceinline__ void p0_phase(const Params& p, LAS unsigned char* lds, const int tid_in) {
    const int tid = tid_in, lane = tid & 63, wave = tid >> 6;
    LAS float* sc = (LAS float*)(lds + 8 * 8448);
    for (int k = tid; k < D_; k += 512) sc[k] = silu_f(p.c[k]);
    __syncthreads();
    { const int gw = wave * 256 + (int)blockIdx.x;
      if (gw < 1536) { const int g = gw * 64 + lane; const int l = g / 49152, rem = g % 49152, ks = rem / 3072, c4 = rem % 3072;
          const float* wp = p.w_ada + ((size_t)l * D_ + (size_t)ks * 128) * 12288 + 4 * c4;
          f32x4 a0 = {0.f, 0.f, 0.f, 0.f}, a1 = a0;
#pragma unroll 4
          for (int k = 0; k < 128; k += 2) { const f32x4 w0 = *(const f32x4*)(wp + (size_t)k * 12288), w1 = *(const f32x4*)(wp + (size_t)(k + 1) * 12288);
              a0 += w0 * sc[ks * 128 + k]; a1 += w1 * sc[ks * 128 + k + 1]; }
          *(f32x4*)((float*)(p.ws + WS_MODP) + ((size_t)(ks * 2 + l) * 12288 + 4 * c4)) = a0 + a1; } }
    weight_transposes(p, lds, tid_in, 0, 1, (int)blockIdx.x * 8 + wave, (int)gridDim.x * 8);
}
__device__ __forceinline__ void weight_transposes(const Params& p, LAS unsigned char* lds, const int tid_in, const int l, const int mask, const int gwv, const int NGW) {
    const int lane = tid_in & 63, wave = tid_in >> 6;
    LAS float* scr = (LAS float*)(lds + wave * 8448);
    constexpr int I_IN = 32 * 232, I_OUT = 32 * 64, I_UP = 32 * 352, I_DN = 88 * 64;
    const int n_in = (mask & 1) ? I_IN : 0, n_out = (mask & 2) ? I_OUT : 0, n_up = (mask & 4) ? I_UP : 0, n_dn = (mask & 8) ? I_DN : 0;
    GAS unsigned char* wl = p.ws + WS_W + (size_t)l * W_LAYER;
    for (int it = gwv; it < n_in + n_out + n_up + n_dn; it += NGW) {
        int r = it;
        if (r < n_in) { const int kb = r / 232, nb = r % 232, nd = 32 * nb; int ns, nv;
            if (nd < 4096) { ns = nd; nv = 32; } else if (nd < 7168) { ns = nd + 16; nv = 32; } else if (nd == 7168) { ns = 4096; nv = 16; } else { ns = 0; nv = 0; }
            transpose_item(p.w_in + (size_t)l * D_ * DIN, D_, DIN, (bf16_t*)(wl + W_IN_OFF), 64 * kb, nd, ns, nv, scr, lane); continue; }
        r -= n_in;
        if (r < n_out) { const int kb = r / 64, nb = r % 64; transpose_item(p.w_out + (size_t)l * D_ * D_, D_, D_, (bf16_t*)(wl + W_OUT_OFF), 64 * kb, 32 * nb, 32 * nb, 32, scr, lane); continue; }
        r -= n_out;
        if (r < n_up) { const int kb = r / 352, nb = r % 352, nd = 32 * nb, pn = nd >> 8, x0 = nd & 255;
            transpose_item(p.w_up + (size_t)l * D_ * NUP, D_, NUP, (bf16_t*)(wl + W_UP_OFF), 64 * kb, nd, (x0 < 128) ? 128 * pn + x0 : DFF + 128 * pn + (x0 - 128), 32, scr, lane); continue; }
        r -= n_up;
        { const int kb = r / 64, nb = r % 64; transpose_item(p.w_down + (size_t)l * DFF * D_, DFF, D_, (bf16_t*)(wl + W_DN_OFF), 64 * kb, 32 * nb, 32 * nb, 32, scr, lane); }
    }
}

__device__ __forceinline__ float mod_from_partials(const Params& p, int l, int j) {
    const float* mp = (const float*)(p.ws + WS_MODP);
    float v = p.b_ada[l * 12288 + j];
#pragma unroll
    for (int ks = 0; ks < KS_MOD; ++ks) v += mp[(size_t)(ks * 2 + l) * 12288 + j];
    return v;
}
__device__ __forceinline__ void norm_phase(const Params& p, LAS unsigned char* lds, const float* xin, const float* normw, int l, int off_shift, int off_scale, bool from_partials, const int tid_in) {
    const int tid = tid_in, lane = tid & 63, wave = tid >> 6;
    LAS float* cA = (LAS float*)lds; LAS float* cB = cA + D_;
    float* modf = (float*)(p.ws + WS_MODF);
    if (from_partials) {
        for (int idx = (int)blockIdx.x * 512 + tid; idx < 2 * 12288; idx += (int)gridDim.x * 512) modf[idx] = mod_from_partials(p, idx / 12288, idx % 12288);
        for (int j = tid; j < D_; j += 512) { const float sh = mod_from_partials(p, l, off_shift + j), scv = mod_from_partials(p, l, off_scale + j);
            cA[j] = normw[j] * (1.f + scv); cB[j] = sh; }
    } else {
        for (int j = tid; j < D_; j += 512) { cA[j] = normw[j] * (1.f + modf[l * 12288 + off_scale + j]); cB[j] = modf[l * 12288 + off_shift + j]; }
    }
    __syncthreads();
    f32x4 a[8], b[8];
#pragma unroll
    for (int j = 0; j < 8; ++j) { a[j] = *(const LAS f32x4*)(cA + 4 * lane + 256 * j); b[j] = *(const LAS f32x4*)(cB + 4 * lane + 256 * j); }
    bf16_t* H = (bf16_t*)(p.ws + WS_H);
    for (int m = (int)blockIdx.x * 8 + wave; m < T_; m += (int)gridDim.x * 8) {
        const f32x4* xr = (const f32x4*)(xin + (size_t)m * D_) + lane;
        f32x4 v[8]; float s = 0.f;
#pragma unroll
        for (int j = 0; j < 8; ++j) { v[j] = xr[64 * j]; s += (v[j].x * v[j].x + v[j].y * v[j].y) + (v[j].z * v[j].z + v[j].w * v[j].w); }
        const float rstd = rsqrtf(wave_sum(s) * (1.f / D_) + EPS_);
        u32x2* o8 = (u32x2*)(H + (size_t)m * D_) + lane;
#pragma unroll
        for (int j = 0; j < 8; ++j) { const f32x4 y = v[j] * rstd * a[j] + b[j]; u32x2 w; w.x = pk2(y.x, y.y); w.y = pk2(y.z, y.w); o8[64 * j] = w; }
    }
}


__device__ __forceinline__ void win_small_cols(const Params& p, LAS unsigned char* lds, int l, const int tid_in) {
    const int lane = tid_in & 63, wave = tid_in >> 6, r16 = lane & 15, q4 = lane >> 4;
    const int tw = wave & 3, kh = wave >> 2;
    const int m0 = ((int)blockIdx.x * 4 + tw) * 16;
    const bf16_t* H = (const bf16_t*)(p.ws + WS_H) + (size_t)(m0 + r16) * D_ + 8 * q4 + 1024 * kh;
    const bf16_t* Wt = (const bf16_t*)(p.ws + WS_W + (size_t)l * W_LAYER + W_IN_OFF) + (size_t)(7168 + r16) * D_ + 8 * q4 + 1024 * kh;
    f32x4 acc0 = {0.f, 0.f, 0.f, 0.f}, acc1 = acc0;
#pragma unroll 8
    for (int s = 0; s < 32; s += 2) {
        const bf16x8 a0 = *(const bf16x8*)(H + 32 * s), b0 = *(const bf16x8*)(Wt + 32 * s), a1 = *(const bf16x8*)(H + 32 * s + 32), b1 = *(const bf16x8*)(Wt + 32 * s + 32);
        acc0 = MFMA16(a0, b0, acc0); acc1 = MFMA16(a1, b1, acc1); }
    acc0 += acc1;
    LAS f32x4* xch = (LAS f32x4*)lds;
    if (kh) xch[tw * 64 + lane] = acc0;
    __syncthreads();
    if (!kh) { acc0 += xch[tw * 64 + lane];
        bf16_t* proj = (bf16_t*)(p.ws + WS_PROJ);
#pragma unroll
        for (int rg = 0; rg < 4; ++rg) proj[(size_t)(m0 + 4 * q4 + rg) * NIN + 7168 + r16] = (bf16_t)(pk2(acc0[rg], 0.f) & 0xffffu); }
    __syncthreads();
}

__device__ __forceinline__ void gdn_prep_phase(const Params& p, LAS unsigned char* lds, int l, const int tid_in) {
    const int tid0 = tid_in, wave = __builtin_amdgcn_readfirstlane(tid0 >> 6);
    LAS float* Lslot = (LAS float*)lds;
    LAS bf16_t* Qn = (LAS bf16_t*)(lds + 65536); LAS bf16_t* Kn = (LAS bf16_t*)(lds + 82944); LAS bf16_t* KdTs = (LAS bf16_t*)(lds + 100352);
    LAS float* betaS = (LAS float*)(lds + 118784); LAS float* gcS = (LAS float*)(lds + 119808); LAS float* gS = (LAS float*)(lds + 120832);
    LAS bf16_t* VbT = (LAS bf16_t*)(lds + 65536); LAS bf16_t* KbgT = (LAS bf16_t*)(lds + 82944);
    const bf16_t* proj = (const bf16_t*)(p.ws + WS_PROJ);
    bf16_t* Wg = (bf16_t*)(p.ws + WS_GDN); bf16_t* UTg = (bf16_t*)(p.ws + WS_GDN + 32 * MiB); bf16_t* KdTg = (bf16_t*)(p.ws + WS_GDN + 64 * MiB);
    bf16_t* Qgg = (bf16_t*)(p.ws + WS_GDN + 96 * MiB); bf16_t* Ag = (bf16_t*)(p.ws + WS_GDN + 128 * MiB);
    float* egl = (float*)(p.ws + WS_EGL);
    LAS float* cwS = (LAS float*)(lds + 122880);
    { const int h0 = ((int)blockIdx.x * 8) >> 8; const float* convw = p.conv_qkv + (size_t)l * 4 * 3072;
      for (int u = tid0; u < 4 * 3 * 128; u += 512) { const int r = u / 384, xx = (u % 384) >> 7, d = u & 127; cwS[u] = convw[r * 3072 + xx * 1024 + h0 * 128 + d]; }
      __syncthreads(); }
#pragma unroll 1
    for (int batch = 0; batch < 2; ++batch) {
        { int tid = tid0; asm volatile("" : "+v"(tid));
          const int kk = tid >> 6, row = tid & 63;
          if (tid < 256) { const int I = (int)blockIdx.x * 8 + batch * 4 + kk, h = I >> 8, c = I & 255; const size_t t = (size_t)64 * c + row;
              const float braw = bf2f(proj[t * NIN + PBETA + h]), araw = bf2f(proj[t * NIN + PALPHA + h]);
              betaS[kk * 64 + row] = 1.f / (1.f + __expf(-braw));
              float g = -__expf(p.a_log[l * NH + h]) * softplus_f(araw + p.dt_bias[l * NH + h]);
#pragma unroll
              for (int o = 1; o < 64; o <<= 1) { const float u = __shfl_up(g, o); if (row >= o) g += u; }
              gcS[kk * 64 + row] = g; if (row == 63) egl[I] = __expf(g); }
          __syncthreads(); }
        u32x4 raw[3][4][2];
#define PREP_LOADRAW(kq) do { const int I_ = (int)blockIdx.x * 8 + batch * 4 + (kq), h_ = I_ >> 8, c_ = I_ & 255; \
            _Pragma("unroll") for (int X = 0; X < 3; ++X) _Pragma("unroll") for (int r = 0; r < 4; ++r) { int tt_ = 64 * c_ + (tid0 >> 3) - 3 + r; tt_ = tt_ < 0 ? 0 : tt_; \
                const u32x4* pp_ = (const u32x4*)(proj + (size_t)tt_ * NIN + X * 1024 + h_ * 128 + 16 * (tid0 & 7)); raw[X][r][0] = pp_[0]; raw[X][r][1] = pp_[1]; } } while (0)
        PREP_LOADRAW(0);
#pragma unroll 1
        for (int k = 0; k < 4; ++k) {
            int tid = tid0; asm volatile("" : "+v"(tid));
            const int lane = tid & 63, r16 = lane & 15, q4 = lane >> 4, i = tid >> 3, sub = tid & 7;
            const int I = (int)blockIdx.x * 8 + batch * 4 + k, h = I >> 8, c = I & 255, t = 64 * c + i;
            const float gci = gcS[k * 64 + i], glast = gcS[k * 64 + 63];
#pragma unroll
            for (int X = 0; X < 3; ++X) {
                const int col = X * 1024 + h * 128 + 16 * sub;
                float y[16];
#pragma unroll
                for (int e = 0; e < 16; ++e) y[e] = 0.f;
#pragma unroll
                for (int r = 0; r < 4; ++r) { const int tt = t - 3 + r;
                    if (tt >= 0) { float xv[16]; unpack8(raw[X][r][0], xv); unpack8(raw[X][r][1], xv + 8);
                        const LAS f32x4* wp = (const LAS f32x4*)(cwS + (r * 3 + X) * 128 + 16 * sub);
#pragma unroll
                        for (int e4 = 0; e4 < 4; ++e4) { const f32x4 w = wp[e4]; y[4 * e4] += w.x * xv[4 * e4]; y[4 * e4 + 1] += w.y * xv[4 * e4 + 1]; y[4 * e4 + 2] += w.z * xv[4 * e4 + 2]; y[4 * e4 + 3] += w.w * xv[4 * e4 + 3]; } } }
                float ss = 0.f;
#pragma unroll
                for (int e = 0; e < 16; ++e) { y[e] = silu_f(y[e]); ss += y[e] * y[e]; }
                if (X < 2) { ss += __shfl_xor(ss, 1); ss += __shfl_xor(ss, 2); ss += __shfl_xor(ss, 4);
                    const float scl = rsqrtf(ss + EPS_) * (X == 0 ? 0.08838834764831845f : 1.f);
#pragma unroll
                    for (int e = 0; e < 16; ++e) y[e] *= scl; }
                if (X == 0) { *(LAS u32x4*)(Qn + i * 136 + 16 * sub) = pack8(y); *(LAS u32x4*)(Qn + i * 136 + 16 * sub + 8) = pack8(y + 8);
                    const float eg = __expf(gci); float z[16];
#pragma unroll
                    for (int e = 0; e < 16; ++e) z[e] = y[e] * eg;
                    { const int c8a = 2 * sub, c8b = 2 * sub + 1;
                      *(u32x4*)(Qgg + (size_t)I * 8192 + ((((i >> 4) * 4 + (c8a >> 2)) * 64 + (c8a & 3) * 16 + (i & 15)) * 8)) = pack8(z);
                      *(u32x4*)(Qgg + (size_t)I * 8192 + ((((i >> 4) * 4 + (c8b >> 2)) * 64 + (c8b & 3) * 16 + (i & 15)) * 8)) = pack8(z + 8); }
                } else if (X == 1) { const u32x4 k0 = pack8(y), k1 = pack8(y + 8);
                    *(LAS u32x4*)(Kn + i * 136 + 16 * sub) = k0; *(LAS u32x4*)(Kn + i * 136 + 16 * sub + 8) = k1;
                    u32x4* dst = (u32x4*)(Wg + ((size_t)I * 64 + i) * 128 + 16 * sub); dst[0] = k0; dst[1] = k1;
                    const float ed = __expf(glast - gci);
#pragma unroll
                    for (int e = 0; e < 16; e += 2) { const unsigned w = pk2(y[e] * ed, y[e + 1] * ed); KdTs[(16 * sub + e) * 72 + i] = (bf16_t)(w & 0xffffu); KdTs[(16 * sub + e + 1) * 72 + i] = (bf16_t)(w >> 16); }
                } else { u32x4* dst = (u32x4*)(UTg + ((size_t)I * 64 + i) * 128 + 16 * sub); dst[0] = pack8(y); dst[1] = pack8(y + 8); }
            }
            __syncthreads();
            if (k < 3) PREP_LOADRAW(k + 1);
#pragma unroll
            for (int u = 0; u < 2; ++u) { const int ch = tid + 512 * u, d = ch >> 3, part = ch & 7;
                *(u32x4*)(KdTg + (size_t)I * 8192 + ((((d >> 4) * 2 + (part >> 2)) * 64 + (part & 3) * 16 + (d & 15)) * 8)) = *(const LAS u32x4*)(KdTs + d * 72 + 8 * part); }
            { const int pr = wave >> 2, ti = wave & 3;
              for (int tj = 0; tj < 4; ++tj) {
                  f32x4 acc = {0.f, 0.f, 0.f, 0.f};
                  if (tj <= ti) {
#pragma unroll
                      for (int s = 0; s < 4; ++s) {
                          if (pr == 0) { const bf16x8 a = *(const LAS bf16x8*)(Kn + (16 * ti + r16) * 136 + 32 * s + 8 * q4), b = *(const LAS bf16x8*)(Kn + (16 * tj + r16) * 136 + 32 * s + 8 * q4); acc = MFMA16(a, b, acc); }
                          else { const bf16x8 a = *(const LAS bf16x8*)(Kn + (16 * tj + r16) * 136 + 32 * s + 8 * q4), b = *(const LAS bf16x8*)(Qn + (16 * ti + r16) * 136 + 32 * s + 8 * q4); acc = MFMA16(a, b, acc); }
                      }
                  }
                  if (pr == 0) {
                      if (tj <= ti) { const int jj = 16 * tj + r16; const float gj = gcS[k * 64 + jj];
#pragma unroll
                          for (int rg = 0; rg < 4; ++rg) { const int ii = 16 * ti + 4 * q4 + rg; const float v = (ii > jj) ? betaS[k * 64 + ii] * acc[rg] * __expf(gcS[k * 64 + ii] - gj) : 0.f;
                              Lslot[k * 4096 + ii * 64 + jj] = v; } }
                  } else {
                      const int ii = 16 * ti + r16; const float gi = gcS[k * 64 + ii]; float o[4];
#pragma unroll
                      for (int rg = 0; rg < 4; ++rg) { const int jj = 16 * tj + 4 * q4 + rg; o[rg] = (tj <= ti && ii >= jj) ? acc[rg] * __expf(gi - gcS[k * 64 + jj]) : 0.f; }
                      u32x2 w; w.x = pk2(o[0], o[1]); w.y = pk2(o[2], o[3]);
                      *(u32x2*)(Ag + (size_t)I * 4096 + (((ti * 2 + (tj >> 1)) * 64 + ((2 * tj + (q4 >> 1)) & 3) * 16 + r16) * 8) + 4 * (q4 & 1)) = w;
                  }
              } }
            __syncthreads();
        }
        if (wave < 4) {
            const int lane = tid0 & 63;
            LAS float* L = Lslot + wave * 4096; float tc[64];
#pragma unroll
            for (int ii = 0; ii < 64; ++ii) { float a = (lane == ii) ? 1.f : 0.f;
#pragma unroll
                for (int jj = 0; jj < ii; ++jj) a -= L[ii * 64 + jj] * tc[jj];
                tc[ii] = a;
                if ((ii & 3) == 3) asm volatile("" ::: "memory"); }
            LDS_WAIT();
#pragma unroll
            for (int ii = 0; ii < 64; ++ii) L[ii * 64 + lane] = tc[ii];
        }
        __syncthreads();
#pragma unroll 1
        for (int k = 0; k < 4; ++k) {
            int tid = tid0; asm volatile("" : "+v"(tid));
            const int lane = tid & 63, r16 = lane & 15, q4 = lane >> 4, i = tid >> 3, sub = tid & 7;
            const int I = (int)blockIdx.x * 8 + batch * 4 + k;
            { const float be = betaS[k * 64 + i], beg = be * __expf(gcS[k * 64 + i]);
              const u32x4* pk = (const u32x4*)(Wg + ((size_t)I * 64 + i) * 128 + 16 * sub); const u32x4* pv = (const u32x4*)(UTg + ((size_t)I * 64 + i) * 128 + 16 * sub);
              float kv[16], vv[16]; unpack8(pk[0], kv); unpack8(pk[1], kv + 8); unpack8(pv[0], vv); unpack8(pv[1], vv + 8);
#pragma unroll
              for (int e = 0; e < 16; ++e) { vv[e] *= be; kv[e] *= beg; }
              *(LAS u32x4*)(VbT + i * 136 + 16 * sub) = pack8(vv); *(LAS u32x4*)(VbT + i * 136 + 16 * sub + 8) = pack8(vv + 8);
              *(LAS u32x4*)(KbgT + i * 136 + 16 * sub) = pack8(kv); *(LAS u32x4*)(KbgT + i * 136 + 16 * sub + 8) = pack8(kv + 8); }
            __syncthreads();
            { const int pr = wave >> 2, ti = wave & 3; bf16x8 aT[2];
#pragma unroll
              for (int s = 0; s < 2; ++s) { const LAS float* tp = Lslot + k * 4096 + (16 * ti + r16) * 64 + 32 * s + 8 * q4; const f32x4 t0 = *(const LAS f32x4*)tp, t1 = *(const LAS f32x4*)(tp + 4);
                  u32x4 w; w.x = pk2(t0.x, t0.y); w.y = pk2(t0.z, t0.w); w.z = pk2(t1.x, t1.y); w.w = pk2(t1.z, t1.w); aT[s] = as_bf8(w); }
#pragma unroll 2
              for (int tn = 0; tn < 8; ++tn) { f32x4 acc = {0.f, 0.f, 0.f, 0.f};
                  if (pr == 0) {
#pragma unroll
                      for (int s = 0; s < 2; ++s) { const LAS bf16_t* bp = VbT + (32 * s + 8 * q4 + (r16 >> 2)) * 136 + 16 * tn + 4 * (r16 & 3);
                          const s16x4 t0 = __builtin_amdgcn_ds_read_tr16_b64_v4i16((LAS s16x4*)bp), t1 = __builtin_amdgcn_ds_read_tr16_b64_v4i16((LAS s16x4*)(bp + 4 * 136));
                          const bf16x8 b = {t0[0], t0[1], t0[2], t0[3], t1[0], t1[1], t1[2], t1[3]}; acc = MFMA16(aT[s], b, acc); }
                      u32x2 w; w.x = pk2(acc[0], acc[1]); w.y = pk2(acc[2], acc[3]);
                      *(u32x2*)(UTg + (size_t)I * 8192 + (((tn * 4 + ti) * 64 + lane) * 4)) = w;
                  } else {
#pragma unroll
                      for (int s = 0; s < 2; ++s) { const LAS bf16_t* bp = KbgT + (32 * s + 8 * q4 + (r16 >> 2)) * 136 + 16 * tn + 4 * (r16 & 3);
                          const s16x4 t0 = __builtin_amdgcn_ds_read_tr16_b64_v4i16((LAS s16x4*)bp), t1 = __builtin_amdgcn_ds_read_tr16_b64_v4i16((LAS s16x4*)(bp + 4 * 136));
                          const bf16x8 b = {t0[0], t0[1], t0[2], t0[3], t1[0], t1[1], t1[2], t1[3]}; acc = MFMA16(b, aT[s], acc); }
                      u32x2 w; w.x = pk2(acc[0], acc[1]); w.y = pk2(acc[2], acc[3]);
                      *(u32x2*)(Wg + (size_t)I * 8192 + (((ti * 4 + (tn >> 1)) * 64 + ((2 * tn + (q4 >> 1)) & 3) * 16 + r16) * 8) + 4 * (q4 & 1)) = w;
                  } } }
            __syncthreads();
        }
    }
}

struct ScanBuf { bf16x8 a4[4]; bf16x8 a2[2]; bf16x8 kd[2]; u32x2 u[2]; float eg; };
template <int ROLE, int HOT>
__device__ __forceinline__ void scan_loop(const Params& p, LAS bf16_t* ST, LAS bf16_t* VT, int h, int vs, int wave, int lane) {
    const int r16 = lane & 15, q4 = lane >> 4, tm = wave & 3;
    const bf16_t* Wg = (const bf16_t*)(p.ws + WS_GDN); const bf16_t* UTg = (const bf16_t*)(p.ws + WS_GDN + 32 * MiB); const bf16_t* KdTg = (const bf16_t*)(p.ws + WS_GDN + 64 * MiB);
    const bf16_t* Qgg = (const bf16_t*)(p.ws + WS_GDN + 96 * MiB); const bf16_t* Ag = (const bf16_t*)(p.ws + WS_GDN + 128 * MiB);
    const float* egl = (const float*)(p.ws + WS_EGL);
    bf16_t* ocat = (bf16_t*)(p.ws + (HOT ? WS_H : WS_OCAT));
    const bf16_t* p4 = ROLE ? Qgg : Wg;
    f32x4 accS[2] = {{0.f, 0.f, 0.f, 0.f}, {0.f, 0.f, 0.f, 0.f}};
    ScanBuf B[4];
#define SCAN_LOAD(buf, cc) do { const size_t I_ = (size_t)h * 256 + (HOT ? ((cc) & 3) : (cc)); \
        _Pragma("unroll") for (int s = 0; s < 4; ++s) (buf).a4[s] = *(const bf16x8*)(p4 + I_ * 8192 + ((tm * 4 + s) * 64 + lane) * 8); \
        _Pragma("unroll") for (int s = 0; s < 2; ++s) (buf).kd[s] = *(const bf16x8*)(KdTg + I_ * 8192 + ((wave * 2 + s) * 64 + lane) * 8); \
        if (ROLE) { _Pragma("unroll") for (int s = 0; s < 2; ++s) (buf).a2[s] = *(const bf16x8*)(Ag + I_ * 4096 + ((tm * 2 + s) * 64 + lane) * 8); } \
        else { _Pragma("unroll") for (int tn = 0; tn < 2; ++tn) (buf).u[tn] = *(const u32x2*)(UTg + I_ * 8192 + (((vs * 2 + tn) * 4 + tm) * 64 + lane) * 4); } \
        (buf).eg = egl[I_]; } while (0)
#pragma unroll
    for (int u = 0; u < 4; ++u) SCAN_LOAD(B[u], u);
    for (int c0 = 0; c0 < 256; c0 += 4) {
#pragma unroll
        for (int u = 0; u < 4; ++u) {
            const int c = c0 + u, pb = u & 1;
            const LAS bf16_t* STc = ST + pb * (32 * 136); LAS bf16_t* STn = ST + (pb ^ 1) * (32 * 136);
            if (ROLE == 0) asm volatile("" : "+v"(B[u].u[0].x), "+v"(B[u].u[0].y), "+v"(B[u].u[1].x), "+v"(B[u].u[1].y), "+v"(B[u].eg));
            else asm volatile("" : "+v"(B[u].eg));
            bf16x8 sf[2][4];
#pragma unroll
            for (int tn = 0; tn < 2; ++tn)
#pragma unroll
                for (int s = 0; s < 4; ++s) sf[tn][s] = *(const LAS bf16x8*)(STc + (16 * tn + r16) * 136 + 32 * s + 8 * q4);
            f32x4 o[2] = {{0.f, 0.f, 0.f, 0.f}, {0.f, 0.f, 0.f, 0.f}};
            if (ROLE == 0) {
#pragma unroll
                for (int tn = 0; tn < 2; ++tn) { f32x4 t1 = {0.f, 0.f, 0.f, 0.f};
#pragma unroll
                    for (int s = 0; s < 4; ++s) t1 = MFMA16(B[u].a4[s], sf[tn][s], t1);
                    const float v0 = bflo(B[u].u[tn].x) - t1[0], v1 = bfhi(B[u].u[tn].x) - t1[1], v2 = bflo(B[u].u[tn].y) - t1[2], v3 = bfhi(B[u].u[tn].y) - t1[3];
                    u32x2 w; w.x = pk2(v0, v1); w.y = pk2(v2, v3);
                    *(LAS u32x2*)(VT + (16 * tn + r16) * 72 + 16 * tm + 4 * q4) = w; }
            } else {
#pragma unroll
                for (int tn = 0; tn < 2; ++tn)
#pragma unroll
                    for (int s = 0; s < 4; ++s) o[tn] = MFMA16(sf[tn][s], B[u].a4[s], o[tn]);
            }
            accS[0] *= B[u].eg; accS[1] *= B[u].eg;
            LDS_WAIT(); __builtin_amdgcn_s_barrier(); asm volatile("" ::: "memory");
            bf16x8 vf[2][2];
#pragma unroll
            for (int tn = 0; tn < 2; ++tn)
#pragma unroll
                for (int s = 0; s < 2; ++s) vf[tn][s] = *(const LAS bf16x8*)(VT + (16 * tn + r16) * 72 + 32 * s + 8 * q4);
#pragma unroll
            for (int tn = 0; tn < 2; ++tn) {
#pragma unroll
                for (int s = 0; s < 2; ++s) accS[tn] = MFMA16(B[u].kd[s], vf[tn][s], accS[tn]);
                u32x2 w; w.x = pk2(accS[tn][0], accS[tn][1]); w.y = pk2(accS[tn][2], accS[tn][3]);
                *(LAS u32x2*)(STn + (16 * tn + r16) * 136 + 16 * wave + 4 * q4) = w; }
            if (ROLE) {
#pragma unroll
                for (int tn = 0; tn < 2; ++tn) {
#pragma unroll
                    for (int s = 0; s < 2; ++s) o[tn] = MFMA16(vf[tn][s], B[u].a2[s], o[tn]);
                    u32x2 w; w.x = pk2(o[tn][0], o[tn][1]); w.y = pk2(o[tn][2], o[tn][3]);
                    if (HOT < 2) *(u32x2*)(ocat + (size_t)(64 * c + 16 * tm + r16) * D_ + h * 128 + vs * 32 + 16 * tn + 4 * q4) = w; else asm volatile("" :: "v"(w.x), "v"(w.y)); }
            }
            { const int cn = (c + 4 < 256) ? c + 4 : 255; SCAN_LOAD(B[u], cn); }
            LDS_WAIT(); __builtin_amdgcn_s_barrier(); asm volatile("" ::: "memory");
        }
    }
#undef SCAN_LOAD
}
template <int HOT>
__device__ __forceinline__ void scan_phase(const Params& p, LAS unsigned char* lds, const int tid_in) {
    const int tid = tid_in, lane = tid & 63, wave = __builtin_amdgcn_readfirstlane(tid >> 6);
    const int h = (int)blockIdx.x & 7, vs = (int)blockIdx.x >> 3;
    LAS bf16_t* ST = (LAS bf16_t*)lds;
    LAS bf16_t* VT = (LAS bf16_t*)(lds + 17408);
    for (int u = tid; u < 2 * 32 * 136 / 2; u += 512) ((LAS unsigned*)ST)[u] = 0u;
    __syncthreads();
    if (wave < 4) scan_loop<0, HOT>(p, ST, VT, h, vs, wave, lane); else scan_loop<1, HOT>(p, ST, VT, h, vs, wave, lane);
    __syncthreads();
}


__device__ __forceinline__ void sb_attn_phase(const Params& p, LAS unsigned char* lds, int l, int first_blk, int nblk, const int tid_in) {
    const int tid = tid_in, lane = tid & 63, wave = __builtin_amdgcn_readfirstlane(tid >> 6);
    const int r16 = lane & 15, q4 = lane >> 4;
    LAS bf16_t* Qs = (LAS bf16_t*)lds; LAS bf16_t* Ks = (LAS bf16_t*)(lds + 34816); LAS bf16_t* Vs = (LAS bf16_t*)(lds + 52224);
    LAS float* Z = (LAS float*)(lds + 70656); LAS bf16_t* As = (LAS bf16_t*)(lds + 103936); LAS float* SegTot = (LAS float*)(lds + 122368);
    const bf16_t* proj = (const bf16_t*)(p.ws + WS_PROJ);
    bf16_t* ocat = (bf16_t*)(p.ws + WS_OCAT);
    const float* gq = p.sbq + l * 128; const float* gk = p.sbk + l * 128;
    const int q = tid & 127, seg = tid >> 7;
    for (int item = (int)blockIdx.x - first_blk; item < 1024; item += nblk) {
        const int h = item & 7, qb = 127 - (item >> 3);
#pragma unroll
        for (int u = 0; u < 4; ++u) { const int ch = tid + 512 * u, row = ch >> 4, c8 = ch & 15;
            float xv[8]; unpack8(*(const u32x4*)(proj + (size_t)(128 * qb + row) * NIN + PQ_B + h * 128 + 8 * c8), xv);
            float ss = 0.f;
#pragma unroll
            for (int e = 0; e < 8; ++e) ss += xv[e] * xv[e];
            ss += __shfl_xor(ss, 1); ss += __shfl_xor(ss, 2); ss += __shfl_xor(ss, 4); ss += __shfl_xor(ss, 8);
            const float sc = rsqrtf(ss * (1.f / 128.f) + EPS_) * 0.08838834764831845f;
#pragma unroll
            for (int e = 0; e < 8; ++e) xv[e] *= sc * gq[8 * c8 + e];
            *(LAS u32x4*)(Qs + row * 136 + 8 * c8) = pack8(xv); }
        f32x4 oacc[8];
#pragma unroll
        for (int tn = 0; tn < 8; ++tn) oacc[tn] = (f32x4){0.f, 0.f, 0.f, 0.f};
        float Rq = 0.f;
        const int tq = 128 * qb + q;
        u32x4 kreg[2], vreg[2];
#pragma unroll
        for (int u = 0; u < 2; ++u) { const int ch = tid + 512 * u, row = ch >> 4, c8 = ch & 15; const size_t rb = (size_t)(64 * (2 * qb + 1) + row) * NIN + h * 128 + 8 * c8;
            kreg[u] = *(const u32x4*)(proj + rb + PK_B); vreg[u] = *(const u32x4*)(proj + rb + PV_B); }
        for (int j = 2 * qb + 1; j >= 0; --j) {
#pragma unroll
            for (int u = 0; u < 2; ++u) { const int ch = tid + 512 * u, row = ch >> 4, c8 = ch & 15;
                float xv[8]; unpack8(kreg[u], xv);
                float ss = 0.f;
#pragma unroll
                for (int e = 0; e < 8; ++e) ss += xv[e] * xv[e];
                ss += __shfl_xor(ss, 1); ss += __shfl_xor(ss, 2); ss += __shfl_xor(ss, 4); ss += __shfl_xor(ss, 8);
                const float sc = rsqrtf(ss * (1.f / 128.f) + EPS_);
#pragma unroll
                for (int e = 0; e < 8; ++e) xv[e] *= sc * gk[8 * c8 + e];
                *(LAS u32x4*)(Ks + row * 136 + 8 * c8) = pack8(xv);
                *(LAS u32x4*)(Vs + row * 136 + 8 * c8) = vreg[u]; }
            { const int jn = j > 0 ? j - 1 : 0;
#pragma unroll
              for (int u = 0; u < 2; ++u) { const int ch = tid + 512 * u, row = ch >> 4, c8 = ch & 15; const size_t rb = (size_t)(64 * jn + row) * NIN + h * 128 + 8 * c8;
                  kreg[u] = *(const u32x4*)(proj + rb + PK_B); vreg[u] = *(const u32x4*)(proj + rb + PV_B); } }
            __syncthreads();
            { bf16x8 qf[4];
#pragma unroll
              for (int s = 0; s < 4; ++s) qf[s] = *(const LAS bf16x8*)(Qs + (16 * wave + r16) * 136 + 32 * s + 8 * q4);
#pragma unroll
              for (int tn = 0; tn < 4; ++tn) { f32x4 acc = {0.f, 0.f, 0.f, 0.f};
#pragma unroll
                  for (int s = 0; s < 4; ++s) { const bf16x8 kf = *(const LAS bf16x8*)(Ks + (16 * tn + r16) * 136 + 32 * s + 8 * q4); acc = MFMA16(qf[s], kf, acc); }
#pragma unroll
                  for (int rg = 0; rg < 4; ++rg) Z[(16 * wave + 4 * q4 + rg) * 65 + 16 * tn + r16] = acc[rg]; } }
            __syncthreads();
            float zz[16], ls[16], suf[16]; const int s0 = 64 * j + 16 * seg;
#pragma unroll
            for (int e = 0; e < 16; ++e) { zz[e] = Z[q * 65 + 16 * seg + e]; ls[e] = (s0 + e < tq) ? -softplus_fast(zz[e]) : 0.f; }
            float run = 0.f;
#pragma unroll
            for (int e = 15; e >= 0; --e) { suf[e] = run; run += ls[e]; }
            SegTot[seg * 128 + q] = run;
            __syncthreads();
            float hi = 0.f, all = 0.f;
#pragma unroll
            for (int sg = 0; sg < 4; ++sg) { const float tv = SegTot[sg * 128 + q]; all += tv; if (sg > seg) hi += tv; }
            const float base = Rq + hi; float av[16];
#pragma unroll
            for (int e = 0; e < 16; ++e) av[e] = (s0 + e < tq) ? __expf(zz[e] + ls[e] + base + suf[e]) : 0.f;
            Rq += all;
            *(LAS u32x4*)(As + q * 72 + 16 * seg) = pack8(av); *(LAS u32x4*)(As + q * 72 + 16 * seg + 8) = pack8(av + 8);
            __syncthreads();
            { bf16x8 af[2];
#pragma unroll
              for (int s = 0; s < 2; ++s) af[s] = *(const LAS bf16x8*)(As + (16 * wave + r16) * 72 + 32 * s + 8 * q4);
#pragma unroll
              for (int tn = 0; tn < 8; ++tn)
#pragma unroll
                  for (int s = 0; s < 2; ++s) {
                      const LAS bf16_t* vp = Vs + (32 * s + 8 * q4 + (r16 >> 2)) * 136 + 16 * tn + 4 * (r16 & 3);
                      const s16x4 t0 = __builtin_amdgcn_ds_read_tr16_b64_v4i16((LAS s16x4*)vp), t1 = __builtin_amdgcn_ds_read_tr16_b64_v4i16((LAS s16x4*)(vp + 4 * 136));
                      const bf16x8 vf = {t0[0], t0[1], t0[2], t0[3], t1[0], t1[1], t1[2], t1[3]};
                      oacc[tn] = MFMA16(vf, af[s], oacc[tn]); } }
            if (!__syncthreads_or(Rq >= -104.f)) break;
        }
        __syncthreads();
#pragma unroll
        for (int tn = 0; tn < 8; ++tn) { u32x2 w; w.x = pk2(oacc[tn][0], oacc[tn][1]); w.y = pk2(oacc[tn][2], oacc[tn][3]);
            *(u32x2*)(ocat + (size_t)(128 * qb + 16 * wave + r16) * D_ + 1024 + h * 128 + 16 * tn + 4 * q4) = w; }
    }
}

__device__ __forceinline__ void gdn_finalize_phase(const Params& p, int l, const int tid_in) {
    const int g = opaque_bid() * 512 + tid_in, l16 = g & 15;
    bf16_t* ocat = (bf16_t*)(p.ws + WS_OCAT); const bf16_t* proj = (const bf16_t*)(p.ws + WS_PROJ);
    float gn[8];
#pragma unroll
    for (int e = 0; e < 8; ++e) gn[e] = p.gdn_norm[l * 128 + 8 * l16 + e];
#pragma unroll 4
    for (int R = g >> 4; R < T_ * NH; R += ((int)gridDim.x * 512) >> 4) {
        const int t = R >> 3, h = R & 7;
        u32x4* op = (u32x4*)(ocat + (size_t)t * D_ + h * 128 + 8 * l16);
        float ov[8], zv[8]; unpack8(*op, ov); unpack8(*(const u32x4*)(proj + (size_t)t * NIN + PZ_A + h * 128 + 8 * l16), zv);
        float ss = 0.f;
#pragma unroll
        for (int e = 0; e < 8; ++e) ss += ov[e] * ov[e];
        ss += __shfl_xor(ss, 1); ss += __shfl_xor(ss, 2); ss += __shfl_xor(ss, 4); ss += __shfl_xor(ss, 8);
        const float rs = rsqrtf(ss * (1.f / 128.f) + EPS_);
#pragma unroll
        for (int e = 0; e < 8; ++e) ov[e] = ov[e] * rs * gn[e] * silu_f(zv[e]);
        *op = pack8(ov);
    }
}

__device__ __forceinline__ void act_fix_rows(const Params& p, int l, const int tid_in, const int pm) {
    bf16_t* V = (bf16_t*)(p.ws + WS_V); const bf16_t* Gh = (const bf16_t*)(p.ws + WS_G); const bf16_t* Gt = (const bf16_t*)(p.ws + WS_G + 8 * MiB); const bf16_t* Vh = (const bf16_t*)(p.ws + WS_G + 16 * MiB);
    const float* cw = p.conv_ffn + (size_t)l * 3 * DFF;
    for (int it = tid_in; it < 8 * 704; it += 512) {
        const int q = it / 704, cc = it % 704, col = 8 * cc, sp = 4 * pm + (q >> 1), rs = q & 1;
        float w0[8], w1[8], w2[8], ga[8], gb[8], gc[8], vv[8], o[8];
#pragma unroll
        for (int e = 0; e < 8; ++e) { w0[e] = cw[col + e]; w1[e] = cw[DFF + col + e]; w2[e] = cw[2 * DFF + col + e]; }
        const int spm = sp > 0 ? sp - 1 : 0;
        const bf16_t* pa = rs ? Gt + (size_t)(spm * 2 + 1) * DFF + col : Gt + (size_t)(spm * 2) * DFF + col;
        const bf16_t* pb = rs ? Gh + (size_t)(sp * 2) * DFF + col : Gt + (size_t)(spm * 2 + 1) * DFF + col;
        const bf16_t* pc = rs ? Gh + (size_t)(sp * 2 + 1) * DFF + col : Gh + (size_t)(sp * 2) * DFF + col;
        unpack8(*(const u32x4*)pa, ga); unpack8(*(const u32x4*)pb, gb); unpack8(*(const u32x4*)pc, gc);
        const float za = (sp > 0) ? 1.f : 0.f, zb = (sp > 0 || rs) ? 1.f : 0.f;
#pragma unroll
        for (int e = 0; e < 8; ++e) { ga[e] *= za; gb[e] *= zb; }
        unpack8(*(const u32x4*)(Vh + (size_t)(sp * 2 + rs) * DFF + col), vv);
#pragma unroll
        for (int e = 0; e < 8; ++e) o[e] = silu_f(w0[e] * ga[e] + w1[e] * gb[e] + w2[e] * gc[e]) * vv[e];
        *(u32x4*)(V + ((size_t)64 * sp + rs) * DFF + col) = pack8(o);
    }
}

__global__ void __launch_bounds__(512) fwd_megakernel(Params p) {
    extern __shared__ __attribute__((aligned(16))) unsigned char lds_raw[];
    LAS unsigned char* lds = (LAS unsigned char*)lds_raw;
    cg::grid_group grid = cg::this_grid();
    const int wave_sg = __builtin_amdgcn_readfirstlane((int)threadIdx.x >> 6);
    if (threadIdx.x < 4) ((volatile LAS unsigned*)(lds + 131072))[threadIdx.x] = 0u;
    __syncthreads();
    (void)xcd_barrier_post((unsigned*)(p.ws + WS_BAR), (volatile LAS unsigned*)(lds + 131072));
    if (p.ph_hi < 0) grid.sync();
#if defined(__HIP_DEVICE_COMPILE__)
#define GRID_BARRIER() xcd_barrier((unsigned*)(((const __attribute__((address_space(4))) Params*)__builtin_amdgcn_kernarg_segment_ptr())->ws + WS_BAR), (volatile LAS unsigned*)(lds + 131072), wave_sg == 0 && lane_id_hw() == 0)
#else
#define GRID_BARRIER() xcd_barrier((unsigned*)(p.ws + WS_BAR), (volatile LAS unsigned*)(lds + 131072), wave_sg == 0 && lane_id_hw() == 0)
#endif
    const int lo = p.ph_lo, hi = p.ph_hi;
    int ph = 0;
#ifndef REP_MASK
#define REP_MASK 0
#endif
#if defined(__HIP_DEVICE_COMPILE__)
#define LOAD_ARGS const __attribute__((address_space(4))) Params* kp_ = (const __attribute__((address_space(4))) Params*)__builtin_amdgcn_kernarg_segment_ptr(); asm volatile("" : "+s"(kp_)); Params pp = *kp_;
#else
#define LOAD_ARGS Params pp = p;
#endif
#define PHASE_BEGIN if (ph >= lo && ph < hi) { const int nrep_ = 1 + ((REP_MASK >> ph) & 1); for (int rep_ = 0; rep_ < nrep_; ++rep_) { if (rep_) GRID_BARRIER(); LOAD_ARGS int ll = l; int tid_ = (wave_sg << 6) | lane_id_hw(); asm volatile("" : "+v"(tid_)); asm volatile("" : "+s"(pp.ws), "+s"(ll)); asm volatile("" : "+s"(pp.out));
#define PHASE_END } } ++ph; if (ph > lo && ph < hi) GRID_BARRIER();
    { const int l = 0; PHASE_BEGIN p0_phase(pp, lds, tid_); PHASE_END }
#ifdef REP_SCAN
#define REP_SCAN_N REP_SCAN
#else
#define REP_SCAN_N 0
#endif
#ifdef REP_ATTN
#define REP_ATTN_N 1
#else
#define REP_ATTN_N 0
#endif
#define LAYER_BODY(l)  \
        PHASE_BEGIN norm_phase(pp, lds, (ll == 0) ? pp.x : (const float*)pp.out, pp.norm1 + ll * D_, ll, 0, 2048, ll == 0, tid_); PHASE_END \
        PHASE_BEGIN { GAS unsigned char* wl = pp.ws + WS_W + (size_t)ll * W_LAYER; \
            win_small_cols(pp, lds, ll, tid_); pg8::Gemm g{(const bf16_t*)(pp.ws + WS_H), (const bf16_t*)(wl + W_IN_OFF), T_, 7168, D_}; pg8::StaticOrder S; S.init(T_, 7168, (int)gridDim.x, (int)blockIdx.x); \
            pg8::EpiBf16 E{(bf16_t*)(pp.ws + WS_PROJ), NIN, 0, 0}; pg8::gemm_phase(lds, g, S, E, tid_); } PHASE_END \
        PHASE_BEGIN gdn_prep_phase(pp, lds, ll, tid_); PHASE_END \
        PHASE_BEGIN if ((int)blockIdx.x < 32) { scan_phase<0>(pp, lds, tid_); \
            if (REP_SCAN_N) { __syncthreads(); scan_phase<(REP_SCAN_N > 0 ? REP_SCAN_N - 1 : 0)>(pp, lds, tid_); } \
            } else { sb_attn_phase(pp, lds, ll, 32, (int)gridDim.x - 32, tid_); \
            if (REP_ATTN_N) { __syncthreads(); sb_attn_phase(pp, lds, ll, 32, (int)gridDim.x - 32, tid_); } \
            { __syncthreads(); const int gw_ = ((int)blockIdx.x - 32) * 8 + (tid_ >> 6), ng_ = ((int)gridDim.x - 32) * 8;        \
              weight_transposes(pp, lds, tid_, l, 2 | 4 | 8, gw_, ng_); if (l == 0) weight_transposes(pp, lds, tid_, 1, 1, gw_, ng_); } \
            } PHASE_END \
        PHASE_BEGIN gdn_finalize_phase(pp, ll, tid_); PHASE_END \
        PHASE_BEGIN { GAS unsigned char* wl = pp.ws + WS_W + (size_t)ll * W_LAYER; const float* modf = (const float*)(pp.ws + WS_MODF) + ll * 12288; \
            pg8::Gemm g{(const bf16_t*)(pp.ws + WS_OCAT), (const bf16_t*)(wl + W_OUT_OFF), T_, D_, D_}; pg8::StaticOrder S; S.init(T_, D_, (int)gridDim.x, (int)blockIdx.x); \
            pg8::EpiRes E{(ll == 0) ? pp.x : (const float*)pp.out, (float*)pp.out, D_, modf + 4096}; pg8::gemm_phase(lds, g, S, E, tid_); } PHASE_END \
        PHASE_BEGIN norm_phase(pp, lds, (const float*)pp.out, pp.norm2 + ll * D_, ll, 6144, 8192, false, tid_); PHASE_END \
        PHASE_BEGIN { GAS unsigned char* wl = pp.ws + WS_W + (size_t)ll * W_LAYER; \
            pg8::Gemm g{(const bf16_t*)(pp.ws + WS_H), (const bf16_t*)(wl + W_UP_OFF), T_, NUP, D_}; pg8::StaticOrder S; S.init(T_, NUP, (int)gridDim.x, (int)blockIdx.x); \
            pg8::EpiAct E{(bf16_t*)(pp.ws + WS_V), (bf16_t*)(pp.ws + WS_G), (bf16_t*)(pp.ws + WS_G + 8 * MiB), (bf16_t*)(pp.ws + WS_G + 16 * MiB), pp.conv_ffn + (size_t)ll * 3 * DFF}; pg8::gemm_phase(lds, g, S, E, tid_); } PHASE_END \
        PHASE_BEGIN { GAS unsigned char* wl = pp.ws + WS_W + (size_t)ll * W_LAYER; const float* modf = (const float*)(pp.ws + WS_MODF) + ll * 12288; \
            pg8::Gemm g{(const bf16_t*)(pp.ws + WS_V), (const bf16_t*)(wl + W_DN_OFF), T_, D_, DFF}; pg8::StaticOrder S; S.init(T_, D_, (int)gridDim.x, (int)blockIdx.x); \
            { pg8::Unit uu_; int last_ = -1; for (int i_ = 0; S.next(i_, uu_); ++i_) if (uu_.pm != last_) { act_fix_rows(pp, ll, tid_, uu_.pm); last_ = uu_.pm; } asm volatile("s_waitcnt vmcnt(0)" ::: "memory"); __syncthreads(); } \
            pg8::EpiRes E{(const float*)pp.out, (float*)pp.out, D_, modf + 10240}; pg8::gemm_phase(lds, g, S, E, tid_); } PHASE_END \

    { const int l = 0; LAYER_BODY(l) }
    { const int l = 1; LAYER_BODY(l) }
#undef LAYER_BODY
#undef PHASE_BEGIN
#undef PHASE_END
#ifdef EXTRA_SYNCS
    for (int e = 0; e < EXTRA_SYNCS; ++e) GRID_BARRIER();
#endif
#ifdef DBG_OFF
    GRID_BARRIER();
    { const bf16_t* src = (const bf16_t*)(p.ws + (size_t)DBG_OFF);
      for (size_t i = (size_t)blockIdx.x * 512 + ((wave_sg << 6) | lane_id_hw()); i < (size_t)T_ * D_; i += (size_t)gridDim.x * 512) p.out[i] = bf2f(src[i]); }
#endif
}

extern "C" void kernel_launch(void* const* d_in, const int* in_sizes, int n_in, void* d_out, int out_size, void* d_ws, size_t ws_size, hipStream_t stream) {
    static int grid = 0;
    if (grid == 0) {
        if (n_in != 17 || ws_size < WS_END) { fprintf(stderr, "kernel_launch: expected 17 inputs and >= %zu bytes of workspace; got %d, %zu\n", (size_t)WS_END, n_in, ws_size); grid = -1; return; }
        int dev = 0, cus = 0, per_cu = 0;
        hipGetDevice(&dev); hipDeviceGetAttribute(&cus, hipDeviceAttributeMultiprocessorCount, dev);
        if (hipFuncSetAttribute((const void*)fwd_megakernel, hipFuncAttributeMaxDynamicSharedMemorySize, LDS_BYTES) != hipSuccess) { fprintf(stderr, "kernel_launch: hipFuncSetAttribute failed\n"); grid = -1; return; }
        hipOccupancyMaxActiveBlocksPerMultiprocessor(&per_cu, (const void*)fwd_megakernel, 512, LDS_BYTES);
        if (per_cu < 1) { fprintf(stderr, "kernel_launch: occupancy query says %d blocks/CU\n", per_cu); per_cu = 1; }
        (void)hipGetLastError();
        grid = cus;
        if (grid > 256) grid = 256;
    }
    if (grid < 0) return;
    Params p{};
    p.x = (const float*)d_in[0]; p.c = (const float*)d_in[1]; p.w_ada = (const float*)d_in[2]; p.b_ada = (const float*)d_in[3]; p.norm1 = (const float*)d_in[4];
    p.w_in = (const float*)d_in[5]; p.conv_qkv = (const float*)d_in[6]; p.a_log = (const float*)d_in[7]; p.dt_bias = (const float*)d_in[8]; p.gdn_norm = (const float*)d_in[9];
    p.sbq = (const float*)d_in[10]; p.sbk = (const float*)d_in[11]; p.w_out = (const float*)d_in[12]; p.norm2 = (const float*)d_in[13]; p.w_up = (const float*)d_in[14];
    p.conv_ffn = (const float*)d_in[15]; p.w_down = (const float*)d_in[16];
    p.out = (GAS float*)d_out; p.ws = (GAS unsigned char*)d_ws; p.ph_lo = 0; p.ph_hi = 19;
#ifdef DBG_HI
    p.ph_hi = DBG_HI;
#endif
    if (hipMemsetAsync((char*)d_ws + WS_BAR, 0, XCD_BAR_WORDS * 4, stream) != hipSuccess) { fprintf(stderr, "kernel_launch: hipMemsetAsync failed\n"); return; }
    void* args[] = {&p};
    hipError_t e = hipLaunchCooperativeKernel((const void*)fwd_megakernel, dim3(grid), dim3(512), args, LDS_BYTES, stream);
    if (e != hipSuccess) fprintf(stderr, "cooperative launch failed: %s (grid %d)\n", hipGetErrorString(e), grid);
}
```

```cpp
#define REP_S1 2
#include <hip/hip_runtime.h>
#include <hip/hip_cooperative_groups.h>
#include <cstdio>
#include <cstdint>
namespace cg = cooperative_groups;

#define LAS __attribute__((address_space(3)))
#define GAS __attribute__((address_space(1)))
typedef unsigned short bf16_t;
typedef short bf16x8 __attribute__((ext_vector_type(8)));
typedef short s16x4 __attribute__((ext_vector_type(4)));
typedef float f32x4 __attribute__((ext_vector_type(4)));
typedef float f32x2 __attribute__((ext_vector_type(2)));
typedef unsigned u32x4 __attribute__((ext_vector_type(4)));
typedef unsigned u32x2 __attribute__((ext_vector_type(2)));

constexpr int T_ = 16384, D_ = 2048, DIN = 7184, NIN = 7424, DFF = 5632, NUP = 11264, NH = 8;
constexpr int PQ_A = 0, PK_A = 1024, PV_A = 2048, PZ_A = 3072, PQ_B = 4096, PK_B = 5120, PV_B = 6144, PBETA = 7168, PALPHA = 7176;
constexpr int KS_MOD = 16;
constexpr float EPS_ = 1e-6f;
constexpr size_t MiB = 1024ull * 1024ull;
constexpr size_t WS_MODF = 0;
constexpr size_t WS_MODP = 131072;
constexpr size_t WS_EGL = 1835008;
constexpr size_t WS_PROG = 1900544;
constexpr size_t WS_BAR = 1904640;
constexpr size_t WS_W = 2 * MiB;
constexpr size_t W_IN_OFF = 0, W_OUT_OFF = 29 * MiB, W_UP_OFF = 37 * MiB, W_DN_OFF = 81 * MiB, W_LAYER = 103 * MiB;
constexpr size_t WS_H = 208 * MiB;
constexpr size_t WS_PROJ = 272 * MiB;
constexpr size_t WS_G = 272 * MiB, WS_V = 448 * MiB;
constexpr size_t WS_OCAT = 504 * MiB;
constexpr size_t WS_GDN = 568 * MiB;
constexpr size_t WS_END = 712 * MiB;
constexpr int LDS_BYTES = 131072 + 256;

struct Params {
    const float *x, *c, *w_ada, *b_ada, *norm1, *w_in, *conv_qkv, *a_log, *dt_bias, *gdn_norm, *sbq, *sbk, *w_out, *norm2, *w_up, *conv_ffn, *w_down;
    GAS float* out; GAS unsigned char* ws; int ph_lo, ph_hi;
};

typedef __bf16 bf16v2 __attribute__((ext_vector_type(2)));
__device__ __forceinline__ unsigned pk2(float lo, float hi) { const f32x2 v = {lo, hi}; union { bf16v2 b; unsigned u; } x; x.b = __builtin_convertvector(v, bf16v2); return x.u; }
__device__ __forceinline__ float bf2f(bf16_t b) { return __uint_as_float(((unsigned)b) << 16); }
__device__ __forceinline__ float bflo(unsigned w) { return __uint_as_float(w << 16); }
__device__ __forceinline__ float bfhi(unsigned w) { return __uint_as_float(w & 0xffff0000u); }
__device__ __forceinline__ void unpack8(const u32x4 v, float* f) { f[0] = bflo(v.x); f[1] = bfhi(v.x); f[2] = bflo(v.y); f[3] = bfhi(v.y); f[4] = bflo(v.z); f[5] = bfhi(v.z); f[6] = bflo(v.w); f[7] = bfhi(v.w); }
__device__ __forceinline__ u32x4 pack8(const float* f) { u32x4 o; o.x = pk2(f[0], f[1]); o.y = pk2(f[2], f[3]); o.z = pk2(f[4], f[5]); o.w = pk2(f[6], f[7]); return o; }
__device__ __forceinline__ float silu_f(float y) { return y * __builtin_amdgcn_rcpf(1.0f + __expf(-y)); }
__device__ __forceinline__ float softplus_f(float z) { return fmaxf(z, 0.f) + log1pf(__expf(-fabsf(z))); }
__device__ __forceinline__ float softplus_fast(float z) { return fmaxf(z, 0.f) + __logf(1.0f + __expf(-fabsf(z))); }
__device__ __forceinline__ float wave_sum(float v) {
#pragma unroll
    for (int o = 1; o < 64; o <<= 1) v += __shfl_xor(v, o);
    return v;
}
__device__ __forceinline__ bf16x8 as_bf8(u32x4 v) { union { u32x4 u; bf16x8 b; } x; x.u = v; return x.b; }
#define MFMA16(a, b, c) __builtin_amdgcn_mfma_f32_16x16x32_bf16((a), (b), (c), 0, 0, 0)
#define LDS_WAIT() asm volatile("s_waitcnt lgkmcnt(0)" ::: "memory")
__device__ __forceinline__ int lane_id_hw() { return (int)__builtin_amdgcn_mbcnt_hi(~0u, __builtin_amdgcn_mbcnt_lo(~0u, 0u)); }
__device__ __forceinline__ int opaque_bid() { int b = (int)blockIdx.x; asm volatile("" : "+s"(b)); return b; }


#define XB_TMO      128
#define XB_XCNT(j)  (256  + 64 * (j))
#define XB_XSUB(j)  (1280 + 64 * (j))
#define XB_XGEN(j)  (2304 + 64 * (j))
#define XB_TOP      3328
#define XB_TOPGEN   3392
#define XCD_BAR_WORDS 3456
#define XB_SPIN_CAP (1u << 18)
__device__ __forceinline__ unsigned xb_ld(unsigned* p)              { return __hip_atomic_load(p, __ATOMIC_RELAXED, __HIP_MEMORY_SCOPE_AGENT); }
__device__ __forceinline__ unsigned xb_add(unsigned* p, unsigned v) { return __hip_atomic_fetch_add(p, v, __ATOMIC_RELAXED, __HIP_MEMORY_SCOPE_AGENT); }
__device__ __forceinline__ unsigned xb_xcc_id() { return (unsigned)__builtin_amdgcn_s_getreg((3 << 11) | 20) & 0xFu; }
#define XB_SPIN(cond, bar) do { unsigned _sp = 0; while (cond) { __builtin_amdgcn_s_sleep(1); \
    if ((++_sp & 255u) == 0u) { if (xb_ld(&(bar)[XB_TMO])) break; if (_sp > XB_SPIN_CAP) { atomicAdd(&(bar)[XB_TMO], 1u); break; } } } } while (0)
struct XcdBarrier { unsigned* bar; unsigned x; volatile LAS unsigned* st; };
__device__ __forceinline__ XcdBarrier xcd_barrier_post(unsigned* bar, volatile LAS unsigned* st) {
    XcdBarrier b; b.bar = bar; b.x = xb_xcc_id(); b.st = st;
    if (threadIdx.x == 0) (void)xb_add(&bar[XB_XCNT(b.x)], 1u);
    return b;
}
__device__ __forceinline__ void xcd_barrier_complete(unsigned* bar, unsigned x, unsigned& nloc, unsigned& nx) {
    const unsigned G = gridDim.x * gridDim.y * gridDim.z;
    unsigned sum, cnt, mine, sp = 0u;
    for (;;) {
        sum = 0u; cnt = 0u; mine = 0u;
#pragma unroll
        for (unsigned j = 0; j < 16; ++j) { const unsigned c = xb_ld(&bar[XB_XCNT(j)]); sum += c; cnt += (c > 0u) ? 1u : 0u; mine = (j == x) ? c : mine; }
        if (sum == G) break;
        __builtin_amdgcn_s_sleep(1);
        if ((++sp & 255u) == 0u) { if (xb_ld(&bar[XB_TMO])) break; if (sp > XB_SPIN_CAP) { atomicAdd(&bar[XB_TMO], 1u); break; } }
    }
    nloc = mine > 0u ? mine : 1u; nx = cnt > 0u ? cnt : 1u;
}
__device__ __forceinline__ void xcd_barrier(unsigned* bar, volatile LAS unsigned* st, const bool is_t0) {
    asm volatile("s_waitcnt vmcnt(0)" ::: "memory");
    __syncthreads();
    if (is_t0) {
        const unsigned x = xb_xcc_id();
        __builtin_amdgcn_s_waitcnt(0);
        unsigned nloc = st[0], nx = st[1];
        if (nloc == 0u) { xcd_barrier_complete(bar, x, nloc, nx); st[0] = nloc; st[1] = nx; }
        const unsigned old = xb_add(&bar[XB_XSUB(x)], 1u);
        const unsigned gen = old / nloc;
        if (old + 1u == (gen + 1u) * nloc) {
            __builtin_amdgcn_fence(__ATOMIC_RELEASE, "agent");
            asm volatile("s_waitcnt vmcnt(0)" ::: "memory");
            const unsigned og = xb_add(&bar[XB_TOP], 1u);
            const unsigned tg = og / nx;
            if (og + 1u == (tg + 1u) * nx) xb_add(&bar[XB_TOPGEN], 1u);
            else XB_SPIN(xb_ld(&bar[XB_TOPGEN]) == tg, bar);
            __builtin_amdgcn_fence(__ATOMIC_ACQUIRE, "agent");
            xb_add(&bar[XB_XGEN(x)], 1u);
            asm volatile("s_waitcnt vmcnt(0)" ::: "memory");
        } else {
            XB_SPIN(xb_ld(&bar[XB_XGEN(x)]) == gen, bar);
            __builtin_amdgcn_fence(__ATOMIC_ACQUIRE, "agent");
            asm volatile("s_waitcnt vmcnt(0)" ::: "memory");
        }
    }
    __syncthreads();
}

namespace pg8 {
constexpr int BM = 256, BK = 64, HALF = 128, HTB = HALF * BK * 2, STAGE_BYTES = 8 * HTB, NXCD = 8, WGM = 8;
__host__ __device__ __forceinline__ int lds_byte(int r, int c) { const int st = (r >> 4) * 2 + (c >> 5), rr = r & 15, cc = c & 31, ob = rr * 64 + cc * 2; return st * 1024 + (ob ^ (((ob >> 9) & 1) << 5)); }
__host__ __device__ __forceinline__ void stage_rc(int b, int& R, int& C) { const int st = b / 1024, sb = b % 1024, swz = sb ^ (((sb >> 9) & 1) << 5); R = (st >> 1) * 16 + swz / 64; C = (st & 1) * 32 + (swz % 64) / 2; }
__host__ __device__ __forceinline__ int perm32(int rho) { const int n = rho >> 4, i = rho & 15; return 8 * (i >> 2) + 4 * n + (i & 3); }
struct Unit { int pm, pn; };
struct Gemm { const bf16_t* A; const bf16_t* Bt; int M, N, K; };
struct StaticOrder {
    int nM, nN, nwg, G, c;
    __device__ __forceinline__ void init(int M, int N, int G_, int c_) { nM = M / BM; nN = N / BM; nwg = nM * nN; G = G_; c = c_; }
    __device__ __forceinline__ bool next(int i, Unit& u) const {
        const long L = (long)i * G + c; if (L >= nwg) return false;
        int wgid = (int)L; { const int q = nwg / NXCD, r = nwg % NXCD, xcd = wgid % NXCD, off = wgid / NXCD; wgid = (xcd < r ? xcd * (q + 1) : r * (q + 1) + (xcd - r) * q) + off; }
        const int nig = WGM * nN, gid = wgid / nig, fm = gid * WGM, gsz = (nM - fm) < WGM ? (nM - fm) : WGM;
        u.pm = fm + ((wgid % nig) % gsz); u.pn = (wgid % nig) / gsz; return true;
    }
};
struct EpiBf16 {
    static constexpr bool PERM = true;
    bf16_t* O; int ldc; int split_cols; size_t split_stride;
    __device__ __forceinline__ void operator()(const f32x4 (&acc)[2][2][4][2], const Unit& u, int wr, int wc, int fr, int fq) const {
        const int row0 = u.pm * BM + wr * 64 + fr; int colt = u.pn * BM; bf16_t* base = O;
        if (split_cols) { const int t = colt / split_cols; base += (size_t)t * split_stride; colt -= t * split_cols; }
        const int col0 = colt + wc * 32 + 8 * fq;
#pragma unroll
        for (int ai = 0; ai < 2; ++ai)
#pragma unroll
            for (int m = 0; m < 4; ++m) { bf16_t* rowp = base + (size_t)(row0 + ai * HALF + m * 16) * ldc + col0;
#pragma unroll
                for (int bj = 0; bj < 2; ++bj) { const f32x4 v0 = acc[ai][bj][m][0], v1 = acc[ai][bj][m][1];
                    u32x4 w; w.x = pk2(v0[0], v0[1]); w.y = pk2(v0[2], v0[3]); w.z = pk2(v1[0], v1[1]); w.w = pk2(v1[2], v1[3]);
                    *(u32x4*)(rowp + bj * HALF) = w; } }
    }
};
struct EpiRes {
    static constexpr bool PERM = false;
    const float* xin; float* out; int ldc; const float* gate;
    __device__ __forceinline__ void operator()(const f32x4 (&acc)[2][2][4][2], const Unit& u, int wr, int wc, int fr, int fq) const {
        const int row0 = u.pm * BM + wr * 64 + fr, col0 = u.pn * BM + wc * 32 + 4 * fq;
        f32x4 gv[2][2];
#pragma unroll
        for (int bj = 0; bj < 2; ++bj)
#pragma unroll
            for (int n = 0; n < 2; ++n) gv[bj][n] = *(const f32x4*)(gate + col0 + bj * HALF + n * 16);
#pragma unroll
        for (int ai = 0; ai < 2; ++ai)
#pragma unroll
            for (int m = 0; m < 4; ++m) { const size_t off = (size_t)(row0 + ai * HALF + m * 16) * ldc + col0;
#pragma unroll
                for (int bj = 0; bj < 2; ++bj)
#pragma unroll
                    for (int n = 0; n < 2; ++n) { const f32x4 xv = *(const f32x4*)(xin + off + bj * HALF + n * 16);
                        *(f32x4*)(out + off + bj * HALF + n * 16) = xv + gv[bj][n] * acc[ai][bj][m][n]; }
                asm volatile("" ::: "memory"); }
    }
};

struct EpiAct {
    static constexpr bool PERM = true;
    bf16_t* V; bf16_t* Gh; bf16_t* Gt; bf16_t* Vh; const float* cw;
    __device__ __forceinline__ void operator()(const f32x4 (&acc)[2][2][4][2], const Unit& u, int wr, int wc, int fr, int fq) const {
        const int lane = fr + 16 * fq, ff0 = u.pn * HALF + wc * 32 + 8 * fq;
        float w0[8], w1[8], w2[8];
#pragma unroll
        for (int e = 0; e < 8; ++e) { w0[e] = cw[ff0 + e]; w1[e] = cw[DFF + ff0 + e]; w2[e] = cw[2 * DFF + ff0 + e]; }
        const int src1 = (fr >= 1) ? lane - 1 : lane + 15, src2 = (fr >= 2) ? lane - 2 : lane + 14;
#pragma unroll
        for (int ai = 0; ai < 2; ++ai) { const int strip = 4 * u.pm + 2 * ai + wr; const size_t row_base = (size_t)u.pm * BM + ai * HALF + wr * 64;
#pragma unroll
            for (int m = 0; m < 4; ++m) { float o[8], gr[8];
#pragma unroll
                for (int n = 0; n < 2; ++n)
#pragma unroll
                    for (int j = 0; j < 4; ++j) { const int e = 4 * n + j; const float g0 = acc[ai][0][m][n][j], v = acc[ai][1][m][n][j], gp = (m > 0) ? acc[ai][0][m > 0 ? m - 1 : 0][n][j] : 0.f;
                        const float s1_ = (fr == 15) ? gp : g0, s2_ = (fr >= 14) ? gp : g0;
                        const float g1 = __int_as_float(__builtin_amdgcn_update_dpp(0, __float_as_int(s1_), 0x121, 0xf, 0xf, false)), g2 = __int_as_float(__builtin_amdgcn_update_dpp(0, __float_as_int(s2_), 0x122, 0xf, 0xf, false));
                        const float y = w0[e] * g2 + w1[e] * g1 + w2[e] * g0; const float a = y * __builtin_amdgcn_rcpf(1.0f + __expf(-y)) * v;
                        o[e] = (m == 0 && fr < 2) ? v : a; gr[e] = g0; }
                { u32x4 w; w.x = pk2(o[0], o[1]); w.y = pk2(o[2], o[3]); w.z = pk2(o[4], o[5]); w.w = pk2(o[6], o[7]);
                  *(u32x4*)(V + (row_base + 16 * m + fr) * DFF + ff0) = w;
                  if (m == 0 && fr < 2) *(u32x4*)(Vh + (size_t)(strip * 2 + fr) * DFF + ff0) = w; }
                if (m == 0 && fr < 2) { u32x4 w; w.x = pk2(gr[0], gr[1]); w.y = pk2(gr[2], gr[3]); w.z = pk2(gr[4], gr[5]); w.w = pk2(gr[6], gr[7]); *(u32x4*)(Gh + (size_t)(strip * 2 + fr) * DFF + ff0) = w; }
                if (m == 3 && fr >= 14) { u32x4 w; w.x = pk2(gr[0], gr[1]); w.y = pk2(gr[2], gr[3]); w.z = pk2(gr[4], gr[5]); w.w = pk2(gr[6], gr[7]); *(u32x4*)(Gt + (size_t)(strip * 2 + fr - 14) * DFF + ff0) = w; } } }
    }
};

template <class Epi>
__device__ __forceinline__ void gemm_phase(LAS unsigned char* lds, const Gemm g, const StaticOrder& S, const Epi& E, const int tid_in) {
    const int tid = tid_in, wid = __builtin_amdgcn_readfirstlane(tid >> 6), lane = tid & 63, wr = wid >> 2, wc = wid & 3, fr = lane & 15, fq = lane >> 4;
    const int K = g.K, nt = K / BK;
    unsigned voffA[2], voffB[2];
#pragma unroll
    for (int i = 0; i < 2; ++i) { int R, C; stage_rc(tid * 16 + i * 8192, R, C); const int Rb = Epi::PERM ? ((R & ~31) + perm32(R & 31)) : R;
        voffA[i] = (unsigned)(R * K + C) * 2u; voffB[i] = (unsigned)(Rb * K + C) * 2u; }
    const size_t kstep = (size_t)(BK * 2);
    const size_t hstep = (size_t)HALF * K * 2;
    const size_t tstep = 2 * hstep;
    const unsigned ldsw = (unsigned)wid * 1024u;
    const int aoff = lds_byte(wr * 64 + fr, fq * 8), boff = lds_byte(wc * 32 + fr, fq * 8);
#define PG8_SA(b, h) (((b) * 2 + (h)) * HTB)
#define PG8_SB(b, h) ((4 + (b) * 2 + (h)) * HTB)
#define PG8_STAGE(bufoff, gbase, voff) do { _Pragma("unroll") for (int _i = 0; _i < 2; ++_i) \
        __builtin_amdgcn_global_load_lds((const unsigned*)((const char*)(gbase) + (voff)[_i]), (LAS unsigned*)(lds + (bufoff) + ldsw + _i * 8192), 16, 0, 0); } while (0)
#define PG8_LDA(dst, b, h) do { _Pragma("unroll") for (int m = 0; m < 4; ++m) _Pragma("unroll") for (int k = 0; k < 2; ++k) dst[m][k] = *(const LAS bf16x8*)(lds + PG8_SA(b, h) + aoff + m * 2048 + k * 1024); } while (0)
#define PG8_LDB(dst, b, h) do { _Pragma("unroll") for (int n = 0; n < 2; ++n) _Pragma("unroll") for (int k = 0; k < 2; ++k) dst[n][k] = *(const LAS bf16x8*)(lds + PG8_SB(b, h) + boff + n * 2048 + k * 1024); } while (0)
#define PG8_MMA(ai, bj, At, Bt) do { __builtin_amdgcn_s_setprio(1); _Pragma("unroll") for (int m = 0; m < 4; ++m) _Pragma("unroll") for (int n = 0; n < 2; ++n) _Pragma("unroll") for (int k = 0; k < 2; ++k) \
        acc[ai][bj][m][n] = __builtin_amdgcn_mfma_f32_16x16x32_bf16(Bt[n][k], At[m][k], acc[ai][bj][m][n], 0, 0, 0); __builtin_amdgcn_s_setprio(0); } while (0)
#define PG8_WAIT_V(n) asm volatile("s_waitcnt vmcnt(" #n ")" ::: "memory")
#define PG8_WAIT_L(n) asm volatile("s_waitcnt lgkmcnt(" #n ")" ::: "memory")
#define PG8_BAR __builtin_amdgcn_s_barrier()
#define PG8_SCHED __builtin_amdgcn_sched_barrier(0)
    Unit cur, nxt; int ui = 0;
    if (!S.next(0, cur)) return;
    f32x4 acc[2][2][4][2];
#pragma unroll
    for (int a = 0; a < 2; ++a)
#pragma unroll
        for (int b = 0; b < 2; ++b)
#pragma unroll
            for (int m = 0; m < 4; ++m)
#pragma unroll
                for (int n = 0; n < 2; ++n) acc[a][b][m][n] = (f32x4){0.f, 0.f, 0.f, 0.f};
    bf16x8 At[4][2], B0[2][2], B1[2][2];
    const char* cA = (const char*)g.A + (size_t)cur.pm * tstep; const char* cB = (const char*)g.Bt + (size_t)cur.pn * tstep;
    PG8_STAGE(PG8_SB(0, 0), cB, voffB); PG8_STAGE(PG8_SB(0, 1), cB + hstep, voffB); PG8_STAGE(PG8_SA(0, 0), cA, voffA); PG8_STAGE(PG8_SA(0, 1), cA + hstep, voffA);
    if (wr == 1) PG8_BAR;
    PG8_WAIT_V(2); PG8_BAR;
    PG8_STAGE(PG8_SB(1, 0), cB + kstep, voffB); PG8_STAGE(PG8_SA(1, 0), cA + kstep, voffA); PG8_STAGE(PG8_SB(1, 1), cB + hstep + kstep, voffB);
    PG8_WAIT_V(6); PG8_BAR;
    for (;;) {
        const bool has_next = S.next(ui + 1, nxt);
        const char* nA = has_next ? (const char*)g.A + (size_t)nxt.pm * tstep : cA; const char* nB = has_next ? (const char*)g.Bt + (size_t)nxt.pn * tstep : cB;
        for (int t = 0; t < nt; t += 2) {
            const bool last = (t == nt - 2);
            const char* a1 = cA + (size_t)(t + 1) * kstep;
            const char* a2 = last ? nA : cA + (size_t)(t + 2) * kstep; const char* b2 = last ? nB : cB + (size_t)(t + 2) * kstep;
            const char* a3 = a2 + kstep; const char* b3 = b2 + kstep;
            PG8_LDB(B0, 0, 0); PG8_LDB(B1, 0, 1); PG8_SCHED; PG8_LDA(At, 0, 0); PG8_STAGE(PG8_SA(1, 1), a1 + hstep, voffA);
            PG8_WAIT_V(8); PG8_WAIT_L(0); PG8_BAR; PG8_MMA(0, 0, At, B0); PG8_MMA(0, 1, At, B1); PG8_BAR; PG8_SCHED;
            PG8_LDA(At, 0, 1); PG8_STAGE(PG8_SB(0, 0), b2, voffB); PG8_STAGE(PG8_SB(0, 1), b2 + hstep, voffB); PG8_STAGE(PG8_SA(0, 0), a2, voffA);
            PG8_WAIT_V(8); PG8_WAIT_L(0); PG8_BAR; PG8_MMA(1, 0, At, B0); PG8_MMA(1, 1, At, B1); PG8_BAR; PG8_SCHED;
            PG8_LDB(B0, 1, 0); PG8_LDB(B1, 1, 1); PG8_SCHED; PG8_LDA(At, 1, 0); PG8_STAGE(PG8_SA(0, 1), a2 + hstep, voffA);
            PG8_WAIT_V(8); PG8_WAIT_L(0); PG8_BAR; PG8_MMA(0, 0, At, B0); PG8_MMA(0, 1, At, B1); PG8_BAR; PG8_SCHED;
            PG8_LDA(At, 1, 1); PG8_STAGE(PG8_SB(1, 0), b3, voffB); PG8_STAGE(PG8_SB(1, 1), b3 + hstep, voffB); PG8_STAGE(PG8_SA(1, 0), a3, voffA);
            PG8_WAIT_V(8); PG8_WAIT_L(0); PG8_BAR; PG8_MMA(1, 0, At, B0); PG8_MMA(1, 1, At, B1); PG8_BAR; PG8_SCHED;
        }
        if (wr == 0) PG8_BAR;
        E(acc, cur, wr, wc, fr, fq);
        if (!has_next) break;
#pragma unroll
        for (int a = 0; a < 2; ++a)
#pragma unroll
            for (int b = 0; b < 2; ++b)
#pragma unroll
                for (int m = 0; m < 4; ++m)
#pragma unroll
                    for (int n = 0; n < 2; ++n) acc[a][b][m][n] = (f32x4){0.f, 0.f, 0.f, 0.f};
        cur = nxt; cA = nA; cB = nB; ++ui;
        if (wr == 1) PG8_BAR;
    }
    PG8_WAIT_V(0);
    PG8_BAR;
#undef PG8_SA
#undef PG8_SB
#undef PG8_STAGE
#undef PG8_LDA
#undef PG8_LDB
#undef PG8_MMA
#undef PG8_WAIT_V
#undef PG8_WAIT_L
#undef PG8_BAR
#undef PG8_SCHED
}
}

__device__ __forceinline__ void transpose_item(const float* W, int K, int Nsrc, bf16_t* WT, int k0, int ndst0, int nsrc0, int nvalid, LAS float* scr, int lane) {
    float vv[32];
#pragma unroll
    for (int i = 0; i < 32; ++i) { const int kk = 2 * i + (lane >> 5), nn = lane & 31;
        vv[i] = (nn < nvalid) ? W[(size_t)(k0 + kk) * Nsrc + nsrc0 + nn] : 0.f; }
#pragma unroll
    for (int i = 0; i < 32; ++i) { const int kk = 2 * i + (lane >> 5), nn = lane & 31; scr[kk * 33 + nn] = vv[i]; }
    LDS_WAIT();
    const int c = lane & 7;
#pragma unroll
    for (int j = 0; j < 4; ++j) { const int n = (lane >> 3) + 8 * j; const LAS float* s = scr + (8 * c) * 33 + n;
        u32x4 o; o.x = pk2(s[0 * 33], s[1 * 33]); o.y = pk2(s[2 * 33], s[3 * 33]); o.z = pk2(s[4 * 33], s[5 * 33]); o.w = pk2(s[6 * 33], s[7 * 33]);
        *(u32x4*)(WT + (size_t)(ndst0 + n) * K + k0 + 8 * c) = o; }
    LDS_WAIT();
}
__device__ __forceinline__ void weight_transposes(const Params& p, LAS unsigned char* lds, const int tid_in, const int l, const int mask, const int gwv, const int NGW);
__device__ __forceinline__ void p0_phase(const Params& p, LAS unsigned char* lds, const int tid_in) {
    const int tid = tid_in, lane = tid & 63, wave = tid >> 6;
    LAS float* sc = (LAS float*)(lds + 8 * 8448);
    for (int k = tid; k < D_; k += 512) sc[k] = silu_f(p.c[k]);
    __syncthreads();
    { const int gw = wave * 256 + (int)blockIdx.x;
      if (gw < 1536) { const int g = gw * 64 + lane; const int l = g / 49152, rem = g % 49152, ks = rem / 3072, c4 = rem % 3072;
          const float* wp = p.w_ada + ((size_t)l * D_ + (size_t)ks * 128) * 12288 + 4 * c4;
          f32x4 a0 = {0.f, 0.f, 0.f, 0.f}, a1 = a0;
#pragma unroll 4
          for (int k = 0; k < 128; k += 2) { const f32x4 w0 = *(const f32x4*)(wp + (size_t)k * 12288), w1 = *(const f32x4*)(wp + (size_t)(k + 1) * 12288);
              a0 += w0 * sc[ks * 128 + k]; a1 += w1 * sc[ks * 128 + k + 1]; }
          *(f32x4*)((float*)(p.ws + WS_MODP) + ((size_t)(ks * 2 + l) * 12288 + 4 * c4)) = a0 + a1; } }
    weight_transposes(p, lds, tid_in, 0, 1, (int)blockIdx.x * 8 + wave, (int)gridDim.x * 8);
}
__device__ __forceinline__ void weight_transposes(const Params& p, LAS unsigned char* lds, const int tid_in, const int l, const int mask, const int gwv, const int NGW) {
    const int lane = tid_in & 63, wave = tid_in >> 6;
    LAS float* scr = (LAS float*)(lds + wave * 8448);
    constexpr int I_IN = 32 * 232, I_OUT = 32 * 64, I_UP = 32 * 352, I_DN = 88 * 64;
    const int n_in = (mask & 1) ? I_IN : 0, n_out = (mask & 2) ? I_OUT : 0, n_up = (mask & 4) ? I_UP : 0, n_dn = (mask & 8) ? I_DN : 0;
    GAS unsigned char* wl = p.ws + WS_W + (size_t)l * W_LAYER;
    for (int it = gwv; it < n_in + n_out + n_up + n_dn; it += NGW) {
        int r = it;
        if (r < n_in) { const int kb = r / 232, nb = r % 232, nd = 32 * nb; int ns, nv;
            if (nd < 4096) { ns = nd; nv = 32; } else if (nd < 7168) { ns = nd + 16; nv = 32; } else if (nd == 7168) { ns = 4096; nv = 16; } else { ns = 0; nv = 0; }
            transpose_item(p.w_in + (size_t)l * D_ * DIN, D_, DIN, (bf16_t*)(wl + W_IN_OFF), 64 * kb, nd, ns, nv, scr, lane); continue; }
        r -= n_in;
        if (r < n_out) { const int kb = r / 64, nb = r % 64; transpose_item(p.w_out + (size_t)l * D_ * D_, D_, D_, (bf16_t*)(wl + W_OUT_OFF), 64 * kb, 32 * nb, 32 * nb, 32, scr, lane); continue; }
        r -= n_out;
        if (r < n_up) { const int kb = r / 352, nb = r % 352, nd = 32 * nb, pn = nd >> 8, x0 = nd & 255;
            transpose_item(p.w_up + (size_t)l * D_ * NUP, D_, NUP, (bf16_t*)(wl + W_UP_OFF), 64 * kb, nd, (x0 < 128) ? 128 * pn + x0 : DFF + 128 * pn + (x0 - 128), 32, scr, lane); continue; }
        r -= n_up;
        { const int kb = r / 64, nb = r % 64; transpose_item(p.w_down + (size_t)l * DFF * D_, DFF, D_, (bf16_t*)(wl + W_DN_OFF), 64 * kb, 32 * nb, 32 * nb, 32, scr, lane); }
    }
}

__device__ __forceinline__ float mod_from_partials(const Params& p, int l, int j) {
    const float* mp = (const float*)(p.ws + WS_MODP);
    float v = p.b_ada[l * 12288 + j];
#pragma unroll
    for (int ks = 0; ks < KS_MOD; ++ks) v += mp[(size_t)(ks * 2 + l) * 12288 + j];
    return v;
}
__device__ __forceinline__ void norm_phase(const Params& p, LAS unsigned char* lds, const float* xin, const float* normw, int l, int off_shift, int off_scale, bool from_partials, const int tid_in) {
    const int tid = tid_in, lane = tid & 63, wave = tid >> 6;
    LAS float* cA = (LAS float*)lds; LAS float* cB = cA + D_;
    float* modf = (float*)(p.ws + WS_MODF);
    if (from_partials) {
        for (int idx = (int)blockIdx.x * 512 + tid; idx < 2 * 12288; idx += (int)gridDim.x * 512) modf[idx] = mod_from_partials(p, idx / 12288, idx % 12288);
        for (int j = tid; j < D_; j += 512) { const float sh = mod_from_partials(p, l, off_shift + j), scv = mod_from_partials(p, l, off_scale + j);
            cA[j] = normw[j] * (1.f + scv); cB[j] = sh; }
    } else {
        for (int j = tid; j < D_; j += 512) { cA[j] = normw[j] * (1.f + modf[l * 12288 + off_scale + j]); cB[j] = modf[l * 12288 + off_shift + j]; }
    }
    __syncthreads();
    f32x4 a[8], b[8];
#pragma unroll
    for (int j = 0; j < 8; ++j) { a[j] = *(const LAS f32x4*)(cA + 4 * lane + 256 * j); b[j] = *(const LAS f32x4*)(cB + 4 * lane + 256 * j); }
    bf16_t* H = (bf16_t*)(p.ws + WS_H);
    for (int m = (int)blockIdx.x * 8 + wave; m < T_; m += (int)gridDim.x * 8) {
        const f32x4* xr = (const f32x4*)(xin + (size_t)m * D_) + lane;
        f32x4 v[8]; float s = 0.f;
#pragma unroll
        for (int j = 0; j < 8; ++j) { v[j] = xr[64 * j]; s += (v[j].x * v[j].x + v[j].y * v[j].y) + (v[j].z * v[j].z + v[j].w * v[j].w); }
        const float rstd = rsqrtf(wave_sum(s) * (1.f / D_) + EPS_);
        u32x2* o8 = (u32x2*)(H + (size_t)m * D_) + lane;
#pragma unroll
        for (int j = 0; j < 8; ++j) { const f32x4 y = v[j] * rstd * a[j] + b[j]; u32x2 w; w.x = pk2(y.x, y.y); w.y = pk2(y.z, y.w); o8[64 * j] = w; }
    }
}


__device__ __forceinline__ void win_small_cols(const Params& p, LAS unsigned char* lds, int l, const int tid_in) {
    const int lane = tid_in & 63, wave = tid_in >> 6, r16 = lane & 15, q4 = lane >> 4;
    const int tw = wave & 3, kh = wave >> 2;
    const int m0 = ((int)blockIdx.x * 4 + tw) * 16;
    const bf16_t* H = (const bf16_t*)(p.ws + WS_H) + (size_t)(m0 + r16) * D_ + 8 * q4 + 1024 * kh;
    const bf16_t* Wt = (const bf16_t*)(p.ws + WS_W + (size_t)l * W_LAYER + W_IN_OFF) + (size_t)(7168 + r16) * D_ + 8 * q4 + 1024 * kh;
    f32x4 acc0 = {0.f, 0.f, 0.f, 0.f}, acc1 = acc0;
#pragma unroll 8
    for (int s = 0; s < 32; s += 2) {
        const bf16x8 a0 = *(const bf16x8*)(H + 32 * s), b0 = *(const bf16x8*)(Wt + 32 * s), a1 = *(const bf16x8*)(H + 32 * s + 32), b1 = *(const bf16x8*)(Wt + 32 * s + 32);
        acc0 = MFMA16(a0, b0, acc0); acc1 = MFMA16(a1, b1, acc1); }
    acc0 += acc1;
    LAS f32x4* xch = (LAS f32x4*)lds;
    if (kh) xch[tw * 64 + lane] = acc0;
    __syncthreads();
    if (!kh) { acc0 += xch[tw * 64 + lane];
        bf16_t* proj = (bf16_t*)(p.ws + WS_PROJ);
#pragma unroll
        for (int rg = 0; rg < 4; ++rg) proj[(size_t)(m0 + 4 * q4 + rg) * NIN + 7168 + r16] = (bf16_t)(pk2(acc0[rg], 0.f) & 0xffffu); }
    __syncthreads();
}

__device__ __forceinline__ void gdn_prep_phase(const Params& p, LAS unsigned char* lds, int l, const int tid_in) {
    const int tid0 = tid_in, wave = __builtin_amdgcn_readfirstlane(tid0 >> 6);
    LAS float* Lslot = (LAS float*)lds;
    LAS bf16_t* Qn = (LAS bf16_t*)(lds + 65536); LAS bf16_t* Kn = (LAS bf16_t*)(lds + 82944); LAS bf16_t* KdTs = (LAS bf16_t*)(lds + 100352);
    LAS float* betaS = (LAS float*)(lds + 118784); LAS float* gcS = (LAS float*)(lds + 119808); LAS float* gS = (LAS float*)(lds + 120832);
    LAS bf16_t* VbT = (LAS bf16_t*)(lds + 65536); LAS bf16_t* KbgT = (LAS bf16_t*)(lds + 82944);
    const bf16_t* proj = (const bf16_t*)(p.ws + WS_PROJ);
    bf16_t* Wg = (bf16_t*)(p.ws + WS_GDN); bf16_t* UTg = (bf16_t*)(p.ws + WS_GDN + 32 * MiB); bf16_t* KdTg = (bf16_t*)(p.ws + WS_GDN + 64 * MiB);
    bf16_t* Qgg = (bf16_t*)(p.ws + WS_GDN + 96 * MiB); bf16_t* Ag = (bf16_t*)(p.ws + WS_GDN + 128 * MiB);
    float* egl = (float*)(p.ws + WS_EGL);
    LAS float* cwS = (LAS float*)(lds + 122880);
    { const int h0 = ((int)blockIdx.x * 8) >> 8; const float* convw = p.conv_qkv + (size_t)l * 4 * 3072;
      for (int u = tid0; u < 4 * 3 * 128; u += 512) { const int r = u / 384, xx = (u % 384) >> 7, d = u & 127; cwS[u] = convw[r * 3072 + xx * 1024 + h0 * 128 + d]; }
      __syncthreads(); }
#pragma unroll 1
    for (int batch = 0; batch < 2; ++batch) {
        { int tid = tid0; asm volatile("" : "+v"(tid));
          const int kk = tid >> 6, row = tid & 63;
          if (tid < 256) { const int I = (int)blockIdx.x * 8 + batch * 4 + kk, h = I >> 8, c = I & 255; const size_t t = (size_t)64 * c + row;
              const float braw = bf2f(proj[t * NIN + PBETA + h]), araw = bf2f(proj[t * NIN + PALPHA + h]);
              betaS[kk * 64 + row] = 1.f / (1.f + __expf(-braw));
              float g = -__expf(p.a_log[l * NH + h]) * softplus_f(araw + p.dt_bias[l * NH + h]);
#pragma unroll
              for (int o = 1; o < 64; o <<= 1) { const float u = __shfl_up(g, o); if (row >= o) g += u; }
              gcS[kk * 64 + row] = g; if (row == 63) egl[I] = __expf(g); }
          __syncthreads(); }
        u32x4 raw[3][4][2];
#define PREP_LOADRAW(kq) do { const int I_ = (int)blockIdx.x * 8 + batch * 4 + (kq), h_ = I_ >> 8, c_ = I_ & 255; \
            _Pragma("unroll") for (int X = 0; X < 3; ++X) _Pragma("unroll") for (int r = 0; r < 4; ++r) { int tt_ = 64 * c_ + (tid0 >> 3) - 3 + r; tt_ = tt_ < 0 ? 0 : tt_; \
                const u32x4* pp_ = (const u32x4*)(proj + (size_t)tt_ * NIN + X * 1024 + h_ * 128 + 16 * (tid0 & 7)); raw[X][r][0] = pp_[0]; raw[X][r][1] = pp_[1]; } } while (0)
        PREP_LOADRAW(0);
#pragma unroll 1
        for (int k = 0; k < 4; ++k) {
            int tid = tid0; asm volatile("" : "+v"(tid));
            const int lane = tid & 63, r16 = lane & 15, q4 = lane >> 4, i = tid >> 3, sub = tid & 7;
            const int I = (int)blockIdx.x * 8 + batch * 4 + k, h = I >> 8, c = I & 255, t = 64 * c + i;
            const float gci = gcS[k * 64 + i], glast = gcS[k * 64 + 63];
#pragma unroll
            for (int X = 0; X < 3; ++X) {
                const int col = X * 1024 + h * 128 + 16 * sub;
                float y[16];
#pragma unroll
                for (int e = 0; e < 16; ++e) y[e] = 0.f;
#pragma unroll
                for (int r = 0; r < 4; ++r) { const int tt = t - 3 + r;
                    if (tt >= 0) { float xv[16]; unpack8(raw[X][r][0], xv); unpack8(raw[X][r][1], xv + 8);
                        const LAS f32x4* wp = (const LAS f32x4*)(cwS + (r * 3 + X) * 128 + 16 * sub);
#pragma unroll
                        for (int e4 = 0; e4 < 4; ++e4) { const f32x4 w = wp[e4]; y[4 * e4] += w.x * xv[4 * e4]; y[4 * e4 + 1] += w.y * xv[4 * e4 + 1]; y[4 * e4 + 2] += w.z * xv[4 * e4 + 2]; y[4 * e4 + 3] += w.w * xv[4 * e4 + 3]; } } }
                float ss = 0.f;
#pragma unroll
                for (int e = 0; e < 16; ++e) { y[e] = silu_f(y[e]); ss += y[e] * y[e]; }
                if (X < 2) { ss += __shfl_xor(ss, 1); ss += __shfl_xor(ss, 2); ss += __shfl_xor(ss, 4);
                    const float scl = rsqrtf(ss + EPS_) * (X == 0 ? 0.08838834764831845f : 1.f);
#pragma unroll
                    for (int e = 0; e < 16; ++e) y[e] *= scl; }
                if (X == 0) { *(LAS u32x4*)(Qn + i * 136 + 16 * sub) = pack8(y); *(LAS u32x4*)(Qn + i * 136 + 16 * sub + 8) = pack8(y + 8);
                    const float eg = __expf(gci); float z[16];
#pragma unroll
                    for (int e = 0; e < 16; ++e) z[e] = y[e] * eg;
                    { const int c8a = 2 * sub, c8b = 2 * sub + 1;
                      *(u32x4*)(Qgg + (size_t)I * 8192 + ((((i >> 4) * 4 + (c8a >> 2)) * 64 + (c8a & 3) * 16 + (i & 15)) * 8)) = pack8(z);
                      *(u32x4*)(Qgg + (size_t)I * 8192 + ((((i >> 4) * 4 + (c8b >> 2)) * 64 + (c8b & 3) * 16 + (i & 15)) * 8)) = pack8(z + 8); }
                } else if (X == 1) { const u32x4 k0 = pack8(y), k1 = pack8(y + 8);
                    *(LAS u32x4*)(Kn + i * 136 + 16 * sub) = k0; *(LAS u32x4*)(Kn + i * 136 + 16 * sub + 8) = k1;
                    u32x4* dst = (u32x4*)(Wg + ((size_t)I * 64 + i) * 128 + 16 * sub); dst[0] = k0; dst[1] = k1;
                    const float ed = __expf(glast - gci);
#pragma unroll
                    for (int e = 0; e < 16; e += 2) { const unsigned w = pk2(y[e] * ed, y[e + 1] * ed); KdTs[(16 * sub + e) * 72 + i] = (bf16_t)(w & 0xffffu); KdTs[(16 * sub + e + 1) * 72 + i] = (bf16_t)(w >> 16); }
                } else { u32x4* dst = (u32x4*)(UTg + ((size_t)I * 64 + i) * 128 + 16 * sub); dst[0] = pack8(y); dst[1] = pack8(y + 8); }
            }
            __syncthreads();
            if (k < 3) PREP_LOADRAW(k + 1);
#pragma unroll
            for (int u = 0; u < 2; ++u) { const int ch = tid + 512 * u, d = ch >> 3, part = ch & 7;
                *(u32x4*)(KdTg + (size_t)I * 8192 + ((((d >> 4) * 2 + (part >> 2)) * 64 + (part & 3) * 16 + (d & 15)) * 8)) = *(const LAS u32x4*)(KdTs + d * 72 + 8 * part); }
            { const int pr = wave >> 2, ti = wave & 3;
              for (int tj = 0; tj < 4; ++tj) {
                  f32x4 acc = {0.f, 0.f, 0.f, 0.f};
                  if (tj <= ti) {
#pragma unroll
                      for (int s = 0; s < 4; ++s) {
                          if (pr == 0) { const bf16x8 a = *(const LAS bf16x8*)(Kn + (16 * ti + r16) * 136 + 32 * s + 8 * q4), b = *(const LAS bf16x8*)(Kn + (16 * tj + r16) * 136 + 32 * s + 8 * q4); acc = MFMA16(a, b, acc); }
                          else { const bf16x8 a = *(const LAS bf16x8*)(Kn + (16 * tj + r16) * 136 + 32 * s + 8 * q4), b = *(const LAS bf16x8*)(Qn + (16 * ti + r16) * 136 + 32 * s + 8 * q4); acc = MFMA16(a, b, acc); }
                      }
                  }
                  if (pr == 0) {
                      if (tj <= ti) { const int jj = 16 * tj + r16; const float gj = gcS[k * 64 + jj];
#pragma unroll
                          for (int rg = 0; rg < 4; ++rg) { const int ii = 16 * ti + 4 * q4 + rg; const float v = (ii > jj) ? betaS[k * 64 + ii] * acc[rg] * __expf(gcS[k * 64 + ii] - gj) : 0.f;
                              Lslot[k * 4096 + ii * 64 + jj] = v; } }
                  } else {
                      const int ii = 16 * ti + r16; const float gi = gcS[k * 64 + ii]; float o[4];
#pragma unroll
                      for (int rg = 0; rg < 4; ++rg) { const int jj = 16 * tj + 4 * q4 + rg; o[rg] = (tj <= ti && ii >= jj) ? acc[rg] * __expf(gi - gcS[k * 64 + jj]) : 0.f; }
                      u32x2 w; w.x = pk2(o[0], o[1]); w.y = pk2(o[2], o[3]);
                      *(u32x2*)(Ag + (size_t)I * 4096 + (((ti * 2 + (tj >> 1)) * 64 + ((2 * tj + (q4 >> 1)) & 3) * 16 + r16) * 8) + 4 * (q4 & 1)) = w;
                  }
              } }
            __syncthreads();
        }
        if (wave < 4) {
            const int lane = tid0 & 63;
            LAS float* L = Lslot + wave * 4096; float tc[64];
#pragma unroll
            for (int ii = 0; ii < 64; ++ii) { float a = (lane == ii) ? 1.f : 0.f;
#pragma unroll
                for (int jj = 0; jj < ii; ++jj) a -= L[ii * 64 + jj] * tc[jj];
                tc[ii] = a;
                if ((ii & 3) == 3) asm volatile("" ::: "memory"); }
            LDS_WAIT();
#pragma unroll
            for (int ii = 0; ii < 64; ++ii) L[ii * 64 + lane] = tc[ii];
        }
        __syncthreads();
#pragma unroll 1
        for (int k = 0; k < 4; ++k) {
            int tid = tid0; asm volatile("" : "+v"(tid));
            const int lane = tid & 63, r16 = lane & 15, q4 = lane >> 4, i = tid >> 3, sub = tid & 7;
            const int I = (int)blockIdx.x * 8 + batch * 4 + k;
            { const float be = betaS[k * 64 + i], beg = be * __expf(gcS[k * 64 + i]);
              const u32x4* pk = (const u32x4*)(Wg + ((size_t)I * 64 + i) * 128 + 16 * sub); const u32x4* pv = (const u32x4*)(UTg + ((size_t)I * 64 + i) * 128 + 16 * sub);
              float kv[16], vv[16]; unpack8(pk[0], kv); unpack8(pk[1], kv + 8); unpack8(pv[0], vv); unpack8(pv[1], vv + 8);
#pragma unroll
              for (int e = 0; e < 16; ++e) { vv[e] *= be; kv[e] *= beg; }
              *(LAS u32x4*)(VbT + i * 136 + 16 * sub) = pack8(vv); *(LAS u32x4*)(VbT + i * 136 + 16 * sub + 8) = pack8(vv + 8);
              *(LAS u32x4*)(KbgT + i * 136 + 16 * sub) = pack8(kv); *(LAS u32x4*)(KbgT + i * 136 + 16 * sub + 8) = pack8(kv + 8); }
            __syncthreads();
            { const int pr = wave >> 2, ti = wave & 3; bf16x8 aT[2];
#pragma unroll
              for (int s = 0; s < 2; ++s) { const LAS float* tp = Lslot + k * 4096 + (16 * ti + r16) * 64 + 32 * s + 8 * q4; const f32x4 t0 = *(const LAS f32x4*)tp, t1 = *(const LAS f32x4*)(tp + 4);
                  u32x4 w; w.x = pk2(t0.x, t0.y); w.y = pk2(t0.z, t0.w); w.z = pk2(t1.x, t1.y); w.w = pk2(t1.z, t1.w); aT[s] = as_bf8(w); }
#pragma unroll 2
              for (int tn = 0; tn < 8; ++tn) { f32x4 acc = {0.f, 0.f, 0.f, 0.f};
                  if (pr == 0) {
#pragma unroll
                      for (int s = 0; s < 2; ++s) { const LAS bf16_t* bp = VbT + (32 * s + 8 * q4 + (r16 >> 2)) * 136 + 16 * tn + 4 * (r16 & 3);
                          const s16x4 t0 = __builtin_amdgcn_ds_read_tr16_b64_v4i16((LAS s16x4*)bp), t1 = __builtin_amdgcn_ds_read_tr16_b64_v4i16((LAS s16x4*)(bp + 4 * 136));
                          const bf16x8 b = {t0[0], t0[1], t0[2], t0[3], t1[0], t1[1], t1[2], t1[3]}; acc = MFMA16(aT[s], b, acc); }
                      u32x2 w; w.x = pk2(acc[0], acc[1]); w.y = pk2(acc[2], acc[3]);
                      *(u32x2*)(UTg + (size_t)I * 8192 + (((tn * 4 + ti) * 64 + lane) * 4)) = w;
                  } else {
#pragma unroll
                      for (int s = 0; s < 2; ++s) { const LAS bf16_t* bp = KbgT + (32 * s + 8 * q4 + (r16 >> 2)) * 136 + 16 * tn + 4 * (r16 & 3);
                          const s16x4 t0 = __builtin_amdgcn_ds_read_tr16_b64_v4i16((LAS s16x4*)bp), t1 = __builtin_amdgcn_ds_read_tr16_b64_v4i16((LAS s16x4*)(bp + 4 * 136));
                          const bf16x8 b = {t0[0], t0[1], t0[2], t0[3], t1[0], t1[1], t1[2], t1[3]}; acc = MFMA16(b, aT[s], acc); }
                      u32x2 w; w.x = pk2(acc[0], acc[1]); w.y = pk2(acc[2], acc[3]);
                      *(u32x2*)(Wg + (size_t)I * 8192 + (((ti * 4 + (tn >> 1)) * 64 + ((2 * tn + (q4 >> 1)) & 3) * 16 + r16) * 8) + 4 * (q4 & 1)) = w;
                  } } }
            __syncthreads();
        }
    }
}

struct ScanBuf { bf16x8 a4[4]; bf16x8 a2[2]; bf16x8 kd[2]; u32x2 u[2]; float eg; };
template <int ROLE, int HOT>
__device__ __forceinline__ void scan_loop(const Params& p, LAS bf16_t* ST, LAS bf16_t* VT, int h, int vs, int wave, int lane) {
    const int r16 = lane & 15, q4 = lane >> 4, tm = wave & 3;
    const bf16_t* Wg = (const bf16_t*)(p.ws + WS_GDN); const bf16_t* UTg = (const bf16_t*)(p.ws + WS_GDN + 32 * MiB); const bf16_t* KdTg = (const bf16_t*)(p.ws + WS_GDN + 64 * MiB);
    const bf16_t* Qgg = (const bf16_t*)(p.ws + WS_GDN + 96 * MiB); const bf16_t* Ag = (const bf16_t*)(p.ws + WS_GDN + 128 * MiB);
    const float* egl = (const float*)(p.ws + WS_EGL);
    bf16_t* ocat = (bf16_t*)(p.ws + (HOT ? WS_H : WS_OCAT));
    const bf16_t* p4 = ROLE ? Qgg : Wg;
    f32x4 accS[2] = {{0.f, 0.f, 0.f, 0.f}, {0.f, 0.f, 0.f, 0.f}};
    ScanBuf B[4];
#define SCAN_LOAD(buf, cc) do { const size_t I_ = (size_t)h * 256 + (HOT ? ((cc) & 3) : (cc)); \
        _Pragma("unroll") for (int s = 0; s < 4; ++s) (buf).a4[s] = *(const bf16x8*)(p4 + I_ * 8192 + ((tm * 4 + s) * 64 + lane) * 8); \
        _Pragma("unroll") for (int s = 0; s < 2; ++s) (buf).kd[s] = *(const bf16x8*)(KdTg + I_ * 8192 + ((wave * 2 + s) * 64 + lane) * 8); \
        if (ROLE) { _Pragma("unroll") for (int s = 0; s < 2; ++s) (buf).a2[s] = *(const bf16x8*)(Ag + I_ * 4096 + ((tm * 2 + s) * 64 + lane) * 8); } \
        else { _Pragma("unroll") for (int tn = 0; tn < 2; ++tn) (buf).u[tn] = *(const u32x2*)(UTg + I_ * 8192 + (((vs * 2 + tn) * 4 + tm) * 64 + lane) * 4); } \
        (buf).eg = egl[I_]; } while (0)
#pragma unroll
    for (int u = 0; u < 4; ++u) SCAN_LOAD(B[u], u);
    for (int c0 = 0; c0 < 256; c0 += 4) {
#pragma unroll
        for (int u = 0; u < 4; ++u) {
            const int c = c0 + u, pb = u & 1;
            const LAS bf16_t* STc = ST + pb * (32 * 136); LAS bf16_t* STn = ST + (pb ^ 1) * (32 * 136);
            if (ROLE == 0) asm volatile("" : "+v"(B[u].u[0].x), "+v"(B[u].u[0].y), "+v"(B[u].u[1].x), "+v"(B[u].u[1].y), "+v"(B[u].eg));
            else asm volatile("" : "+v"(B[u].eg));
            bf16x8 sf[2][4];
#pragma unroll
            for (int tn = 0; tn < 2; ++tn)
#pragma unroll
                for (int s = 0; s < 4; ++s) sf[tn][s] = *(const LAS bf16x8*)(STc + (16 * tn + r16) * 136 + 32 * s + 8 * q4);
            f32x4 o[2] = {{0.f, 0.f, 0.f, 0.f}, {0.f, 0.f, 0.f, 0.f}};
            if (ROLE == 0) {
#pragma unroll
                for (int tn = 0; tn < 2; ++tn) { f32x4 t1 = {0.f, 0.f, 0.f, 0.f};
#pragma unroll
                    for (int s = 0; s < 4; ++s) t1 = MFMA16(B[u].a4[s], sf[tn][s], t1);
                    const float v0 = bflo(B[u].u[tn].x) - t1[0], v1 = bfhi(B[u].u[tn].x) - t1[1], v2 = bflo(B[u].u[tn].y) - t1[2], v3 = bfhi(B[u].u[tn].y) - t1[3];
                    u32x2 w; w.x = pk2(v0, v1); w.y = pk2(v2, v3);
                    *(LAS u32x2*)(VT + (16 * tn + r16) * 72 + 16 * tm + 4 * q4) = w; }
            } else {
#pragma unroll
                for (int tn = 0; tn < 2; ++tn)
#pragma unroll
                    for (int s = 0; s < 4; ++s) o[tn] = MFMA16(sf[tn][s], B[u].a4[s], o[tn]);
            }
            accS[0] *= B[u].eg; accS[1] *= B[u].eg;
            LDS_WAIT(); __builtin_amdgcn_s_barrier(); asm volatile("" ::: "memory");
            bf16x8 vf[2][2];
#pragma unroll
            for (int tn = 0; tn < 2; ++tn)
#pragma unroll
                for (int s = 0; s < 2; ++s) vf[tn][s] = *(const LAS bf16x8*)(VT + (16 * tn + r16) * 72 + 32 * s + 8 * q4);
#pragma unroll
            for (int tn = 0; tn < 2; ++tn) {
#pragma unroll
                for (int s = 0; s < 2; ++s) accS[tn] = MFMA16(B[u].kd[s], vf[tn][s], accS[tn]);
                u32x2 w; w.x = pk2(accS[tn][0], accS[tn][1]); w.y = pk2(accS[tn][2], accS[tn][3]);
                *(LAS u32x2*)(STn + (16 * tn + r16) * 136 + 16 * wave + 4 * q4) = w; }
            if (ROLE) {
#pragma unroll
                for (int tn = 0; tn < 2; ++tn) {
#pragma unroll
                    for (int s = 0; s < 2; ++s) o[tn] = MFMA16(vf[tn][s], B[u].a2[s], o[tn]);
                    u32x2 w; w.x = pk2(o[tn][0], o[tn][1]); w.y = pk2(o[tn][2], o[tn][3]);
                    if (HOT < 2) *(u32x2*)(ocat + (size_t)(64 * c + 16 * tm + r16) * D_ + h * 128 + vs * 32 + 16 * tn + 4 * q4) = w; else asm volatile("" :: "v"(w.x), "v"(w.y)); }
            }
            { const int cn = (c + 4 < 256) ? c + 4 : 255; SCAN_LOAD(B[u], cn); }
            LDS_WAIT(); __builtin_amdgcn_s_barrier(); asm volatile("" ::: "memory");
        }
    }
#undef SCAN_LOAD
}
template <int HOT>
__device__ __forceinline__ void scan_phase(const Params& p, LAS unsigned char* lds, const int tid_in) {
    const int tid = tid_in, lane = tid & 63, wave = __builtin_amdgcn_readfirstlane(tid >> 6);
    const int h = (int)blockIdx.x & 7, vs = (int)blockIdx.x >> 3;
    LAS bf16_t* ST = (LAS bf16_t*)lds;
    LAS bf16_t* VT = (LAS bf16_t*)(lds + 17408);
    for (int u = tid; u < 2 * 32 * 136 / 2; u += 512) ((LAS unsigned*)ST)[u] = 0u;
    __syncthreads();
    if (wave < 4) scan_loop<0, HOT>(p, ST, VT, h, vs, wave, lane); else scan_loop<1, HOT>(p, ST, VT, h, vs, wave, lane);
    __syncthreads();
}


__device__ __forceinline__ void sb_attn_phase(const Params& p, LAS unsigned char* lds, int l, int first_blk, int nblk, const int tid_in) {
    const int tid = tid_in, lane = tid & 63, wave = __builtin_amdgcn_readfirstlane(tid >> 6);
    const int r16 = lane & 15, q4 = lane >> 4;
    LAS bf16_t* Qs = (LAS bf16_t*)lds; LAS bf16_t* Ks = (LAS bf16_t*)(lds + 34816); LAS bf16_t* Vs = (LAS bf16_t*)(lds + 52224);
    LAS float* Z = (LAS float*)(lds + 70656); LAS bf16_t* As = (LAS bf16_t*)(lds + 103936); LAS float* SegTot = (LAS float*)(lds + 122368);
    const bf16_t* proj = (const bf16_t*)(p.ws + WS_PROJ);
    bf16_t* ocat = (bf16_t*)(p.ws + WS_OCAT);
    const float* gq = p.sbq + l * 128; const float* gk = p.sbk + l * 128;
    const int q = tid & 127, seg = tid >> 7;
    for (int item = (int)blockIdx.x - first_blk; item < 1024; item += nblk) {
        const int h = item & 7, qb = 127 - (item >> 3);
#pragma unroll
        for (int u = 0; u < 4; ++u) { const int ch = tid + 512 * u, row = ch >> 4, c8 = ch & 15;
            float xv[8]; unpack8(*(const u32x4*)(proj + (size_t)(128 * qb + row) * NIN + PQ_B + h * 128 + 8 * c8), xv);
            float ss = 0.f;
#pragma unroll
            for (int e = 0; e < 8; ++e) ss += xv[e] * xv[e];
            ss += __shfl_xor(ss, 1); ss += __shfl_xor(ss, 2); ss += __shfl_xor(ss, 4); ss += __shfl_xor(ss, 8);
            const float sc = rsqrtf(ss * (1.f / 128.f) + EPS_) * 0.08838834764831845f;
#pragma unroll
            for (int e = 0; e < 8; ++e) xv[e] *= sc * gq[8 * c8 + e];
            *(LAS u32x4*)(Qs + row * 136 + 8 * c8) = pack8(xv); }
        f32x4 oacc[8];
#pragma unroll
        for (int tn = 0; tn < 8; ++tn) oacc[tn] = (f32x4){0.f, 0.f, 0.f, 0.f};
        float Rq = 0.f;
        const int tq = 128 * qb + q;
        u32x4 kreg[2], vreg[2];
#pragma unroll
        for (int u = 0; u < 2; ++u) { const int ch = tid + 512 * u, row = ch >> 4, c8 = ch & 15; const size_t rb = (size_t)(64 * (2 * qb + 1) + row) * NIN + h * 128 + 8 * c8;
            kreg[u] = *(const u32x4*)(proj + rb + PK_B); vreg[u] = *(const u32x4*)(proj + rb + PV_B); }
        for (int j = 2 * qb + 1; j >= 0; --j) {
#pragma unroll
            for (int u = 0; u < 2; ++u) { const int ch = tid + 512 * u, row = ch >> 4, c8 = ch & 15;
                float xv[8]; unpack8(kreg[u], xv);
                float ss = 0.f;
#pragma unroll
                for (int e = 0; e < 8; ++e) ss += xv[e] * xv[e];
                ss += __shfl_xor(ss, 1); ss += __shfl_xor(ss, 2); ss += __shfl_xor(ss, 4); ss += __shfl_xor(ss, 8);
                const float sc = rsqrtf(ss * (1.f / 128.f) + EPS_);
#pragma unroll
                for (int e = 0; e < 8; ++e) xv[e] *= sc * gk[8 * c8 + e];
                *(LAS u32x4*)(Ks + row * 136 + 8 * c8) = pack8(xv);
                *(LAS u32x4*)(Vs + row * 136 + 8 * c8) = vreg[u]; }
            { const int jn = j > 0 ? j - 1 : 0;
#pragma unroll
              for (int u = 0; u < 2; ++u) { const int ch = tid + 512 * u, row = ch >> 4, c8 = ch & 15; const size_t rb = (size_t)(64 * jn + row) * NIN + h * 128 + 8 * c8;
                  kreg[u] = *(const u32x4*)(proj + rb + PK_B); vreg[u] = *(const u32x4*)(proj + rb + PV_B); } }
            __syncthreads();
            { bf16x8 qf[4];
#pragma unroll
              for (int s = 0; s < 4; ++s) qf[s] = *(const LAS bf16x8*)(Qs + (16 * wave + r16) * 136 + 32 * s + 8 * q4);
#pragma unroll
              for (int tn = 0; tn < 4; ++tn) { f32x4 acc = {0.f, 0.f, 0.f, 0.f};
#pragma unroll
                  for (int s = 0; s < 4; ++s) { const bf16x8 kf = *(const LAS bf16x8*)(Ks + (16 * tn + r16) * 136 + 32 * s + 8 * q4); acc = MFMA16(qf[s], kf, acc); }
#pragma unroll
                  for (int rg = 0; rg < 4; ++rg) Z[(16 * wave + 4 * q4 + rg) * 65 + 16 * tn + r16] = acc[rg]; } }
            __syncthreads();
            float zz[16], ls[16], suf[16]; const int s0 = 64 * j + 16 * seg;
#pragma unroll
            for (int e = 0; e < 16; ++e) { zz[e] = Z[q * 65 + 16 * seg + e]; ls[e] = (s0 + e < tq) ? -softplus_fast(zz[e]) : 0.f; }
            float run = 0.f;
#pragma unroll
            for (int e = 15; e >= 0; --e) { suf[e] = run; run += ls[e]; }
            SegTot[seg * 128 + q] = run;
            __syncthreads();
            float hi = 0.f, all = 0.f;
#pragma unroll
            for (int sg = 0; sg < 4; ++sg) { const float tv = SegTot[sg * 128 + q]; all += tv; if (sg > seg) hi += tv; }
            const float base = Rq + hi; float av[16];
#pragma unroll
            for (int e = 0; e < 16; ++e) av[e] = (s0 + e < tq) ? __expf(zz[e] + ls[e] + base + suf[e]) : 0.f;
            Rq += all;
            *(LAS u32x4*)(As + q * 72 + 16 * seg) = pack8(av); *(LAS u32x4*)(As + q * 72 + 16 * seg + 8) = pack8(av + 8);
            __syncthreads();
            { bf16x8 af[2];
#pragma unroll
              for (int s = 0; s < 2; ++s) af[s] = *(const LAS bf16x8*)(As + (16 * wave + r16) * 72 + 32 * s + 8 * q4);
#pragma unroll
              for (int tn = 0; tn < 8; ++tn)
#pragma unroll
                  for (int s = 0; s < 2; ++s) {
                      const LAS bf16_t* vp = Vs + (32 * s + 8 * q4 + (r16 >> 2)) * 136 + 16 * tn + 4 * (r16 & 3);
                      const s16x4 t0 = __builtin_amdgcn_ds_read_tr16_b64_v4i16((LAS s16x4*)vp), t1 = __builtin_amdgcn_ds_read_tr16_b64_v4i16((LAS s16x4*)(vp + 4 * 136));
                      const bf16x8 vf = {t0[0], t0[1], t0[2], t0[3], t1[0], t1[1], t1[2], t1[3]};
                      oacc[tn] = MFMA16(vf, af[s], oacc[tn]); } }
            if (!__syncthreads_or(Rq >= -104.f)) break;
        }
        __syncthreads();
#pragma unroll
        for (int tn = 0; tn < 8; ++tn) { u32x2 w; w.x = pk2(oacc[tn][0], oacc[tn][1]); w.y = pk2(oacc[tn][2], oacc[tn][3]);
            *(u32x2*)(ocat + (size_t)(128 * qb + 16 * wave + r16) * D_ + 1024 + h * 128 + 16 * tn + 4 * q4) = w; }
    }
}

__device__ __forceinline__ void gdn_finalize_phase(const Params& p, int l, const int tid_in) {
    const int g = opaque_bid() * 512 + tid_in, l16 = g & 15;
    bf16_t* ocat = (bf16_t*)(p.ws + WS_OCAT); const bf16_t* proj = (const bf16_t*)(p.ws + WS_PROJ);
    float gn[8];
#pragma unroll
    for (int e = 0; e < 8; ++e) gn[e] = p.gdn_norm[l * 128 + 8 * l16 + e];
    const int Rstep = ((int)gridDim.x * 512) >> 4;
    for (int R0 = g >> 4; R0 < T_ * NH; R0 += 4 * Rstep) {
        u32x4 oraw[4], zraw[4];
#pragma unroll
        for (int q = 0; q < 4; ++q) { const int R = R0 + q * Rstep, t = R >> 3, h = R & 7;
            oraw[q] = *(const u32x4*)(ocat + (size_t)t * D_ + h * 128 + 8 * l16); zraw[q] = *(const u32x4*)(proj + (size_t)t * NIN + PZ_A + h * 128 + 8 * l16); }
#pragma unroll
        for (int q = 0; q < 4; ++q) { const int R = R0 + q * Rstep, t = R >> 3, h = R & 7;
            float ov[8], zv[8]; unpack8(oraw[q], ov); unpack8(zraw[q], zv);
            float ss = 0.f;
#pragma unroll
            for (int e = 0; e < 8; ++e) ss += ov[e] * ov[e];
            ss += __shfl_xor(ss, 1); ss += __shfl_xor(ss, 2); ss += __shfl_xor(ss, 4); ss += __shfl_xor(ss, 8);
            const float rs = rsqrtf(ss * (1.f / 128.f) + EPS_);
#pragma unroll
            for (int e = 0; e < 8; ++e) ov[e] = ov[e] * rs * gn[e] * silu_f(zv[e]);
            *(u32x4*)(ocat + (size_t)t * D_ + h * 128 + 8 * l16) = pack8(ov); }
    }
}

__device__ __forceinline__ void act_fix_rows(const Params& p, int l, const int tid_in, const int pm) {
    bf16_t* V = (bf16_t*)(p.ws + WS_V); const bf16_t* Gh = (const bf16_t*)(p.ws + WS_G); const bf16_t* Gt = (const bf16_t*)(p.ws + WS_G + 8 * MiB); const bf16_t* Vh = (const bf16_t*)(p.ws + WS_G + 16 * MiB);
    const float* cw = p.conv_ffn + (size_t)l * 3 * DFF;
    for (int it = tid_in; it < 8 * 704; it += 512) {
        const int q = it / 704, cc = it % 704, col = 8 * cc, sp = 4 * pm + (q >> 1), rs = q & 1;
        float w0[8], w1[8], w2[8], ga[8], gb[8], gc[8], vv[8], o[8];
#pragma unroll
        for (int e = 0; e < 8; ++e) { w0[e] = cw[col + e]; w1[e] = cw[DFF + col + e]; w2[e] = cw[2 * DFF + col + e]; }
        const int spm = sp > 0 ? sp - 1 : 0;
        const bf16_t* pa = rs ? Gt + (size_t)(spm * 2 + 1) * DFF + col : Gt + (size_t)(spm * 2) * DFF + col;
        const bf16_t* pb = rs ? Gh + (size_t)(sp * 2) * DFF + col : Gt + (size_t)(spm * 2 + 1) * DFF + col;
        const bf16_t* pc = rs ? Gh + (size_t)(sp * 2 + 1) * DFF + col : Gh + (size_t)(sp * 2) * DFF + col;
        unpack8(*(const u32x4*)pa, ga); unpack8(*(const u32x4*)pb, gb); unpack8(*(const u32x4*)pc, gc);
        const float za = (sp > 0) ? 1.f : 0.f, zb = (sp > 0 || rs) ? 1.f : 0.f;
#pragma unroll
        for (int e = 0; e < 8; ++e) { ga[e] *= za; gb[e] *= zb; }
        unpack8(*(const u32x4*)(Vh + (size_t)(sp * 2 + rs) * DFF + col), vv);
#pragma unroll
        for (int e = 0; e < 8; ++e) o[e] = silu_f(w0[e] * ga[e] + w1[e] * gb[e] + w2[e] * gc[e]) * vv[e];
        *(u32x4*)(V + ((size_t)64 * sp + rs) * DFF + col) = pack8(o);
    }
}

__global__ void __launch_bounds__(512) fwd_megakernel(Params p) {
    extern __shared__ __attribute__((aligned(16))) unsigned char lds_raw[];
    LAS unsigned char* lds = (LAS unsigned char*)lds_raw;
    cg::grid_group grid = cg::this_grid();
    const int wave_sg = __builtin_amdgcn_readfirstlane((int)threadIdx.x >> 6);
    if (threadIdx.x < 4) ((volatile LAS unsigned*)(lds + 131072))[threadIdx.x] = 0u;
    __syncthreads();
    (void)xcd_barrier_post((unsigned*)(p.ws + WS_BAR), (volatile LAS unsigned*)(lds + 131072));
    if (p.ph_hi < 0) grid.sync();
#if defined(__HIP_DEVICE_COMPILE__)
#define GRID_BARRIER() xcd_barrier((unsigned*)(((const __attribute__((address_space(4))) Params*)__builtin_amdgcn_kernarg_segment_ptr())->ws + WS_BAR), (volatile LAS unsigned*)(lds + 131072), wave_sg == 0 && lane_id_hw() == 0)
#else
#define GRID_BARRIER() xcd_barrier((unsigned*)(p.ws + WS_BAR), (volatile LAS unsigned*)(lds + 131072), wave_sg == 0 && lane_id_hw() == 0)
#endif
    const int lo = p.ph_lo, hi = p.ph_hi;
    int ph = 0;
#ifndef REP_MASK
#define REP_MASK 0
#endif
#if defined(__HIP_DEVICE_COMPILE__)
#define LOAD_ARGS const __attribute__((address_space(4))) Params* kp_ = (const __attribute__((address_space(4))) Params*)__builtin_amdgcn_kernarg_segment_ptr(); asm volatile("" : "+s"(kp_)); Params pp = *kp_;
#else
#define LOAD_ARGS Params pp = p;
#endif
#define PHASE_BEGIN if (ph >= lo && ph < hi) { const int nrep_ = 1 + ((REP_MASK >> ph) & 1); for (int rep_ = 0; rep_ < nrep_; ++rep_) { if (rep_) GRID_BARRIER(); LOAD_ARGS int ll = l; int tid_ = (wave_sg << 6) | lane_id_hw(); asm volatile("" : "+v"(tid_)); asm volatile("" : "+s"(pp.ws), "+s"(ll)); asm volatile("" : "+s"(pp.out));
#define PHASE_END } } ++ph; if (ph > lo && ph < hi) GRID_BARRIER();
    { const int l = 0; PHASE_BEGIN p0_phase(pp, lds, tid_); PHASE_END }
#ifdef REP_SCAN
#define REP_SCAN_N REP_SCAN
#else
#define REP_SCAN_N 0
#endif
#ifdef REP_ATTN
#define REP_ATTN_N 1
#else
#define REP_ATTN_N 0
#endif
#define LAYER_BODY(l)  \
        PHASE_BEGIN norm_phase(pp, lds, (ll == 0) ? pp.x : (const float*)pp.out, pp.norm1 + ll * D_, ll, 0, 2048, ll == 0, tid_); PHASE_END \
        PHASE_BEGIN { GAS unsigned char* wl = pp.ws + WS_W + (size_t)ll * W_LAYER; \
            win_small_cols(pp, lds, ll, tid_); pg8::Gemm g{(const bf16_t*)(pp.ws + WS_H), (const bf16_t*)(wl + W_IN_OFF), T_, 7168, D_}; pg8::StaticOrder S; S.init(T_, 7168, (int)gridDim.x, (int)blockIdx.x); \
            pg8::EpiBf16 E{(bf16_t*)(pp.ws + WS_PROJ), NIN, 0, 0}; pg8::gemm_phase(lds, g, S, E, tid_); } PHASE_END \
        PHASE_BEGIN gdn_prep_phase(pp, lds, ll, tid_); PHASE_END \
        PHASE_BEGIN if ((int)blockIdx.x < 32) { scan_phase<0>(pp, lds, tid_); \
            if (REP_SCAN_N) { __syncthreads(); scan_phase<(REP_SCAN_N > 0 ? REP_SCAN_N - 1 : 0)>(pp, lds, tid_); } \
            } else { sb_attn_phase(pp, lds, ll, 32, (int)gridDim.x - 32, tid_); \
            if (REP_ATTN_N) { __syncthreads(); sb_attn_phase(pp, lds, ll, 32, (int)gridDim.x - 32, tid_); } \
            { __syncthreads(); const int gw_ = ((int)blockIdx.x - 32) * 8 + (tid_ >> 6), ng_ = ((int)gridDim.x - 32) * 8;        \
              weight_transposes(pp, lds, tid_, l, 2 | 4 | 8, gw_, ng_); if (l == 0) weight_transposes(pp, lds, tid_, 1, 1, gw_, ng_); } \
            } PHASE_END \
        PHASE_BEGIN gdn_finalize_phase(pp, ll, tid_); PHASE_END \
        PHASE_BEGIN { GAS unsigned char* wl = pp.ws + WS_W + (size_t)ll * W_LAYER; const float* modf = (const float*)(pp.ws + WS_MODF) + ll * 12288; \
            pg8::Gemm g{(const bf16_t*)(pp.ws + WS_OCAT), (const bf16_t*)(wl + W_OUT_OFF), T_, D_, D_}; pg8::StaticOrder S; S.init(T_, D_, (int)gridDim.x, (int)blockIdx.x); \
            pg8::EpiRes E{(ll == 0) ? pp.x : (const float*)pp.out, (float*)pp.out, D_, modf + 4096}; pg8::gemm_phase(lds, g, S, E, tid_); } PHASE_END \
        PHASE_BEGIN norm_phase(pp, lds, (const float*)pp.out, pp.norm2 + ll * D_, ll, 6144, 8192, false, tid_); PHASE_END \
        PHASE_BEGIN { GAS unsigned char* wl = pp.ws + WS_W + (size_t)ll * W_LAYER; \
            pg8::Gemm g{(const bf16_t*)(pp.ws + WS_H), (const bf16_t*)(wl + W_UP_OFF), T_, NUP, D_}; pg8::StaticOrder S; S.init(T_, NUP, (int)gridDim.x, (int)blockIdx.x); \
            pg8::EpiAct E{(bf16_t*)(pp.ws + WS_V), (bf16_t*)(pp.ws + WS_G), (bf16_t*)(pp.ws + WS_G + 8 * MiB), (bf16_t*)(pp.ws + WS_G + 16 * MiB), pp.conv_ffn + (size_t)ll * 3 * DFF}; pg8::gemm_phase(lds, g, S, E, tid_); } PHASE_END \
        PHASE_BEGIN { GAS unsigned char* wl = pp.ws + WS_W + (size_t)ll * W_LAYER; const float* modf = (const float*)(pp.ws + WS_MODF) + ll * 12288; \
            pg8::Gemm g{(const bf16_t*)(pp.ws + WS_V), (const bf16_t*)(wl + W_DN_OFF), T_, D_, DFF}; pg8::StaticOrder S; S.init(T_, D_, (int)gridDim.x, (int)blockIdx.x); \
            { pg8::Unit uu_; int last_ = -1; for (int i_ = 0; S.next(i_, uu_); ++i_) if (uu_.pm != last_) { act_fix_rows(pp, ll, tid_, uu_.pm); last_ = uu_.pm; } asm volatile("s_waitcnt vmcnt(0)" ::: "memory"); __syncthreads(); } \
            pg8::EpiRes E{(const float*)pp.out, (float*)pp.out, D_, modf + 10240}; pg8::gemm_phase(lds, g, S, E, tid_); } PHASE_END \

    { const int l = 0; LAYER_BODY(l) }
    { const int l = 1; LAYER_BODY(l) }
#undef LAYER_BODY
#undef PHASE_BEGIN
#undef PHASE_END
#ifdef EXTRA_SYNCS
    for (int e = 0; e < EXTRA_SYNCS; ++e) GRID_BARRIER();
#endif
#ifdef DBG_OFF
    GRID_BARRIER();
    { const bf16_t* src = (const bf16_t*)(p.ws + (size_t)DBG_OFF);
      for (size_t i = (size_t)blockIdx.x * 512 + ((wave_sg << 6) | lane_id_hw()); i < (size_t)T_ * D_; i += (size_t)gridDim.x * 512) p.out[i] = bf2f(src[i]); }
#endif
}

extern "C" void kernel_launch(void* const* d_in, const int* in_sizes, int n_in, void* d_out, int out_size, void* d_ws, size_t ws_size, hipStream_t stream) {
    static int grid = 0;
    if (grid == 0) {
        if (n_in != 17 || ws_size < WS_END) { fprintf(stderr, "kernel_launch: expected 17 inputs and >= %zu bytes of workspace; got %d, %zu\n", (size_t)WS_END, n_in, ws_size); grid = -1; return; }
        int dev = 0, cus = 0, per_cu = 0;
        hipGetDevice(&dev); hipDeviceGetAttribute(&cus, hipDeviceAttributeMultiprocessorCount, dev);
        if (hipFuncSetAttribute((const void*)fwd_megakernel, hipFuncAttributeMaxDynamicSharedMemorySize, LDS_BYTES) != hipSuccess) { fprintf(stderr, "kernel_launch: hipFuncSetAttribute failed\n"); grid = -1; return; }
        hipOccupancyMaxActiveBlocksPerMultiprocessor(&per_cu, (const void*)fwd_megakernel, 512, LDS_BYTES);
        if (per_cu < 1) { fprintf(stderr, "kernel_launch: occupancy query says %d blocks/CU\n", per_cu); per_cu = 1; }
        (void)hipGetLastError();
        grid = cus;
        if (grid > 256) grid = 256;
    }
    if (grid < 0) return;
    Params p{};
    p.x = (const float*)d_in[0]; p.c = (const float*)d_in[1]; p.w_ada = (const float*)d_in[2]; p.b_ada = (const float*)d_in[3]; p.norm1 = (const float*)d_in[4];
    p.w_in = (const float*)d_in[5]; p.conv_qkv = (const float*)d_in[6]; p.a_log = (const float*)d_in[7]; p.dt_bias = (const float*)d_in[8]; p.gdn_norm = (const float*)d_in[9];
    p.sbq = (const float*)d_in[10]; p.sbk = (const float*)d_in[11]; p.w_out = (const float*)d_in[12]; p.norm2 = (const float*)d_in[13]; p.w_up = (const float*)d_in[14];
    p.conv_ffn = (const float*)d_in[15]; p.w_down = (const float*)d_in[16];
    p.out = (GAS float*)d_out; p.ws = (GAS unsigned char*)d_ws; p.ph_lo = 0; p.ph_hi = 19;
#ifdef DBG_HI
    p.ph_hi = DBG_HI;
#endif
    if (hipMemsetAsync((char*)d_ws + WS_BAR, 0, XCD_BAR_WORDS * 4, stream) != hipSuccess) { fprintf(stderr, "kernel_launch: hipMemsetAsync failed\n"); return; }
    void* args[] = {&p};
    hipError_t e = hipLaunchCooperativeKernel((const void*)fwd_megakernel, dim3(grid), dim3(512), args, LDS_BYTES, stream);
    if (e != hipSuccess) fprintf(stderr, "cooperative launch failed: %s (grid %d)\n", hipGetErrorString(e), grid);
}
```

```cpp
#define REP_S1 2
#include <hip/hip_runtime.h>
#include <hip/hip_cooperative_groups.h>
#include <cstdio>
#include <cstdint>
namespace cg = cooperative_groups;

#define LAS __attribute__((address_space(3)))
#define GAS __attribute__((address_space(1)))
typedef unsigned short bf16_t;
typedef short bf16x8 __attribute__((ext_vector_type(8)));
typedef short s16x4 __attribute__((ext_vector_type(4)));
typedef float f32x4 __attribute__((ext_vector_type(4)));
typedef float f32x2 __attribute__((ext_vector_type(2)));
typedef unsigned u32x4 __attribute__((ext_vector_type(4)));
typedef unsigned u32x2 __attribute__((ext_vector_type(2)));

constexpr int T_ = 16384, D_ = 2048, DIN = 7184, NIN = 7424, DFF = 5632, NUP = 11264, NH = 8;
constexpr int PQ_A = 0, PK_A = 1024, PV_A = 2048, PZ_A = 3072, PQ_B = 4096, PK_B = 5120, PV_B = 6144, PBETA = 7168, PALPHA = 7176;
constexpr int KS_MOD = 16;
constexpr float EPS_ = 1e-6f;
constexpr size_t MiB = 1024ull * 1024ull;
constexpr size_t WS_MODF = 0;
constexpr size_t WS_MODP = 131072;
constexpr size_t WS_EGL = 1835008;
constexpr size_t WS_PROG = 1900544;
constexpr size_t WS_BAR = 1904640;
constexpr size_t WS_W = 2 * MiB;
constexpr size_t W_IN_OFF = 0, W_OUT_OFF = 29 * MiB, W_UP_OFF = 37 * MiB, W_DN_OFF = 81 * MiB, W_LAYER = 103 * MiB;
constexpr size_t WS_H = 208 * MiB;
constexpr size_t WS_PROJ = 272 * MiB;
constexpr size_t WS_G = 272 * MiB, WS_V = 448 * MiB;
constexpr size_t WS_OCAT = 504 * MiB;
constexpr size_t WS_GDN = 568 * MiB;
constexpr size_t WS_END = 712 * MiB;
constexpr int LDS_BYTES = 131072 + 256;

struct Params {
    const float *x, *c, *w_ada, *b_ada, *norm1, *w_in, *conv_qkv, *a_log, *dt_bias, *gdn_norm, *sbq, *sbk, *w_out, *norm2, *w_up, *conv_ffn, *w_down;
    GAS float* out; GAS unsigned char* ws; int ph_lo, ph_hi;
};

typedef __bf16 bf16v2 __attribute__((ext_vector_type(2)));
__device__ __forceinline__ unsigned pk2(float lo, float hi) { const f32x2 v = {lo, hi}; union { bf16v2 b; unsigned u; } x; x.b = __builtin_convertvector(v, bf16v2); return x.u; }
__device__ __forceinline__ float bf2f(bf16_t b) { return __uint_as_float(((unsigned)b) << 16); }
__device__ __forceinline__ float bflo(unsigned w) { return __uint_as_float(w << 16); }
__device__ __forceinline__ float bfhi(unsigned w) { return __uint_as_float(w & 0xffff0000u); }
__device__ __forceinline__ void unpack8(const u32x4 v, float* f) { f[0] = bflo(v.x); f[1] = bfhi(v.x); f[2] = bflo(v.y); f[3] = bfhi(v.y); f[4] = bflo(v.z); f[5] = bfhi(v.z); f[6] = bflo(v.w); f[7] = bfhi(v.w); }
__device__ __forceinline__ u32x4 pack8(const float* f) { u32x4 o; o.x = pk2(f[0], f[1]); o.y = pk2(f[2], f[3]); o.z = pk2(f[4], f[5]); o.w = pk2(f[6], f[7]); return o; }
__device__ __forceinline__ float silu_f(float y) { return y * __builtin_amdgcn_rcpf(1.0f + __expf(-y)); }
__device__ __forceinline__ float softplus_f(float z) { return fmaxf(z, 0.f) + log1pf(__expf(-fabsf(z))); }
__device__ __forceinline__ float softplus_fast(float z) { return fmaxf(z, 0.f) + __logf(1.0f + __expf(-fabsf(z))); }
__device__ __forceinline__ float wave_sum(float v) {
#pragma unroll
    for (int o = 1; o < 64; o <<= 1) v += __shfl_xor(v, o);
    return v;
}
__device__ __forceinline__ bf16x8 as_bf8(u32x4 v) { union { u32x4 u; bf16x8 b; } x; x.u = v; return x.b; }
#define MFMA16(a, b, c) __builtin_amdgcn_mfma_f32_16x16x32_bf16((a), (b), (c), 0, 0, 0)
#define LDS_WAIT() asm volatile("s_waitcnt lgkmcnt(0)" ::: "memory")
__device__ __forceinline__ int lane_id_hw() { return (int)__builtin_amdgcn_mbcnt_hi(~0u, __builtin_amdgcn_mbcnt_lo(~0u, 0u)); }
__device__ __forceinline__ int opaque_bid() { int b = (int)blockIdx.x; asm volatile("" : "+s"(b)); return b; }


#define XB_TMO      128
#define XB_XCNT(j)  (256  + 64 * (j))
#define XB_XSUB(j)  (1280 + 64 * (j))
#define XB_XGEN(j)  (2304 + 64 * (j))
#define XB_TOP      3328
#define XB_TOPGEN   3392
#define XCD_BAR_WORDS 3456
#define XB_SPIN_CAP (1u << 18)
__device__ __forceinline__ unsigned xb_ld(unsigned* p)              { return __hip_atomic_load(p, __ATOMIC_RELAXED, __HIP_MEMORY_SCOPE_AGENT); }
__device__ __forceinline__ unsigned xb_add(unsigned* p, unsigned v) { return __hip_atomic_fetch_add(p, v, __ATOMIC_RELAXED, __HIP_MEMORY_SCOPE_AGENT); }
__device__ __forceinline__ unsigned xb_xcc_id() { return (unsigned)__builtin_amdgcn_s_getreg((3 << 11) | 20) & 0xFu; }
#define XB_SPIN(cond, bar) do { unsigned _sp = 0; while (cond) { __builtin_amdgcn_s_sleep(1); \
    if ((++_sp & 255u) == 0u) { if (xb_ld(&(bar)[XB_TMO])) break; if (_sp > XB_SPIN_CAP) { atomicAdd(&(bar)[XB_TMO], 1u); break; } } } } while (0)
struct XcdBarrier { unsigned* bar; unsigned x; volatile LAS unsigned* st; };
__device__ __forceinline__ XcdBarrier xcd_barrier_post(unsigned* bar, volatile LAS unsigned* st) {
    XcdBarrier b; b.bar = bar; b.x = xb_xcc_id(); b.st = st;
    if (threadIdx.x == 0) (void)xb_add(&bar[XB_XCNT(b.x)], 1u);
    return b;
}
__device__ __forceinline__ void xcd_barrier_complete(unsigned* bar, unsigned x, unsigned& nloc, unsigned& nx) {
    const unsigned G = gridDim.x * gridDim.y * gridDim.z;
    unsigned sum, cnt, mine, sp = 0u;
    for (;;) {
        sum = 0u; cnt = 0u; mine = 0u;
#pragma unroll
        for (unsigned j = 0; j < 16; ++j) { const unsigned c = xb_ld(&bar[XB_XCNT(j)]); sum += c; cnt += (c > 0u) ? 1u : 0u; mine = (j == x) ? c : mine; }
        if (sum == G) break;
        __builtin_amdgcn_s_sleep(1);
        if ((++sp & 255u) == 0u) { if (xb_ld(&bar[XB_TMO])) break; if (sp > XB_SPIN_CAP) { atomicAdd(&bar[XB_TMO], 1u); break; } }
    }
    nloc = mine > 0u ? mine : 1u; nx = cnt > 0u ? cnt : 1u;
}
__device__ __forceinline__ void xcd_barrier(unsigned* bar, volatile LAS unsigned* st, const bool is_t0) {
    asm volatile("s_waitcnt vmcnt(0)" ::: "memory");
    __syncthreads();
    if (is_t0) {
        const unsigned x = xb_xcc_id();
        __builtin_amdgcn_s_waitcnt(0);
        unsigned nloc = st[0], nx = st[1];
        if (nloc == 0u) { xcd_barrier_complete(bar, x, nloc, nx); st[0] = nloc; st[1] = nx; }
        const unsigned old = xb_add(&bar[XB_XSUB(x)], 1u);
        const unsigned gen = old / nloc;
        if (old + 1u == (gen + 1u) * nloc) {
            __builtin_amdgcn_fence(__ATOMIC_RELEASE, "agent");
            asm volatile("s_waitcnt vmcnt(0)" ::: "memory");
            const unsigned og = xb_add(&bar[XB_TOP], 1u);
            const unsigned tg = og / nx;
            if (og + 1u == (tg + 1u) * nx) xb_add(&bar[XB_TOPGEN], 1u);
            else XB_SPIN(xb_ld(&bar[XB_TOPGEN]) == tg, bar);
            __builtin_amdgcn_fence(__ATOMIC_ACQUIRE, "agent");
            xb_add(&bar[XB_XGEN(x)], 1u);
            asm volatile("s_waitcnt vmcnt(0)" ::: "memory");
        } else {
            XB_SPIN(xb_ld(&bar[XB_XGEN(x)]) == gen, bar);
            __builtin_amdgcn_fence(__ATOMIC_ACQUIRE, "agent");
            asm volatile("s_waitcnt vmcnt(0)" ::: "memory");
        }
    }
    __syncthreads();
}

namespace pg8 {
constexpr int BM = 256, BK = 64, HALF = 128, HTB = HALF * BK * 2, STAGE_BYTES = 8 * HTB, NXCD = 8, WGM = 8;
__host__ __device__ __forceinline__ int lds_byte(int r, int c) { const int st = (r >> 4) * 2 + (c >> 5), rr = r & 15, cc = c & 31, ob = rr * 64 + cc * 2; return st * 1024 + (ob ^ (((ob >> 9) & 1) << 5)); }
__host__ __device__ __forceinline__ void stage_rc(int b, int& R, int& C) { const int st = b / 1024, sb = b % 1024, swz = sb ^ (((sb >> 9) & 1) << 5); R = (st >> 1) * 16 + swz / 64; C = (st & 1) * 32 + (swz % 64) / 2; }
__host__ __device__ __forceinline__ int perm32(int rho) { const int n = rho >> 4, i = rho & 15; return 8 * (i >> 2) + 4 * n + (i & 3); }
struct Unit { int pm, pn; };
struct Gemm { const bf16_t* A; const bf16_t* Bt; int M, N, K; };
struct StaticOrder {
    int nM, nN, nwg, G, c;
    __device__ __forceinline__ void init(int M, int N, int G_, int c_) { nM = M / BM; nN = N / BM; nwg = nM * nN; G = G_; c = c_; }
    __device__ __forceinline__ bool next(int i, Unit& u) const {
        const long L = (long)i * G + c; if (L >= nwg) return false;
        int wgid = (int)L; { const int q = nwg / NXCD, r = nwg % NXCD, xcd = wgid % NXCD, off = wgid / NXCD; wgid = (xcd < r ? xcd * (q + 1) : r * (q + 1) + (xcd - r) * q) + off; }
        const int nig = WGM * nN, gid = wgid / nig, fm = gid * WGM, gsz = (nM - fm) < WGM ? (nM - fm) : WGM;
        u.pm = fm + ((wgid % nig) % gsz); u.pn = (wgid % nig) / gsz; return true;
    }
};
struct EpiBf16 {
    static constexpr bool PERM = true;
    bf16_t* O; int ldc; int split_cols; size_t split_stride;
    __device__ __forceinline__ void operator()(const f32x4 (&acc)[2][2][4][2], const Unit& u, int wr, int wc, int fr, int fq) const {
        const int row0 = u.pm * BM + wr * 64 + fr; int colt = u.pn * BM; bf16_t* base = O;
        if (split_cols) { const int t = colt / split_cols; base += (size_t)t * split_stride; colt -= t * split_cols; }
        const int col0 = colt + wc * 32 + 8 * fq;
#pragma unroll
        for (int ai = 0; ai < 2; ++ai)
#pragma unroll
            for (int m = 0; m < 4; ++m) { bf16_t* rowp = base + (size_t)(row0 + ai * HALF + m * 16) * ldc + col0;
#pragma unroll
                for (int bj = 0; bj < 2; ++bj) { const f32x4 v0 = acc[ai][bj][m][0], v1 = acc[ai][bj][m][1];
                    u32x4 w; w.x = pk2(v0[0], v0[1]); w.y = pk2(v0[2], v0[3]); w.z = pk2(v1[0], v1[1]); w.w = pk2(v1[2], v1[3]);
                    *(u32x4*)(rowp + bj * HALF) = w; } }
    }
};
struct EpiRes {
    static constexpr bool PERM = false;
    const float* xin; float* out; int ldc; const float* gate;
    __device__ __forceinline__ void operator()(const f32x4 (&acc)[2][2][4][2], const Unit& u, int wr, int wc, int fr, int fq) const {
        const int row0 = u.pm * BM + wr * 64 + fr, col0 = u.pn * BM + wc * 32 + 4 * fq;
        f32x4 gv[2][2];
#pragma unroll
        for (int bj = 0; bj < 2; ++bj)
#pragma unroll
            for (int n = 0; n < 2; ++n) gv[bj][n] = *(const f32x4*)(gate + col0 + bj * HALF + n * 16);
#pragma unroll
        for (int ai = 0; ai < 2; ++ai) {
            f32x4 xv[4][2][2];
#pragma unroll
            for (int m = 0; m < 4; ++m) { const size_t off = (size_t)(row0 + ai * HALF + m * 16) * ldc + col0;
#pragma unroll
                for (int bj = 0; bj < 2; ++bj)
#pragma unroll
                    for (int n = 0; n < 2; ++n) xv[m][bj][n] = *(const f32x4*)(xin + off + bj * HALF + n * 16); }
#pragma unroll
            for (int m = 0; m < 4; ++m) { const size_t off = (size_t)(row0 + ai * HALF + m * 16) * ldc + col0;
#pragma unroll
                for (int bj = 0; bj < 2; ++bj)
#pragma unroll
                    for (int n = 0; n < 2; ++n) *(f32x4*)(out + off + bj * HALF + n * 16) = xv[m][bj][n] + gv[bj][n] * acc[ai][bj][m][n]; }
            asm volatile("" ::: "memory"); }
    }
};
struct EpiAct {
    static constexpr bool PERM = true;
    bf16_t* V; bf16_t* Gh; bf16_t* Gt; bf16_t* Vh; const float* cw;
    __device__ __forceinline__ void operator()(const f32x4 (&acc)[2][2][4][2], const Unit& u, int wr, int wc, int fr, int fq) const {
        const int lane = fr + 16 * fq, ff0 = u.pn * HALF + wc * 32 + 8 * fq;
        float w0[8], w1[8], w2[8];
#pragma unroll
        for (int e = 0; e < 8; ++e) { w0[e] = cw[ff0 + e]; w1[e] = cw[DFF + ff0 + e]; w2[e] = cw[2 * DFF + ff0 + e]; }
        const int src1 = (fr >= 1) ? lane - 1 : lane + 15, src2 = (fr >= 2) ? lane - 2 : lane + 14;
#pragma unroll
        for (int ai = 0; ai < 2; ++ai) { const int strip = 4 * u.pm + 2 * ai + wr; const size_t row_base = (size_t)u.pm * BM + ai * HALF + wr * 64;
#pragma unroll
            for (int m = 0; m < 4; ++m) { float o[8], gr[8];
#pragma unroll
                for (int n = 0; n < 2; ++n)
#pragma unroll
                    for (int j = 0; j < 4; ++j) { const int e = 4 * n + j; const float g0 = acc[ai][0][m][n][j], v = acc[ai][1][m][n][j], gp = (m > 0) ? acc[ai][0][m > 0 ? m - 1 : 0][n][j] : 0.f;
                        const float s1_ = (fr == 15) ? gp : g0, s2_ = (fr >= 14) ? gp : g0;
                        const float g1 = __int_as_float(__builtin_amdgcn_update_dpp(0, __float_as_int(s1_), 0x121, 0xf, 0xf, false)), g2 = __int_as_float(__builtin_amdgcn_update_dpp(0, __float_as_int(s2_), 0x122, 0xf, 0xf, false));
                        const float y = w0[e] * g2 + w1[e] * g1 + w2[e] * g0; const float a = y * __builtin_amdgcn_rcpf(1.0f + __expf(-y)) * v;
                        o[e] = (m == 0 && fr < 2) ? v : a; gr[e] = g0; }
                { u32x4 w; w.x = pk2(o[0], o[1]); w.y = pk2(o[2], o[3]); w.z = pk2(o[4], o[5]); w.w = pk2(o[6], o[7]);
                  *(u32x4*)(V + (row_base + 16 * m + fr) * DFF + ff0) = w;
                  if (m == 0 && fr < 2) *(u32x4*)(Vh + (size_t)(strip * 2 + fr) * DFF + ff0) = w; }
                if (m == 0 && fr < 2) { u32x4 w; w.x = pk2(gr[0], gr[1]); w.y = pk2(gr[2], gr[3]); w.z = pk2(gr[4], gr[5]); w.w = pk2(gr[6], gr[7]); *(u32x4*)(Gh + (size_t)(strip * 2 + fr) * DFF + ff0) = w; }
                if (m == 3 && fr >= 14) { u32x4 w; w.x = pk2(gr[0], gr[1]); w.y = pk2(gr[2], gr[3]); w.z = pk2(gr[4], gr[5]); w.w = pk2(gr[6], gr[7]); *(u32x4*)(Gt + (size_t)(strip * 2 + fr - 14) * DFF + ff0) = w; } } }
    }
};

template <class Epi>
__device__ __forceinline__ void gemm_phase(LAS unsigned char* lds, const Gemm g, const StaticOrder& S, const Epi& E, const int tid_in) {
    const int tid = tid_in, wid = __builtin_amdgcn_readfirstlane(tid >> 6), lane = tid & 63, wr = wid >> 2, wc = wid & 3, fr = lane & 15, fq = lane >> 4;
    const int K = g.K, nt = K / BK;
    unsigned voffA[2], voffB[2];
#pragma unroll
    for (int i = 0; i < 2; ++i) { int R, C; stage_rc(tid * 16 + i * 8192, R, C); const int Rb = Epi::PERM ? ((R & ~31) + perm32(R & 31)) : R;
        voffA[i] = (unsigned)(R * K + C) * 2u; voffB[i] = (unsigned)(Rb * K + C) * 2u; }
    const size_t kstep = (size_t)(BK * 2);
    const size_t hstep = (size_t)HALF * K * 2;
    const size_t tstep = 2 * hstep;
    const unsigned ldsw = (unsigned)wid * 1024u;
    const int aoff = lds_byte(wr * 64 + fr, fq * 8), boff = lds_byte(wc * 32 + fr, fq * 8);
#define PG8_SA(b, h) (((b) * 2 + (h)) * HTB)
#define PG8_SB(b, h) ((4 + (b) * 2 + (h)) * HTB)
#define PG8_STAGE(bufoff, gbase, voff) do { _Pragma("unroll") for (int _i = 0; _i < 2; ++_i) \
        __builtin_amdgcn_global_load_lds((const unsigned*)((const char*)(gbase) + (voff)[_i]), (LAS unsigned*)(lds + (bufoff) + ldsw + _i * 8192), 16, 0, 0); } while (0)
#define PG8_LDA(dst, b, h) do { _Pragma("unroll") for (int m = 0; m < 4; ++m) _Pragma("unroll") for (int k = 0; k < 2; ++k) dst[m][k] = *(const LAS bf16x8*)(lds + PG8_SA(b, h) + aoff + m * 2048 + k * 1024); } while (0)
#define PG8_LDB(dst, b, h) do { _Pragma("unroll") for (int n = 0; n < 2; ++n) _Pragma("unroll") for (int k = 0; k < 2; ++k) dst[n][k] = *(const LAS bf16x8*)(lds + PG8_SB(b, h) + boff + n * 2048 + k * 1024); } while (0)
#define PG8_MMA(ai, bj, At, Bt) do { __builtin_amdgcn_s_setprio(1); _Pragma("unroll") for (int m = 0; m < 4; ++m) _Pragma("unroll") for (int n = 0; n < 2; ++n) _Pragma("unroll") for (int k = 0; k < 2; ++k) \
        acc[ai][bj][m][n] = __builtin_amdgcn_mfma_f32_16x16x32_bf16(Bt[n][k], At[m][k], acc[ai][bj][m][n], 0, 0, 0); __builtin_amdgcn_s_setprio(0); } while (0)
#define PG8_WAIT_V(n) asm volatile("s_waitcnt vmcnt(" #n ")" ::: "memory")
#define PG8_WAIT_L(n) asm volatile("s_waitcnt lgkmcnt(" #n ")" ::: "memory")
#define PG8_BAR __builtin_amdgcn_s_barrier()
#define PG8_SCHED __builtin_amdgcn_sched_barrier(0)
    Unit cur, nxt; int ui = 0;
    if (!S.next(0, cur)) return;
    f32x4 acc[2][2][4][2];
#pragma unroll
    for (int a = 0; a < 2; ++a)
#pragma unroll
        for (int b = 0; b < 2; ++b)
#pragma unroll
            for (int m = 0; m < 4; ++m)
#pragma unroll
                for (int n = 0; n < 2; ++n) acc[a][b][m][n] = (f32x4){0.f, 0.f, 0.f, 0.f};
    bf16x8 At[4][2], B0[2][2], B1[2][2];
    const char* cA = (const char*)g.A + (size_t)cur.pm * tstep; const char* cB = (const char*)g.Bt + (size_t)cur.pn * tstep;
    PG8_STAGE(PG8_SB(0, 0), cB, voffB); PG8_STAGE(PG8_SB(0, 1), cB + hstep, voffB); PG8_STAGE(PG8_SA(0, 0), cA, voffA); PG8_STAGE(PG8_SA(0, 1), cA + hstep, voffA);
    if (wr == 1) PG8_BAR;
    PG8_WAIT_V(2); PG8_BAR;
    PG8_STAGE(PG8_SB(1, 0), cB + kstep, voffB); PG8_STAGE(PG8_SA(1, 0), cA + kstep, voffA); PG8_STAGE(PG8_SB(1, 1), cB + hstep + kstep, voffB);
    PG8_WAIT_V(6); PG8_BAR;
    for (;;) {
        const bool has_next = S.next(ui + 1, nxt);
        const char* nA = has_next ? (const char*)g.A + (size_t)nxt.pm * tstep : cA; const char* nB = has_next ? (const char*)g.Bt + (size_t)nxt.pn * tstep : cB;
        for (int t = 0; t < nt; t += 2) {
            const bool last = (t == nt - 2);
            const char* a1 = cA + (size_t)(t + 1) * kstep;
            const char* a2 = last ? nA : cA + (size_t)(t + 2) * kstep; const char* b2 = last ? nB : cB + (size_t)(t + 2) * kstep;
            const char* a3 = a2 + kstep; const char* b3 = b2 + kstep;
            PG8_LDB(B0, 0, 0); PG8_LDB(B1, 0, 1); PG8_SCHED; PG8_LDA(At, 0, 0); PG8_STAGE(PG8_SA(1, 1), a1 + hstep, voffA);
            PG8_WAIT_V(8); PG8_WAIT_L(0); PG8_BAR; PG8_MMA(0, 0, At, B0); PG8_MMA(0, 1, At, B1); PG8_BAR; PG8_SCHED;
            PG8_LDA(At, 0, 1); PG8_STAGE(PG8_SB(0, 0), b2, voffB); PG8_STAGE(PG8_SB(0, 1), b2 + hstep, voffB); PG8_STAGE(PG8_SA(0, 0), a2, voffA);
            PG8_WAIT_V(8); PG8_WAIT_L(0); PG8_BAR; PG8_MMA(1, 0, At, B0); PG8_MMA(1, 1, At, B1); PG8_BAR; PG8_SCHED;
            PG8_LDB(B0, 1, 0); PG8_LDB(B1, 1, 1); PG8_SCHED; PG8_LDA(At, 1, 0); PG8_STAGE(PG8_SA(0, 1), a2 + hstep, voffA);
            PG8_WAIT_V(8); PG8_WAIT_L(0); PG8_BAR; PG8_MMA(0, 0, At, B0); PG8_MMA(0, 1, At, B1); PG8_BAR; PG8_SCHED;
            PG8_LDA(At, 1, 1); PG8_STAGE(PG8_SB(1, 0), b3, voffB); PG8_STAGE(PG8_SB(1, 1), b3 + hstep, voffB); PG8_STAGE(PG8_SA(1, 0), a3, voffA);
            PG8_WAIT_V(8); PG8_WAIT_L(0); PG8_BAR; PG8_MMA(1, 0, At, B0); PG8_MMA(1, 1, At, B1); PG8_BAR; PG8_SCHED;
        }
        if (wr == 0) PG8_BAR;
        E(acc, cur, wr, wc, fr, fq);
        if (!has_next) break;
#pragma unroll
        for (int a = 0; a < 2; ++a)
#pragma unroll
            for (int b = 0; b < 2; ++b)
#pragma unroll
                for (int m = 0; m < 4; ++m)
#pragma unroll
                    for (int n = 0; n < 2; ++n) acc[a][b][m][n] = (f32x4){0.f, 0.f, 0.f, 0.f};
        cur = nxt; cA = nA; cB = nB; ++ui;
        if (wr == 1) PG8_BAR;
    }
    PG8_WAIT_V(0);
    PG8_BAR;
#undef PG8_SA
#undef PG8_SB
#undef PG8_STAGE
#undef PG8_LDA
#undef PG8_LDB
#undef PG8_MMA
#undef PG8_WAIT_V
#undef PG8_WAIT_L
#undef PG8_BAR
#undef PG8_SCHED
}
}

__device__ __forceinline__ void transpose_item(const float* W, int K, int Nsrc, bf16_t* WT, int k0, int ndst0, int nsrc0, int nvalid, LAS float* scr, int lane) {
    float vv[32];
#pragma unroll
    for (int i = 0; i < 32; ++i) { const int kk = 2 * i + (lane >> 5), nn = lane & 31;
        vv[i] = (nn < nvalid) ? W[(size_t)(k0 + kk) * Nsrc + nsrc0 + nn] : 0.f; }
#pragma unroll
    for (int i = 0; i < 32; ++i) { const int kk = 2 * i + (lane >> 5), nn = lane & 31; scr[kk * 33 + nn] = vv[i]; }
    LDS_WAIT();
    const int c = lane & 7;
#pragma unroll
    for (int j = 0; j < 4; ++j) { const int n = (lane >> 3) + 8 * j; const LAS float* s = scr + (8 * c) * 33 + n;
        u32x4 o; o.x = pk2(s[0 * 33], s[1 * 33]); o.y = pk2(s[2 * 33], s[3 * 33]); o.z = pk2(s[4 * 33], s[5 * 33]); o.w = pk2(s[6 * 33], s[7 * 33]);
        *(u32x4*)(WT + (size_t)(ndst0 + n) * K + k0 + 8 * c) = o; }
    LDS_WAIT();
}
__device__ __forceinline__ void weight_transposes(const Params& p, LAS unsigned char* lds, const int tid_in, const int l, const int mask, const int gwv, const int NGW);
__device__ __forceinline__ void p0_phase(const Params& p, LAS unsigned char* lds, const int tid_in) {
    const int tid = tid_in, lane = tid & 63, wave = tid >> 6;
    LAS float* sc = (LAS float*)(lds + 8 * 8448);
    for (int k = tid; k < D_; k += 512) sc[k] = silu_f(p.c[k]);
    __syncthreads();
    { const int gw = wave * 256 + (int)blockIdx.x;
      if (gw < 1536) { const int g = gw * 64 + lane; const int l = g / 49152, rem = g % 49152, ks = rem / 3072, c4 = rem % 3072;
          const float* wp = p.w_ada + ((size_t)l * D_ + (size_t)ks * 128) * 12288 + 4 * c4;
          f32x4 a0 = {0.f, 0.f, 0.f, 0.f}, a1 = a0;
#pragma unroll 4
          for (int k = 0; k < 128; k += 2) { const f32x4 w0 = *(const f32x4*)(wp + (size_t)k * 12288), w1 = *(const f32x4*)(wp + (size_t)(k + 1) * 12288);
              a0 += w0 * sc[ks * 128 + k]; a1 += w1 * sc[ks * 128 + k + 1]; }
          *(f32x4*)((float*)(p.ws + WS_MODP) + ((size_t)(ks * 2 + l) * 12288 + 4 * c4)) = a0 + a1; } }
    weight_transposes(p, lds, tid_in, 0, 1, (int)blockIdx.x * 8 + wave, (int)gridDim.x * 8);
}
__device__ __forceinline__ void weight_transposes(const Params& p, LAS unsigned char* lds, const int tid_in, const int l, const int mask, const int gwv, const int NGW) {
    const int lane = tid_in & 63, wave = tid_in >> 6;
    LAS float* scr = (LAS float*)(lds + wave * 8448);
    constexpr int I_IN = 32 * 232, I_OUT = 32 * 64, I_UP = 32 * 352, I_DN = 88 * 64;
    const int n_in = (mask & 1) ? I_IN : 0, n_out = (mask & 2) ? I_OUT : 0, n_up = (mask & 4) ? I_UP : 0, n_dn = (mask & 8) ? I_DN : 0;
    GAS unsigned char* wl = p.ws + WS_W + (size_t)l * W_LAYER;
    for (int it = gwv; it < n_in + n_out + n_up + n_dn; it += NGW) {
        int r = it;
        if (r < n_in) { const int kb = r / 232, nb = r % 232, nd = 32 * nb; int ns, nv;
            if (nd < 4096) { ns = nd; nv = 32; } else if (nd < 7168) { ns = nd + 16; nv = 32; } else if (nd == 7168) { ns = 4096; nv = 16; } else { ns = 0; nv = 0; }
            transpose_item(p.w_in + (size_t)l * D_ * DIN, D_, DIN, (bf16_t*)(wl + W_IN_OFF), 64 * kb, nd, ns, nv, scr, lane); continue; }
        r -= n_in;
        if (r < n_out) { const int kb = r / 64, nb = r % 64; transpose_item(p.w_out + (size_t)l * D_ * D_, D_, D_, (bf16_t*)(wl + W_OUT_OFF), 64 * kb, 32 * nb, 32 * nb, 32, scr, lane); continue; }
        r -= n_out;
        if (r < n_up) { const int kb = r / 352, nb = r % 352, nd = 32 * nb, pn = nd >> 8, x0 = nd & 255;
            transpose_item(p.w_up + (size_t)l * D_ * NUP, D_, NUP, (bf16_t*)(wl + W_UP_OFF), 64 * kb, nd, (x0 < 128) ? 128 * pn + x0 : DFF + 128 * pn + (x0 - 128), 32, scr, lane); continue; }
        r -= n_up;
        { const int kb = r / 64, nb = r % 64; transpose_item(p.w_down + (size_t)l * DFF * D_, DFF, D_, (bf16_t*)(wl + W_DN_OFF), 64 * kb, 32 * nb, 32 * nb, 32, scr, lane); }
    }
}

__device__ __forceinline__ float mod_from_partials(const Params& p, int l, int j) {
    const float* mp = (const float*)(p.ws + WS_MODP);
    float v = p.b_ada[l * 12288 + j];
#pragma unroll
    for (int ks = 0; ks < KS_MOD; ++ks) v += mp[(size_t)(ks * 2 + l) * 12288 + j];
    return v;
}
__device__ __forceinline__ void norm_phase(const Params& p, LAS unsigned char* lds, const float* xin, const float* normw, int l, int off_shift, int off_scale, bool from_partials, const int tid_in) {
    const int tid = tid_in, lane = tid & 63, wave = tid >> 6;
    LAS float* cA = (LAS float*)lds; LAS float* cB = cA + D_;
    float* modf = (float*)(p.ws + WS_MODF);
    if (from_partials) {
        for (int idx = (int)blockIdx.x * 512 + tid; idx < 2 * 12288; idx += (int)gridDim.x * 512) modf[idx] = mod_from_partials(p, idx / 12288, idx % 12288);
        for (int j = tid; j < D_; j += 512) { const float sh = mod_from_partials(p, l, off_shift + j), scv = mod_from_partials(p, l, off_scale + j);
            cA[j] = normw[j] * (1.f + scv); cB[j] = sh; }
    } else {
        for (int j = tid; j < D_; j += 512) { cA[j] = normw[j] * (1.f + modf[l * 12288 + off_scale + j]); cB[j] = modf[l * 12288 + off_shift + j]; }
    }
    __syncthreads();
    f32x4 a[8], b[8];
#pragma unroll
    for (int j = 0; j < 8; ++j) { a[j] = *(const LAS f32x4*)(cA + 4 * lane + 256 * j); b[j] = *(const LAS f32x4*)(cB + 4 * lane + 256 * j); }
    bf16_t* H = (bf16_t*)(p.ws + WS_H);
    for (int m = (int)blockIdx.x * 8 + wave; m < T_; m += (int)gridDim.x * 8) {
        const f32x4* xr = (const f32x4*)(xin + (size_t)m * D_) + lane;
        f32x4 v[8]; float s = 0.f;
#pragma unroll
        for (int j = 0; j < 8; ++j) { v[j] = xr[64 * j]; s += (v[j].x * v[j].x + v[j].y * v[j].y) + (v[j].z * v[j].z + v[j].w * v[j].w); }
        const float rstd = rsqrtf(wave_sum(s) * (1.f / D_) + EPS_);
        u32x2* o8 = (u32x2*)(H + (size_t)m * D_) + lane;
#pragma unroll
        for (int j = 0; j < 8; ++j) { const f32x4 y = v[j] * rstd * a[j] + b[j]; u32x2 w; w.x = pk2(y.x, y.y); w.y = pk2(y.z, y.w); o8[64 * j] = w; }
    }
}


__device__ __forceinline__ void win_small_cols(const Params& p, LAS unsigned char* lds, int l, const int tid_in) {
    const int lane = tid_in & 63, wave = tid_in >> 6, r16 = lane & 15, q4 = lane >> 4;
    const int tw = wave & 3, kh = wave >> 2;
    const int m0 = ((int)blockIdx.x * 4 + tw) * 16;
    const bf16_t* H = (const bf16_t*)(p.ws + WS_H) + (size_t)(m0 + r16) * D_ + 8 * q4 + 1024 * kh;
    const bf16_t* Wt = (const bf16_t*)(p.ws + WS_W + (size_t)l * W_LAYER + W_IN_OFF) + (size_t)(7168 + r16) * D_ + 8 * q4 + 1024 * kh;
    f32x4 acc0 = {0.f, 0.f, 0.f, 0.f}, acc1 = acc0;
#pragma unroll 8
    for (int s = 0; s < 32; s += 2) {
        const bf16x8 a0 = *(const bf16x8*)(H + 32 * s), b0 = *(const bf16x8*)(Wt + 32 * s), a1 = *(const bf16x8*)(H + 32 * s + 32), b1 = *(const bf16x8*)(Wt + 32 * s + 32);
        acc0 = MFMA16(a0, b0, acc0); acc1 = MFMA16(a1, b1, acc1); }
    acc0 += acc1;
    LAS f32x4* xch = (LAS f32x4*)lds;
    if (kh) xch[tw * 64 + lane] = acc0;
    __syncthreads();
    if (!kh) { acc0 += xch[tw * 64 + lane];
        bf16_t* proj = (bf16_t*)(p.ws + WS_PROJ);
#pragma unroll
        for (int rg = 0; rg < 4; ++rg) proj[(size_t)(m0 + 4 * q4 + rg) * NIN + 7168 + r16] = (bf16_t)(pk2(acc0[rg], 0.f) & 0xffffu); }
    __syncthreads();
}

__device__ __forceinline__ void gdn_prep_phase(const Params& p, LAS unsigned char* lds, int l, const int tid_in) {
    const int tid0 = tid_in, wave = __builtin_amdgcn_readfirstlane(tid0 >> 6);
    LAS float* Lslot = (LAS float*)lds;
    LAS bf16_t* Qn = (LAS bf16_t*)(lds + 65536); LAS bf16_t* Kn = (LAS bf16_t*)(lds + 82944); LAS bf16_t* KdTs = (LAS bf16_t*)(lds + 100352);
    LAS float* betaS = (LAS float*)(lds + 118784); LAS float* gcS = (LAS float*)(lds + 119808); LAS float* gS = (LAS float*)(lds + 120832);
    LAS bf16_t* VbT = (LAS bf16_t*)(lds + 65536); LAS bf16_t* KbgT = (LAS bf16_t*)(lds + 82944);
    const bf16_t* proj = (const bf16_t*)(p.ws + WS_PROJ);
    bf16_t* Wg = (bf16_t*)(p.ws + WS_GDN); bf16_t* UTg = (bf16_t*)(p.ws + WS_GDN + 32 * MiB); bf16_t* KdTg = (bf16_t*)(p.ws + WS_GDN + 64 * MiB);
    bf16_t* Qgg = (bf16_t*)(p.ws + WS_GDN + 96 * MiB); bf16_t* Ag = (bf16_t*)(p.ws + WS_GDN + 128 * MiB);
    float* egl = (float*)(p.ws + WS_EGL);
    LAS float* cwS = (LAS float*)(lds + 122880);
    { const int h0 = ((int)blockIdx.x * 8) >> 8; const float* convw = p.conv_qkv + (size_t)l * 4 * 3072;
      for (int u = tid0; u < 4 * 3 * 128; u += 512) { const int r = u / 384, xx = (u % 384) >> 7, d = u & 127; cwS[u] = convw[r * 3072 + xx * 1024 + h0 * 128 + d]; }
      __syncthreads(); }
#pragma unroll 1
    for (int batch = 0; batch < 2; ++batch) {
        { int tid = tid0; asm volatile("" : "+v"(tid));
          const int kk = tid >> 6, row = tid & 63;
          if (tid < 256) { const int I = (int)blockIdx.x * 8 + batch * 4 + kk, h = I >> 8, c = I & 255; const size_t t = (size_t)64 * c + row;
              const float braw = bf2f(proj[t * NIN + PBETA + h]), araw = bf2f(proj[t * NIN + PALPHA + h]);
              betaS[kk * 64 + row] = 1.f / (1.f + __expf(-braw));
              float g = -__expf(p.a_log[l * NH + h]) * softplus_f(araw + p.dt_bias[l * NH + h]);
#pragma unroll
              for (int o = 1; o < 64; o <<= 1) { const float u = __shfl_up(g, o); if (row >= o) g += u; }
              gcS[kk * 64 + row] = g; if (row == 63) egl[I] = __expf(g); }
          __syncthreads(); }
        u32x4 raw[3][4][2];
#define PREP_LOADRAW(kq) do { const int I_ = (int)blockIdx.x * 8 + batch * 4 + (kq), h_ = I_ >> 8, c_ = I_ & 255; \
            _Pragma("unroll") for (int X = 0; X < 3; ++X) _Pragma("unroll") for (int r = 0; r < 4; ++r) { int tt_ = 64 * c_ + (tid0 >> 3) - 3 + r; tt_ = tt_ < 0 ? 0 : tt_; \
                const u32x4* pp_ = (const u32x4*)(proj + (size_t)tt_ * NIN + X * 1024 + h_ * 128 + 16 * (tid0 & 7)); raw[X][r][0] = pp_[0]; raw[X][r][1] = pp_[1]; } } while (0)
        PREP_LOADRAW(0);
#pragma unroll 1
        for (int k = 0; k < 4; ++k) {
            int tid = tid0; asm volatile("" : "+v"(tid));
            const int lane = tid & 63, r16 = lane & 15, q4 = lane >> 4, i = tid >> 3, sub = tid & 7;
            const int I = (int)blockIdx.x * 8 + batch * 4 + k, h = I >> 8, c = I & 255, t = 64 * c + i;
            const float gci = gcS[k * 64 + i], glast = gcS[k * 64 + 63];
#pragma unroll
            for (int X = 0; X < 3; ++X) {
                const int col = X * 1024 + h * 128 + 16 * sub;
                float y[16];
#pragma unroll
                for (int e = 0; e < 16; ++e) y[e] = 0.f;
#pragma unroll
                for (int r = 0; r < 4; ++r) { const int tt = t - 3 + r;
                    if (tt >= 0) { float xv[16]; unpack8(raw[X][r][0], xv); unpack8(raw[X][r][1], xv + 8);
                        const LAS f32x4* wp = (const LAS f32x4*)(cwS + (r * 3 + X) * 128 + 16 * sub);
#pragma unroll
                        for (int e4 = 0; e4 < 4; ++e4) { const f32x4 w = wp[e4]; y[4 * e4] += w.x * xv[4 * e4]; y[4 * e4 + 1] += w.y * xv[4 * e4 + 1]; y[4 * e4 + 2] += w.z * xv[4 * e4 + 2]; y[4 * e4 + 3] += w.w * xv[4 * e4 + 3]; } } }
                float ss = 0.f;
#pragma unroll
                for (int e = 0; e < 16; ++e) { y[e] = silu_f(y[e]); ss += y[e] * y[e]; }
                if (X < 2) { ss += __shfl_xor(ss, 1); ss += __shfl_xor(ss, 2); ss += __shfl_xor(ss, 4);
                    const float scl = rsqrtf(ss + EPS_) * (X == 0 ? 0.08838834764831845f : 1.f);
#pragma unroll
                    for (int e = 0; e < 16; ++e) y[e] *= scl; }
                if (X == 0) { *(LAS u32x4*)(Qn + i * 136 + 16 * sub) = pack8(y); *(LAS u32x4*)(Qn + i * 136 + 16 * sub + 8) = pack8(y + 8);
                    const float eg = __expf(gci); float z[16];
#pragma unroll
                    for (int e = 0; e < 16; ++e) z[e] = y[e] * eg;
                    { const int c8a = 2 * sub, c8b = 2 * sub + 1;
                      *(u32x4*)(Qgg + (size_t)I * 8192 + ((((i >> 4) * 4 + (c8a >> 2)) * 64 + (c8a & 3) * 16 + (i & 15)) * 8)) = pack8(z);
                      *(u32x4*)(Qgg + (size_t)I * 8192 + ((((i >> 4) * 4 + (c8b >> 2)) * 64 + (c8b & 3) * 16 + (i & 15)) * 8)) = pack8(z + 8); }
                } else if (X == 1) { const u32x4 k0 = pack8(y), k1 = pack8(y + 8);
                    *(LAS u32x4*)(Kn + i * 136 + 16 * sub) = k0; *(LAS u32x4*)(Kn + i * 136 + 16 * sub + 8) = k1;
                    u32x4* dst = (u32x4*)(Wg + ((size_t)I * 64 + i) * 128 + 16 * sub); dst[0] = k0; dst[1] = k1;
                    const float ed = __expf(glast - gci);
#pragma unroll
                    for (int e = 0; e < 16; e += 2) { const unsigned w = pk2(y[e] * ed, y[e + 1] * ed); KdTs[(16 * sub + e) * 72 + i] = (bf16_t)(w & 0xffffu); KdTs[(16 * sub + e + 1) * 72 + i] = (bf16_t)(w >> 16); }
                } else { u32x4* dst = (u32x4*)(UTg + ((size_t)I * 64 + i) * 128 + 16 * sub); dst[0] = pack8(y); dst[1] = pack8(y + 8); }
            }
            __syncthreads();
            if (k < 3) PREP_LOADRAW(k + 1);
#pragma unroll
            for (int u = 0; u < 2; ++u) { const int ch = tid + 512 * u, d = ch >> 3, part = ch & 7;
                *(u32x4*)(KdTg + (size_t)I * 8192 + ((((d >> 4) * 2 + (part >> 2)) * 64 + (part & 3) * 16 + (d & 15)) * 8)) = *(const LAS u32x4*)(KdTs + d * 72 + 8 * part); }
            { const int pr = wave >> 2, ti = wave & 3;
              for (int tj = 0; tj < 4; ++tj) {
                  f32x4 acc = {0.f, 0.f, 0.f, 0.f};
                  if (tj <= ti) {
#pragma unroll
                      for (int s = 0; s < 4; ++s) {
                          if (pr == 0) { const bf16x8 a = *(const LAS bf16x8*)(Kn + (16 * ti + r16) * 136 + 32 * s + 8 * q4), b = *(const LAS bf16x8*)(Kn + (16 * tj + r16) * 136 + 32 * s + 8 * q4); acc = MFMA16(a, b, acc); }
                          else { const bf16x8 a = *(const LAS bf16x8*)(Kn + (16 * tj + r16) * 136 + 32 * s + 8 * q4), b = *(const LAS bf16x8*)(Qn + (16 * ti + r16) * 136 + 32 * s + 8 * q4); acc = MFMA16(a, b, acc); }
                      }
                  }
                  if (pr == 0) {
                      if (tj <= ti) { const int jj = 16 * tj + r16; const float gj = gcS[k * 64 + jj];
#pragma unroll
                          for (int rg = 0; rg < 4; ++rg) { const int ii = 16 * ti + 4 * q4 + rg; const float v = (ii > jj) ? betaS[k * 64 + ii] * acc[rg] * __expf(gcS[k * 64 + ii] - gj) : 0.f;
                              Lslot[k * 4096 + ii * 64 + jj] = v; } }
                  } else {
                      const int ii = 16 * ti + r16; const float gi = gcS[k * 64 + ii]; float o[4];
#pragma unroll
                      for (int rg = 0; rg < 4; ++rg) { const int jj = 16 * tj + 4 * q4 + rg; o[rg] = (tj <= ti && ii >= jj) ? acc[rg] * __expf(gi - gcS[k * 64 + jj]) : 0.f; }
                      u32x2 w; w.x = pk2(o[0], o[1]); w.y = pk2(o[2], o[3]);
                      *(u32x2*)(Ag + (size_t)I * 4096 + (((ti * 2 + (tj >> 1)) * 64 + ((2 * tj + (q4 >> 1)) & 3) * 16 + r16) * 8) + 4 * (q4 & 1)) = w;
                  }
              } }
            __syncthreads();
        }
        if (wave < 4) {
            const int lane = tid0 & 63;
            LAS float* L = Lslot + wave * 4096; float tc[64];
#pragma unroll
            for (int ii = 0; ii < 64; ++ii) { float a = (lane == ii) ? 1.f : 0.f;
#pragma unroll
                for (int jj = 0; jj < ii; ++jj) a -= L[ii * 64 + jj] * tc[jj];
                tc[ii] = a;
                if ((ii & 3) == 3) asm volatile("" ::: "memory"); }
            LDS_WAIT();
#pragma unroll
            for (int ii = 0; ii < 64; ++ii) L[ii * 64 + lane] = tc[ii];
        }
        __syncthreads();
#pragma unroll 1
        for (int k = 0; k < 4; ++k) {
            int tid = tid0; asm volatile("" : "+v"(tid));
            const int lane = tid & 63, r16 = lane & 15, q4 = lane >> 4, i = tid >> 3, sub = tid & 7;
            const int I = (int)blockIdx.x * 8 + batch * 4 + k;
            { const float be = betaS[k * 64 + i], beg = be * __expf(gcS[k * 64 + i]);
              const u32x4* pk = (const u32x4*)(Wg + ((size_t)I * 64 + i) * 128 + 16 * sub); const u32x4* pv = (const u32x4*)(UTg + ((size_t)I * 64 + i) * 128 + 16 * sub);
              float kv[16], vv[16]; unpack8(pk[0], kv); unpack8(pk[1], kv + 8); unpack8(pv[0], vv); unpack8(pv[1], vv + 8);
#pragma unroll
              for (int e = 0; e < 16; ++e) { vv[e] *= be; kv[e] *= beg; }
              *(LAS u32x4*)(VbT + i * 136 + 16 * sub) = pack8(vv); *(LAS u32x4*)(VbT + i * 136 + 16 * sub + 8) = pack8(vv + 8);
              *(LAS u32x4*)(KbgT + i * 136 + 16 * sub) = pack8(kv); *(LAS u32x4*)(KbgT + i * 136 + 16 * sub + 8) = pack8(kv + 8); }
            __syncthreads();
            { const int pr = wave >> 2, ti = wave & 3; bf16x8 aT[2];
#pragma unroll
              for (int s = 0; s < 2; ++s) { const LAS float* tp = Lslot + k * 4096 + (16 * ti + r16) * 64 + 32 * s + 8 * q4; const f32x4 t0 = *(const LAS f32x4*)tp, t1 = *(const LAS f32x4*)(tp + 4);
                  u32x4 w; w.x = pk2(t0.x, t0.y); w.y = pk2(t0.z, t0.w); w.z = pk2(t1.x, t1.y); w.w = pk2(t1.z, t1.w); aT[s] = as_bf8(w); }
#pragma unroll 2
              for (int tn = 0; tn < 8; ++tn) { f32x4 acc = {0.f, 0.f, 0.f, 0.f};
                  if (pr == 0) {
#pragma unroll
                      for (int s = 0; s < 2; ++s) { const LAS bf16_t* bp = VbT + (32 * s + 8 * q4 + (r16 >> 2)) * 136 + 16 * tn + 4 * (r16 & 3);
                          const s16x4 t0 = __builtin_amdgcn_ds_read_tr16_b64_v4i16((LAS s16x4*)bp), t1 = __builtin_amdgcn_ds_read_tr16_b64_v4i16((LAS s16x4*)(bp + 4 * 136));
                          const bf16x8 b = {t0[0], t0[1], t0[2], t0[3], t1[0], t1[1], t1[2], t1[3]}; acc = MFMA16(aT[s], b, acc); }
                      u32x2 w; w.x = pk2(acc[0], acc[1]); w.y = pk2(acc[2], acc[3]);
                      *(u32x2*)(UTg + (size_t)I * 8192 + (((tn * 4 + ti) * 64 + lane) * 4)) = w;
                  } else {
#pragma unroll
                      for (int s = 0; s < 2; ++s) { const LAS bf16_t* bp = KbgT + (32 * s + 8 * q4 + (r16 >> 2)) * 136 + 16 * tn + 4 * (r16 & 3);
                          const s16x4 t0 = __builtin_amdgcn_ds_read_tr16_b64_v4i16((LAS s16x4*)bp), t1 = __builtin_amdgcn_ds_read_tr16_b64_v4i16((LAS s16x4*)(bp + 4 * 136));
                          const bf16x8 b = {t0[0], t0[1], t0[2], t0[3], t1[0], t1[1], t1[2], t1[3]}; acc = MFMA16(b, aT[s], acc); }
                      u32x2 w; w.x = pk2(acc[0], acc[1]); w.y = pk2(acc[2], acc[3]);
                      *(u32x2*)(Wg + (size_t)I * 8192 + (((ti * 4 + (tn >> 1)) * 64 + ((2 * tn + (q4 >> 1)) & 3) * 16 + r16) * 8) + 4 * (q4 & 1)) = w;
                  } } }
            __syncthreads();
        }
    }
}

struct ScanBuf { bf16x8 a4[4]; bf16x8 a2[2]; bf16x8 kd[2]; u32x2 u[2]; float eg; };
template <int ROLE, int HOT>
__device__ __forceinline__ void scan_loop(const Params& p, LAS bf16_t* ST, LAS bf16_t* VT, int h, int vs, int wave, int lane) {
    const int r16 = lane & 15, q4 = lane >> 4, tm = wave & 3;
    const bf16_t* Wg = (const bf16_t*)(p.ws + WS_GDN); const bf16_t* UTg = (const bf16_t*)(p.ws + WS_GDN + 32 * MiB); const bf16_t* KdTg = (const bf16_t*)(p.ws + WS_GDN + 64 * MiB);
    const bf16_t* Qgg = (const bf16_t*)(p.ws + WS_GDN + 96 * MiB); const bf16_t* Ag = (const bf16_t*)(p.ws + WS_GDN + 128 * MiB);
    const float* egl = (const float*)(p.ws + WS_EGL);
    bf16_t* ocat = (bf16_t*)(p.ws + (HOT ? WS_H : WS_OCAT));
    const bf16_t* p4 = ROLE ? Qgg : Wg;
    f32x4 accS[2] = {{0.f, 0.f, 0.f, 0.f}, {0.f, 0.f, 0.f, 0.f}};
    ScanBuf B[4];
#define SCAN_LOAD(buf, cc) do { const size_t I_ = (size_t)h * 256 + (HOT ? ((cc) & 3) : (cc)); \
        _Pragma("unroll") for (int s = 0; s < 4; ++s) (buf).a4[s] = *(const bf16x8*)(p4 + I_ * 8192 + ((tm * 4 + s) * 64 + lane) * 8); \
        _Pragma("unroll") for (int s = 0; s < 2; ++s) (buf).kd[s] = *(const bf16x8*)(KdTg + I_ * 8192 + ((wave * 2 + s) * 64 + lane) * 8); \
        if (ROLE) { _Pragma("unroll") for (int s = 0; s < 2; ++s) (buf).a2[s] = *(const bf16x8*)(Ag + I_ * 4096 + ((tm * 2 + s) * 64 + lane) * 8); } \
        else { _Pragma("unroll") for (int tn = 0; tn < 2; ++tn) (buf).u[tn] = *(const u32x2*)(UTg + I_ * 8192 + (((vs * 2 + tn) * 4 + tm) * 64 + lane) * 4); } \
        (buf).eg = egl[I_]; } while (0)
#pragma unroll
    for (int u = 0; u < 4; ++u) SCAN_LOAD(B[u], u);
    for (int c0 = 0; c0 < 256; c0 += 4) {
#pragma unroll
        for (int u = 0; u < 4; ++u) {
            const int c = c0 + u, pb = u & 1;
            const LAS bf16_t* STc = ST + pb * (32 * 136); LAS bf16_t* STn = ST + (pb ^ 1) * (32 * 136);
            if (ROLE == 0) asm volatile("" : "+v"(B[u].u[0].x), "+v"(B[u].u[0].y), "+v"(B[u].u[1].x), "+v"(B[u].u[1].y), "+v"(B[u].eg));
            else asm volatile("" : "+v"(B[u].eg));
            bf16x8 sf[2][4];
#pragma unroll
            for (int tn = 0; tn < 2; ++tn)
#pragma unroll
                for (int s = 0; s < 4; ++s) sf[tn][s] = *(const LAS bf16x8*)(STc + (16 * tn + r16) * 136 + 32 * s + 8 * q4);
            f32x4 o[2] = {{0.f, 0.f, 0.f, 0.f}, {0.f, 0.f, 0.f, 0.f}};
            if (ROLE == 0) {
#pragma unroll
                for (int tn = 0; tn < 2; ++tn) { f32x4 t1 = {0.f, 0.f, 0.f, 0.f};
#pragma unroll
                    for (int s = 0; s < 4; ++s) t1 = MFMA16(B[u].a4[s], sf[tn][s], t1);
                    const float v0 = bflo(B[u].u[tn].x) - t1[0], v1 = bfhi(B[u].u[tn].x) - t1[1], v2 = bflo(B[u].u[tn].y) - t1[2], v3 = bfhi(B[u].u[tn].y) - t1[3];
                    u32x2 w; w.x = pk2(v0, v1); w.y = pk2(v2, v3);
                    *(LAS u32x2*)(VT + (16 * tn + r16) * 72 + 16 * tm + 4 * q4) = w; }
            } else {
#pragma unroll
                for (int tn = 0; tn < 2; ++tn)
#pragma unroll
                    for (int s = 0; s < 4; ++s) o[tn] = MFMA16(sf[tn][s], B[u].a4[s], o[tn]);
            }
            accS[0] *= B[u].eg; accS[1] *= B[u].eg;
            LDS_WAIT(); __builtin_amdgcn_s_barrier(); asm volatile("" ::: "memory");
            bf16x8 vf[2][2];
#pragma unroll
            for (int tn = 0; tn < 2; ++tn)
#pragma unroll
                for (int s = 0; s < 2; ++s) vf[tn][s] = *(const LAS bf16x8*)(VT + (16 * tn + r16) * 72 + 32 * s + 8 * q4);
#pragma unroll
            for (int tn = 0; tn < 2; ++tn) {
#pragma unroll
                for (int s = 0; s < 2; ++s) accS[tn] = MFMA16(B[u].kd[s], vf[tn][s], accS[tn]);
                u32x2 w; w.x = pk2(accS[tn][0], accS[tn][1]); w.y = pk2(accS[tn][2], accS[tn][3]);
                *(LAS u32x2*)(STn + (16 * tn + r16) * 136 + 16 * wave + 4 * q4) = w; }
            if (ROLE) {
#pragma unroll
                for (int tn = 0; tn < 2; ++tn) {
#pragma unroll
                    for (int s = 0; s < 2; ++s) o[tn] = MFMA16(vf[tn][s], B[u].a2[s], o[tn]);
                    u32x2 w; w.x = pk2(o[tn][0], o[tn][1]); w.y = pk2(o[tn][2], o[tn][3]);
                    if (HOT < 2) *(u32x2*)(ocat + (size_t)(64 * c + 16 * tm + r16) * D_ + h * 128 + vs * 32 + 16 * tn + 4 * q4) = w; else asm volatile("" :: "v"(w.x), "v"(w.y)); }
            }
            { const int cn = (c + 4 < 256) ? c + 4 : 255; SCAN_LOAD(B[u], cn); }
            LDS_WAIT(); __builtin_amdgcn_s_barrier(); asm volatile("" ::: "memory");
        }
    }
#undef SCAN_LOAD
}
template <int HOT>
__device__ __forceinline__ void scan_phase(const Params& p, LAS unsigned char* lds, const int tid_in) {
    const int tid = tid_in, lane = tid & 63, wave = __builtin_amdgcn_readfirstlane(tid >> 6);
    const int h = (int)blockIdx.x & 7, vs = (int)blockIdx.x >> 3;
    LAS bf16_t* ST = (LAS bf16_t*)lds;
    LAS bf16_t* VT = (LAS bf16_t*)(lds + 17408);
    for (int u = tid; u < 2 * 32 * 136 / 2; u += 512) ((LAS unsigned*)ST)[u] = 0u;
    __syncthreads();
    if (wave < 4) scan_loop<0, HOT>(p, ST, VT, h, vs, wave, lane); else scan_loop<1, HOT>(p, ST, VT, h, vs, wave, lane);
    __syncthreads();
}


__device__ __forceinline__ void sb_attn_phase(const Params& p, LAS unsigned char* lds, int l, int first_blk, int nblk, const int tid_in) {
    const int tid = tid_in, lane = tid & 63, wave = __builtin_amdgcn_readfirstlane(tid >> 6);
    const int r16 = lane & 15, q4 = lane >> 4;
    LAS bf16_t* Qs = (LAS bf16_t*)lds; LAS bf16_t* Ks = (LAS bf16_t*)(lds + 34816); LAS bf16_t* Vs = (LAS bf16_t*)(lds + 52224);
    LAS float* Z = (LAS float*)(lds + 70656); LAS bf16_t* As = (LAS bf16_t*)(lds + 103936); LAS float* SegTot = (LAS float*)(lds + 122368);
    const bf16_t* proj = (const bf16_t*)(p.ws + WS_PROJ);
    bf16_t* ocat = (bf16_t*)(p.ws + WS_OCAT);
    const float* gq = p.sbq + l * 128; const float* gk = p.sbk + l * 128;
    const int q = tid & 127, seg = tid >> 7;
    for (int item = (int)blockIdx.x - first_blk; item < 1024; item += nblk) {
        const int h = item & 7, qb = 127 - (item >> 3);
#pragma unroll
        for (int u = 0; u < 4; ++u) { const int ch = tid + 512 * u, row = ch >> 4, c8 = ch & 15;
            float xv[8]; unpack8(*(const u32x4*)(proj + (size_t)(128 * qb + row) * NIN + PQ_B + h * 128 + 8 * c8), xv);
            float ss = 0.f;
#pragma unroll
            for (int e = 0; e < 8; ++e) ss += xv[e] * xv[e];
            ss += __shfl_xor(ss, 1); ss += __shfl_xor(ss, 2); ss += __shfl_xor(ss, 4); ss += __shfl_xor(ss, 8);
            const float sc = rsqrtf(ss * (1.f / 128.f) + EPS_) * 0.08838834764831845f;
#pragma unroll
            for (int e = 0; e < 8; ++e) xv[e] *= sc * gq[8 * c8 + e];
            *(LAS u32x4*)(Qs + row * 136 + 8 * c8) = pack8(xv); }
        f32x4 oacc[8];
#pragma unroll
        for (int tn = 0; tn < 8; ++tn) oacc[tn] = (f32x4){0.f, 0.f, 0.f, 0.f};
        float Rq = 0.f;
        const int tq = 128 * qb + q;
        u32x4 kreg[2], vreg[2];
#pragma unroll
        for (int u = 0; u < 2; ++u) { const int ch = tid + 512 * u, row = ch >> 4, c8 = ch & 15; const size_t rb = (size_t)(64 * (2 * qb + 1) + row) * NIN + h * 128 + 8 * c8;
            kreg[u] = *(const u32x4*)(proj + rb + PK_B); vreg[u] = *(const u32x4*)(proj + rb + PV_B); }
        for (int j = 2 * qb + 1; j >= 0; --j) {
#pragma unroll
            for (int u = 0; u < 2; ++u) { const int ch = tid + 512 * u, row = ch >> 4, c8 = ch & 15;
                float xv[8]; unpack8(kreg[u], xv);
                float ss = 0.f;
#pragma unroll
                for (int e = 0; e < 8; ++e) ss += xv[e] * xv[e];
                ss += __shfl_xor(ss, 1); ss += __shfl_xor(ss, 2); ss += __shfl_xor(ss, 4); ss += __shfl_xor(ss, 8);
                const float sc = rsqrtf(ss * (1.f / 128.f) + EPS_);
#pragma unroll
                for (int e = 0; e < 8; ++e) xv[e] *= sc * gk[8 * c8 + e];
                *(LAS u32x4*)(Ks + row * 136 + 8 * c8) = pack8(xv);
                *(LAS u32x4*)(Vs + row * 136 + 8 * c8) = vreg[u]; }
            { const int jn = j > 0 ? j - 1 : 0;
#pragma unroll
              for (int u = 0; u < 2; ++u) { const int ch = tid + 512 * u, row = ch >> 4, c8 = ch & 15; const size_t rb = (size_t)(64 * jn + row) * NIN + h * 128 + 8 * c8;
                  kreg[u] = *(const u32x4*)(proj + rb + PK_B); vreg[u] = *(const u32x4*)(proj + rb + PV_B); } }
            __syncthreads();
            { bf16x8 qf[4];
#pragma unroll
              for (int s = 0; s < 4; ++s) qf[s] = *(const LAS bf16x8*)(Qs + (16 * wave + r16) * 136 + 32 * s + 8 * q4);
#pragma unroll
              for (int tn = 0; tn < 4; ++tn) { f32x4 acc = {0.f, 0.f, 0.f, 0.f};
#pragma unroll
                  for (int s = 0; s < 4; ++s) { const bf16x8 kf = *(const LAS bf16x8*)(Ks + (16 * tn + r16) * 136 + 32 * s + 8 * q4); acc = MFMA16(qf[s], kf, acc); }
#pragma unroll
                  for (int rg = 0; rg < 4; ++rg) Z[(16 * wave + 4 * q4 + rg) * 65 + 16 * tn + r16] = acc[rg]; } }
            __syncthreads();
            float zz[16], ls[16], suf[16]; const int s0 = 64 * j + 16 * seg;
#pragma unroll
            for (int e = 0; e < 16; ++e) { zz[e] = Z[q * 65 + 16 * seg + e]; ls[e] = (s0 + e < tq) ? -softplus_fast(zz[e]) : 0.f; }
            float run = 0.f;
#pragma unroll
            for (int e = 15; e >= 0; --e) { suf[e] = run; run += ls[e]; }
            SegTot[seg * 128 + q] = run;
            __syncthreads();
            float hi = 0.f, all = 0.f;
#pragma unroll
            for (int sg = 0; sg < 4; ++sg) { const float tv = SegTot[sg * 128 + q]; all += tv; if (sg > seg) hi += tv; }
            const float base = Rq + hi; float av[16];
#pragma unroll
            for (int e = 0; e < 16; ++e) av[e] = (s0 + e < tq) ? __expf(zz[e] + ls[e] + base + suf[e]) : 0.f;
            Rq += all;
            *(LAS u32x4*)(As + q * 72 + 16 * seg) = pack8(av); *(LAS u32x4*)(As + q * 72 + 16 * seg + 8) = pack8(av + 8);
            __syncthreads();
            { bf16x8 af[2];
#pragma unroll
              for (int s = 0; s < 2; ++s) af[s] = *(const LAS bf16x8*)(As + (16 * wave + r16) * 72 + 32 * s + 8 * q4);
#pragma unroll
              for (int tn = 0; tn < 8; ++tn)
#pragma unroll
                  for (int s = 0; s < 2; ++s) {
                      const LAS bf16_t* vp = Vs + (32 * s + 8 * q4 + (r16 >> 2)) * 136 + 16 * tn + 4 * (r16 & 3);
                      const s16x4 t0 = __builtin_amdgcn_ds_read_tr16_b64_v4i16((LAS s16x4*)vp), t1 = __builtin_amdgcn_ds_read_tr16_b64_v4i16((LAS s16x4*)(vp + 4 * 136));
                      const bf16x8 vf = {t0[0], t0[1], t0[2], t0[3], t1[0], t1[1], t1[2], t1[3]};
                      oacc[tn] = MFMA16(vf, af[s], oacc[tn]); } }
            if (!__syncthreads_or(Rq >= -104.f)) break;
        }
        __syncthreads();
#pragma unroll
        for (int tn = 0; tn < 8; ++tn) { u32x2 w; w.x = pk2(oacc[tn][0], oacc[tn][1]); w.y = pk2(oacc[tn][2], oacc[tn][3]);
            *(u32x2*)(ocat + (size_t)(128 * qb + 16 * wave + r16) * D_ + 1024 + h * 128 + 16 * tn + 4 * q4) = w; }
    }
}

__device__ __forceinline__ void gdn_finalize_phase(const Params& p, int l, const int tid_in) {
    const int g = opaque_bid() * 512 + tid_in, l16 = g & 15;
    bf16_t* ocat = (bf16_t*)(p.ws + WS_OCAT); const bf16_t* proj = (const bf16_t*)(p.ws + WS_PROJ);
    float gn[8];
#pragma unroll
    for (int e = 0; e < 8; ++e) gn[e] = p.gdn_norm[l * 128 + 8 * l16 + e];
    const int Rstep = ((int)gridDim.x * 512) >> 4;
    for (int R0 = g >> 4; R0 < T_ * NH; R0 += 4 * Rstep) {
        u32x4 oraw[4], zraw[4];
#pragma unroll
        for (int q = 0; q < 4; ++q) { const int R = R0 + q * Rstep, t = R >> 3, h = R & 7;
            oraw[q] = *(const u32x4*)(ocat + (size_t)t * D_ + h * 128 + 8 * l16); zraw[q] = *(const u32x4*)(proj + (size_t)t * NIN + PZ_A + h * 128 + 8 * l16); }
#pragma unroll
        for (int q = 0; q < 4; ++q) { const int R = R0 + q * Rstep, t = R >> 3, h = R & 7;
            float ov[8], zv[8]; unpack8(oraw[q], ov); unpack8(zraw[q], zv);
            float ss = 0.f;
#pragma unroll
            for (int e = 0; e < 8; ++e) ss += ov[e] * ov[e];
            ss += __shfl_xor(ss, 1); ss += __shfl_xor(ss, 2); ss += __shfl_xor(ss, 4); ss += __shfl_xor(ss, 8);
            const float rs = rsqrtf(ss * (1.f / 128.f) + EPS_);
#pragma unroll
            for (int e = 0; e < 8; ++e) ov[e] = ov[e] * rs * gn[e] * silu_f(zv[e]);
            *(u32x4*)(ocat + (size_t)t * D_ + h * 128 + 8 * l16) = pack8(ov); }
    }
}

__device__ __forceinline__ void act_fix_rows(const Params& p, int l, const int tid_in, const int pm) {
    bf16_t* V = (bf16_t*)(p.ws + WS_V); const bf16_t* Gh = (const bf16_t*)(p.ws + WS_G); const bf16_t* Gt = (const bf16_t*)(p.ws + WS_G + 8 * MiB); const bf16_t* Vh = (const bf16_t*)(p.ws + WS_G + 16 * MiB);
    const float* cw = p.conv_ffn + (size_t)l * 3 * DFF;
    for (int it = tid_in; it < 8 * 704; it += 512) {
        const int q = it / 704, cc = it % 704, col = 8 * cc, sp = 4 * pm + (q >> 1), rs = q & 1;
        float w0[8], w1[8], w2[8], ga[8], gb[8], gc[8], vv[8], o[8];
#pragma unroll
        for (int e = 0; e < 8; ++e) { w0[e] = cw[col + e]; w1[e] = cw[DFF + col + e]; w2[e] = cw[2 * DFF + col + e]; }
        const int spm = sp > 0 ? sp - 1 : 0;
        const bf16_t* pa = rs ? Gt + (size_t)(spm * 2 + 1) * DFF + col : Gt + (size_t)(spm * 2) * DFF + col;
        const bf16_t* pb = rs ? Gh + (size_t)(sp * 2) * DFF + col : Gt + (size_t)(spm * 2 + 1) * DFF + col;
        const bf16_t* pc = rs ? Gh + (size_t)(sp * 2 + 1) * DFF + col : Gh + (size_t)(sp * 2) * DFF + col;
        unpack8(*(const u32x4*)pa, ga); unpack8(*(const u32x4*)pb, gb); unpack8(*(const u32x4*)pc, gc);
        const float za = (sp > 0) ? 1.f : 0.f, zb = (sp > 0 || rs) ? 1.f : 0.f;
#pragma unroll
        for (int e = 0; e < 8; ++e) { ga[e] *= za; gb[e] *= zb; }
        unpack8(*(const u32x4*)(Vh + (size_t)(sp * 2 + rs) * DFF + col), vv);
#pragma unroll
        for (int e = 0; e < 8; ++e) o[e] = silu_f(w0[e] * ga[e] + w1[e] * gb[e] + w2[e] * gc[e]) * vv[e];
        *(u32x4*)(V + ((size_t)64 * sp + rs) * DFF + col) = pack8(o);
    }
}

__global__ void __launch_bounds__(512) fwd_megakernel(Params p) {
    extern __shared__ __attribute__((aligned(16))) unsigned char lds_raw[];
    LAS unsigned char* lds = (LAS unsigned char*)lds_raw;
    cg::grid_group grid = cg::this_grid();
    const int wave_sg = __builtin_amdgcn_readfirstlane((int)threadIdx.x >> 6);
    if (threadIdx.x < 4) ((volatile LAS unsigned*)(lds + 131072))[threadIdx.x] = 0u;
    __syncthreads();
    (void)xcd_barrier_post((unsigned*)(p.ws + WS_BAR), (volatile LAS unsigned*)(lds + 131072));
    if (p.ph_hi < 0) grid.sync();
#if defined(__HIP_DEVICE_COMPILE__)
#define GRID_BARRIER() xcd_barrier((unsigned*)(((const __attribute__((address_space(4))) Params*)__builtin_amdgcn_kernarg_segment_ptr())->ws + WS_BAR), (volatile LAS unsigned*)(lds + 131072), wave_sg == 0 && lane_id_hw() == 0)
#else
#define GRID_BARRIER() xcd_barrier((unsigned*)(p.ws + WS_BAR), (volatile LAS unsigned*)(lds + 131072), wave_sg == 0 && lane_id_hw() == 0)
#endif
    const int lo = p.ph_lo, hi = p.ph_hi;
    int ph = 0;
#ifndef REP_MASK
#define REP_MASK 0
#endif
#if defined(__HIP_DEVICE_COMPILE__)
#define LOAD_ARGS const __attribute__((address_space(4))) Params* kp_ = (const __attribute__((address_space(4))) Params*)__builtin_amdgcn_kernarg_segment_ptr(); asm volatile("" : "+s"(kp_)); Params pp = *kp_;
#else
#define LOAD_ARGS Params pp = p;
#endif
#define PHASE_BEGIN if (ph >= lo && ph < hi) { const int nrep_ = 1 + ((REP_MASK >> ph) & 1); for (int rep_ = 0; rep_ < nrep_; ++rep_) { if (rep_) GRID_BARRIER(); LOAD_ARGS int ll = l; int tid_ = (wave_sg << 6) | lane_id_hw(); asm volatile("" : "+v"(tid_)); asm volatile("" : "+s"(pp.ws), "+s"(ll)); asm volatile("" : "+s"(pp.out));
#define PHASE_END } } ++ph; if (ph > lo && ph < hi) GRID_BARRIER();
    { const int l = 0; PHASE_BEGIN p0_phase(pp, lds, tid_); PHASE_END }
#ifdef REP_SCAN
#define REP_SCAN_N REP_SCAN
#else
#define REP_SCAN_N 0
#endif
#ifdef REP_ATTN
#define REP_ATTN_N 1
#else
#define REP_ATTN_N 0
#endif
#define LAYER_BODY(l)  \
        PHASE_BEGIN norm_phase(pp, lds, (ll == 0) ? pp.x : (const float*)pp.out, pp.norm1 + ll * D_, ll, 0, 2048, ll == 0, tid_); PHASE_END \
        PHASE_BEGIN { GAS unsigned char* wl = pp.ws + WS_W + (size_t)ll * W_LAYER; \
            win_small_cols(pp, lds, ll, tid_); pg8::Gemm g{(const bf16_t*)(pp.ws + WS_H), (const bf16_t*)(wl + W_IN_OFF), T_, 7168, D_}; pg8::StaticOrder S; S.init(T_, 7168, (int)gridDim.x, (int)blockIdx.x); \
            pg8::EpiBf16 E{(bf16_t*)(pp.ws + WS_PROJ), NIN, 0, 0}; pg8::gemm_phase(lds, g, S, E, tid_); } PHASE_END \
        PHASE_BEGIN gdn_prep_phase(pp, lds, ll, tid_); PHASE_END \
        PHASE_BEGIN if ((int)blockIdx.x < 32) { scan_phase<0>(pp, lds, tid_); \
            if (REP_SCAN_N) { __syncthreads(); scan_phase<(REP_SCAN_N > 0 ? REP_SCAN_N - 1 : 0)>(pp, lds, tid_); } \
            } else { sb_attn_phase(pp, lds, ll, 32, (int)gridDim.x - 32, tid_); \
            if (REP_ATTN_N) { __syncthreads(); sb_attn_phase(pp, lds, ll, 32, (int)gridDim.x - 32, tid_); } \
            { __syncthreads(); const int gw_ = ((int)blockIdx.x - 32) * 8 + (tid_ >> 6), ng_ = ((int)gridDim.x - 32) * 8;        \
              weight_transposes(pp, lds, tid_, l, 2 | 4 | 8, gw_, ng_); if (l == 0) weight_transposes(pp, lds, tid_, 1, 1, gw_, ng_); } \
            } PHASE_END \
        PHASE_BEGIN gdn_finalize_phase(pp, ll, tid_); PHASE_END \
        PHASE_BEGIN { GAS unsigned char* wl = pp.ws + WS_W + (size_t)ll * W_LAYER; const float* modf = (const float*)(pp.ws + WS_MODF) + ll * 12288; \
            pg8::Gemm g{(const bf16_t*)(pp.ws + WS_OCAT), (const bf16_t*)(wl + W_OUT_OFF), T_, D_, D_}; pg8::StaticOrder S; S.init(T_, D_, (int)gridDim.x, (int)blockIdx.x); \
            pg8::EpiRes E{(ll == 0) ? pp.x : (const float*)pp.out, (float*)pp.out, D_, modf + 4096}; pg8::gemm_phase(lds, g, S, E, tid_); } PHASE_END \
        PHASE_BEGIN norm_phase(pp, lds, (const float*)pp.out, pp.norm2 + ll * D_, ll, 6144, 8192, false, tid_); PHASE_END \
        PHASE_BEGIN { GAS unsigned char* wl = pp.ws + WS_W + (size_t)ll * W_LAYER; \
            pg8::Gemm g{(const bf16_t*)(pp.ws + WS_H), (const bf16_t*)(wl + W_UP_OFF), T_, NUP, D_}; pg8::StaticOrder S; S.init(T_, NUP, (int)gridDim.x, (int)blockIdx.x); \
            pg8::EpiAct E{(bf16_t*)(pp.ws + WS_V), (bf16_t*)(pp.ws + WS_G), (bf16_t*)(pp.ws + WS_G + 8 * MiB), (bf16_t*)(pp.ws + WS_G + 16 * MiB), pp.conv_ffn + (size_t)ll * 3 * DFF}; pg8::gemm_phase(lds, g, S, E, tid_); } PHASE_END \
        PHASE_BEGIN { GAS unsigned char* wl = pp.ws + WS_W + (size_t)ll * W_LAYER; const float* modf = (const float*)(pp.ws + WS_MODF) + ll * 12288; \
            pg8::Gemm g{(const bf16_t*)(pp.ws + WS_V), (const bf16_t*)(wl + W_DN_OFF), T_, D_, DFF}; pg8::StaticOrder S; S.init(T_, D_, (int)gridDim.x, (int)blockIdx.x); \
            { pg8::Unit uu_; int last_ = -1; for (int i_ = 0; S.next(i_, uu_); ++i_) if (uu_.pm != last_) { act_fix_rows(pp, ll, tid_, uu_.pm); last_ = uu_.pm; } asm volatile("s_waitcnt vmcnt(0)" ::: "memory"); __syncthreads(); } \
            pg8::EpiRes E{(const float*)pp.out, (float*)pp.out, D_, modf + 10240}; pg8::gemm_phase(lds, g, S, E, tid_); } PHASE_END \

    { const int l = 0; LAYER_BODY(l) }
    { const int l = 1; LAYER_BODY(l) }
#undef LAYER_BODY
#undef PHASE_BEGIN
#undef PHASE_END
#ifdef EXTRA_SYNCS
    for (int e = 0; e < EXTRA_SYNCS; ++e) GRID_BARRIER();
#endif
#ifdef DBG_OFF
    GRID_BARRIER();
    { const bf16_t* src = (const bf16_t*)(p.ws + (size_t)DBG_OFF);
      for (size_t i = (size_t)blockIdx.x * 512 + ((wave_sg << 6) | lane_id_hw()); i < (size_t)T_ * D_; i += (size_t)gridDim.x * 512) p.out[i] = bf2f(src[i]); }
#endif
}

extern "C" void kernel_launch(void* const* d_in, const int* in_sizes, int n_in, void* d_out, int out_size, void* d_ws, size_t ws_size, hipStream_t stream) {
    static int grid = 0;
    if (grid == 0) {
        if (n_in != 17 || ws_size < WS_END) { fprintf(stderr, "kernel_launch: expected 17 inputs and >= %zu bytes of workspace; got %d, %zu\n", (size_t)WS_END, n_in, ws_size); grid = -1; return; }
        int dev = 0, cus = 0, per_cu = 0;
        hipGetDevice(&dev); hipDeviceGetAttribute(&cus, hipDeviceAttributeMultiprocessorCount, dev);
        if (hipFuncSetAttribute((const void*)fwd_megakernel, hipFuncAttributeMaxDynamicSharedMemorySize, LDS_BYTES) != hipSuccess) { fprintf(stderr, "kernel_launch: hipFuncSetAttribute failed\n"); grid = -1; return; }
        hipOccupancyMaxActiveBlocksPerMultiprocessor(&per_cu, (const void*)fwd_megakernel, 512, LDS_BYTES);
        if (per_cu < 1) { fprintf(stderr, "kernel_launch: occupancy query says %d blocks/CU\n", per_cu); per_cu = 1; }
        (void)hipGetLastError();
        grid = cus;
        if (grid > 256) grid = 256;
    }
    if (grid < 0) return;
    Params p{};
    p.x = (const float*)d_in[0]; p.c = (const float*)d_in[1]; p.w_ada = (const float*)d_in[2]; p.b_ada = (const float*)d_in[3]; p.norm1 = (const float*)d_in[4];
    p.w_in = (const float*)d_in[5]; p.conv_qkv = (const float*)d_in[6]; p.a_log = (const float*)d_in[7]; p.dt_bias = (const float*)d_in[8]; p.gdn_norm = (const float*)d_in[9];
    p.sbq = (const float*)d_in[10]; p.sbk = (const float*)d_in[11]; p.w_out = (const float*)d_in[12]; p.norm2 = (const float*)d_in[13]; p.w_up = (const float*)d_in[14];
    p.conv_ffn = (const float*)d_in[15]; p.w_down = (const float*)d_in[16];
    p.out = (GAS float*)d_out; p.ws = (GAS unsigned char*)d_ws; p.ph_lo = 0; p.ph_hi = 19;
#ifdef DBG_HI
    p.ph_hi = DBG_HI;
#endif
    if (hipMemsetAsync((char*)d_ws + WS_BAR, 0, XCD_BAR_WORDS * 4, stream) != hipSuccess) { fprintf(stderr, "kernel_launch: hipMemsetAsync failed\n"); return; }
    void* args[] = {&p};
    hipError_t e = hipLaunchCooperativeKernel((const void*)fwd_megakernel, dim3(grid), dim3(512), args, LDS_BYTES, stream);
    if (e != hipSuccess) fprintf(stderr, "cooperative launch failed: %s (grid %d)\n", hipGetErrorString(e), grid);
}
```

```cpp
#define REP_S1 2
#include <hip/hip_runtime.h>
#include <hip/hip_cooperative_groups.h>
#include <cstdio>
#include <cstdint>
namespace cg = cooperative_groups;

#define LAS __attribute__((address_space(3)))
#define GAS __attribute__((address_space(1)))
typedef unsigned short bf16_t;
typedef short bf16x8 __attribute__((ext_vector_type(8)));
typedef short s16x4 __attribute__((ext_vector_type(4)));
typedef float f32x4 __attribute__((ext_vector_type(4)));
typedef float f32x2 __attribute__((ext_vector_type(2)));
typedef unsigned u32x4 __attribute__((ext_vector_type(4)));
typedef unsigned u32x2 __attribute__((ext_vector_type(2)));

constexpr int T_ = 16384, D_ = 2048, DIN = 7184, NIN = 7424, DFF = 5632, NUP = 11264, NH = 8;
constexpr int PQ_A = 0, PK_A = 1024, PV_A = 2048, PZ_A = 3072, PQ_B = 4096, PK_B = 5120, PV_B = 6144, PBETA = 7168, PALPHA = 7176;
constexpr int KS_MOD = 16;
constexpr float EPS_ = 1e-6f;
constexpr size_t MiB = 1024ull * 1024ull;
constexpr size_t WS_MODF = 0;
constexpr size_t WS_MODP = 131072;
constexpr size_t WS_EGL = 1835008;
constexpr size_t WS_PROG = 1900544;
constexpr size_t WS_BAR = 1904640;
constexpr size_t WS_W = 2 * MiB;
constexpr size_t W_IN_OFF = 0, W_OUT_OFF = 29 * MiB, W_UP_OFF = 37 * MiB, W_DN_OFF = 81 * MiB, W_LAYER = 103 * MiB;
constexpr size_t WS_H = 208 * MiB;
constexpr size_t WS_PROJ = 272 * MiB;
constexpr size_t WS_G = 272 * MiB, WS_V = 448 * MiB;
constexpr size_t WS_OCAT = 504 * MiB;
constexpr size_t WS_GDN = 568 * MiB;
constexpr size_t WS_END = 712 * MiB;
constexpr int LDS_BYTES = 131072 + 256;

struct Params {
    const float *x, *c, *w_ada, *b_ada, *norm1, *w_in, *conv_qkv, *a_log, *dt_bias, *gdn_norm, *sbq, *sbk, *w_out, *norm2, *w_up, *conv_ffn, *w_down;
    GAS float* out; GAS unsigned char* ws; int ph_lo, ph_hi;
};

typedef __bf16 bf16v2 __attribute__((ext_vector_type(2)));
__device__ __forceinline__ unsigned pk2(float lo, float hi) { const f32x2 v = {lo, hi}; union { bf16v2 b; unsigned u; } x; x.b = __builtin_convertvector(v, bf16v2); return x.u; }
__device__ __forceinline__ float bf2f(bf16_t b) { return __uint_as_float(((unsigned)b) << 16); }
__device__ __forceinline__ float bflo(unsigned w) { return __uint_as_float(w << 16); }
__device__ __forceinline__ float bfhi(unsigned w) { return __uint_as_float(w & 0xffff0000u); }
__device__ __forceinline__ void unpack8(const u32x4 v, float* f) { f[0] = bflo(v.x); f[1] = bfhi(v.x); f[2] = bflo(v.y); f[3] = bfhi(v.y); f[4] = bflo(v.z); f[5] = bfhi(v.z); f[6] = bflo(v.w); f[7] = bfhi(v.w); }
__device__ __forceinline__ u32x4 pack8(const float* f) { u32x4 o; o.x = pk2(f[0], f[1]); o.y = pk2(f[2], f[3]); o.z = pk2(f[4], f[5]); o.w = pk2(f[6], f[7]); return o; }
__device__ __forceinline__ float silu_f(float y) { return y * __builtin_amdgcn_rcpf(1.0f + __expf(-y)); }
__device__ __forceinline__ float softplus_f(float z) { return fmaxf(z, 0.f) + log1pf(__expf(-fabsf(z))); }
__device__ __forceinline__ float softplus_fast(float z) { return fmaxf(z, 0.f) + __logf(1.0f + __expf(-fabsf(z))); }
__device__ __forceinline__ float wave_sum(float v) {
#pragma unroll
    for (int o = 1; o < 64; o <<= 1) v += __shfl_xor(v, o);
    return v;
}
__device__ __forceinline__ bf16x8 as_bf8(u32x4 v) { union { u32x4 u; bf16x8 b; } x; x.u = v; return x.b; }
#define MFMA16(a, b, c) __builtin_amdgcn_mfma_f32_16x16x32_bf16((a), (b), (c), 0, 0, 0)
#define LDS_WAIT() asm volatile("s_waitcnt lgkmcnt(0)" ::: "memory")
__device__ __forceinline__ int lane_id_hw() { return (int)__builtin_amdgcn_mbcnt_hi(~0u, __builtin_amdgcn_mbcnt_lo(~0u, 0u)); }
__device__ __forceinline__ int opaque_bid() { int b = (int)blockIdx.x; asm volatile("" : "+s"(b)); return b; }


#define XB_TMO      128
#define XB_XCNT(j)  (256  + 64 * (j))
#define XB_XSUB(j)  (1280 + 64 * (j))
#define XB_XGEN(j)  (2304 + 64 * (j))
#define XB_TOP      3328
#define XB_TOPGEN   3392
#define XCD_BAR_WORDS 3456
#define XB_SPIN_CAP (1u << 18)
__device__ __forceinline__ unsigned xb_ld(unsigned* p)              { return __hip_atomic_load(p, __ATOMIC_RELAXED, __HIP_MEMORY_SCOPE_AGENT); }
__device__ __forceinline__ unsigned xb_add(unsigned* p, unsigned v) { return __hip_atomic_fetch_add(p, v, __ATOMIC_RELAXED, __HIP_MEMORY_SCOPE_AGENT); }
__device__ __forceinline__ unsigned xb_xcc_id() { return (unsigned)__builtin_amdgcn_s_getreg((3 << 11) | 20) & 0xFu; }
#define XB_SPIN(cond, bar) do { unsigned _sp = 0; while (cond) { __builtin_amdgcn_s_sleep(1); \
    if ((++_sp & 255u) == 0u) { if (xb_ld(&(bar)[XB_TMO])) break; if (_sp > XB_SPIN_CAP) { atomicAdd(&(bar)[XB_TMO], 1u); break; } } } } while (0)
struct XcdBarrier { unsigned* bar; unsigned x; volatile LAS unsigned* st; };
__device__ __forceinline__ XcdBarrier xcd_barrier_post(unsigned* bar, volatile LAS unsigned* st) {
    XcdBarrier b; b.bar = bar; b.x = xb_xcc_id(); b.st = st;
    if (threadIdx.x == 0) (void)xb_add(&bar[XB_XCNT(b.x)], 1u);
    return b;
}
__device__ __forceinline__ void xcd_barrier_complete(unsigned* bar, unsigned x, unsigned& nloc, unsigned& nx) {
    const unsigned G = gridDim.x * gridDim.y * gridDim.z;
    unsigned sum, cnt, mine, sp = 0u;
    for (;;) {
        sum = 0u; cnt = 0u; mine = 0u;
#pragma unroll
        for (unsigned j = 0; j < 16; ++j) { const unsigned c = xb_ld(&bar[XB_XCNT(j)]); sum += c; cnt += (c > 0u) ? 1u : 0u; mine = (j == x) ? c : mine; }
        if (sum == G) break;
        __builtin_amdgcn_s_sleep(1);
        if ((++sp & 255u) == 0u) { if (xb_ld(&bar[XB_TMO])) break; if (sp > XB_SPIN_CAP) { atomicAdd(&bar[XB_TMO], 1u); break; } }
    }
    nloc = mine > 0u ? mine : 1u; nx = cnt > 0u ? cnt : 1u;
}
__device__ __forceinline__ void xcd_barrier(unsigned* bar, volatile LAS unsigned* st, const bool is_t0) {
    asm volatile("s_waitcnt vmcnt(0)" ::: "memory");
    __syncthreads();
    if (is_t0) {
        const unsigned x = xb_xcc_id();
        __builtin_amdgcn_s_waitcnt(0);
        unsigned nloc = st[0], nx = st[1];
        if (nloc == 0u) { xcd_barrier_complete(bar, x, nloc, nx); st[0] = nloc; st[1] = nx; }
        const unsigned old = xb_add(&bar[XB_XSUB(x)], 1u);
        const unsigned gen = old / nloc;
        if (old + 1u == (gen + 1u) * nloc) {
            __builtin_amdgcn_fence(__ATOMIC_RELEASE, "agent");
            asm volatile("s_waitcnt vmcnt(0)" ::: "memory");
            const unsigned og = xb_add(&bar[XB_TOP], 1u);
            const unsigned tg = og / nx;
            if (og + 1u == (tg + 1u) * nx) xb_add(&bar[XB_TOPGEN], 1u);
            else XB_SPIN(xb_ld(&bar[XB_TOPGEN]) == tg, bar);
            __builtin_amdgcn_fence(__ATOMIC_ACQUIRE, "agent");
            xb_add(&bar[XB_XGEN(x)], 1u);
            asm volatile("s_waitcnt vmcnt(0)" ::: "memory");
        } else {
            XB_SPIN(xb_ld(&bar[XB_XGEN(x)]) == gen, bar);
            __builtin_amdgcn_fence(__ATOMIC_ACQUIRE, "agent");
            asm volatile("s_waitcnt vmcnt(0)" ::: "memory");
        }
    }
    __syncthreads();
}

namespace pg8 {
constexpr int BM = 256, BK = 64, HALF = 128, HTB = HALF * BK * 2, STAGE_BYTES = 8 * HTB, NXCD = 8, WGM = 8;
__host__ __device__ __forceinline__ int lds_byte(int r, int c) { const int st = (r >> 4) * 2 + (c >> 5), rr = r & 15, cc = c & 31, ob = rr * 64 + cc * 2; return st * 1024 + (ob ^ (((ob >> 9) & 1) << 5)); }
__host__ __device__ __forceinline__ void stage_rc(int b, int& R, int& C) { const int st = b / 1024, sb = b % 1024, swz = sb ^ (((sb >> 9) & 1) << 5); R = (st >> 1) * 16 + swz / 64; C = (st & 1) * 32 + (swz % 64) / 2; }
__host__ __device__ __forceinline__ int perm32(int rho) { const int n = rho >> 4, i = rho & 15; return 8 * (i >> 2) + 4 * n + (i & 3); }
struct Unit { int pm, pn; };
struct Gemm { const bf16_t* A; const bf16_t* Bt; int M, N, K; };
struct StaticOrder {
    int nM, nN, nwg, G, c;
    __device__ __forceinline__ void init(int M, int N, int G_, int c_) { nM = M / BM; nN = N / BM; nwg = nM * nN; G = G_; c = c_; }
    __device__ __forceinline__ bool next(int i, Unit& u) const {
        const long L = (long)i * G + c; if (L >= nwg) return false;
        int wgid = (int)L; { const int q = nwg / NXCD, r = nwg % NXCD, xcd = wgid % NXCD, off = wgid / NXCD; wgid = (xcd < r ? xcd * (q + 1) : r * (q + 1) + (xcd - r) * q) + off; }
        const int nig = WGM * nN, gid = wgid / nig, fm = gid * WGM, gsz = (nM - fm) < WGM ? (nM - fm) : WGM;
        u.pm = fm + ((wgid % nig) % gsz); u.pn = (wgid % nig) / gsz; return true;
    }
};
struct EpiBf16 {
    static constexpr bool PERM = true;
    bf16_t* O; int ldc; int split_cols; size_t split_stride;
    __device__ __forceinline__ void operator()(const f32x4 (&acc)[2][2][4][2], const Unit& u, int wr, int wc, int fr, int fq) const {
        const int row0 = u.pm * BM + wr * 64 + fr; int colt = u.pn * BM; bf16_t* base = O;
        if (split_cols) { const int t = colt / split_cols; base += (size_t)t * split_stride; colt -= t * split_cols; }
        const int col0 = colt + wc * 32 + 8 * fq;
#pragma unroll
        for (int ai = 0; ai < 2; ++ai)
#pragma unroll
            for (int m = 0; m < 4; ++m) { bf16_t* rowp = base + (size_t)(row0 + ai * HALF + m * 16) * ldc + col0;
#pragma unroll
                for (int bj = 0; bj < 2; ++bj) { const f32x4 v0 = acc[ai][bj][m][0], v1 = acc[ai][bj][m][1];
                    u32x4 w; w.x = pk2(v0[0], v0[1]); w.y = pk2(v0[2], v0[3]); w.z = pk2(v1[0], v1[1]); w.w = pk2(v1[2], v1[3]);
                    *(u32x4*)(rowp + bj * HALF) = w; } }
    }
};
struct EpiRes {
    static constexpr bool PERM = false;
    const float* xin; float* out; int ldc; const float* gate;
    __device__ __forceinline__ void operator()(const f32x4 (&acc)[2][2][4][2], const Unit& u, int wr, int wc, int fr, int fq) const {
        const int row0 = u.pm * BM + wr * 64 + fr, col0 = u.pn * BM + wc * 32 + 4 * fq;
        f32x4 gv[2][2];
#pragma unroll
        for (int bj = 0; bj < 2; ++bj)
#pragma unroll
            for (int n = 0; n < 2; ++n) gv[bj][n] = *(const f32x4*)(gate + col0 + bj * HALF + n * 16);
#pragma unroll
        for (int ai = 0; ai < 2; ++ai) {
            f32x4 xv[4][2][2];
#pragma unroll
            for (int m = 0; m < 4; ++m) { const size_t off = (size_t)(row0 + ai * HALF + m * 16) * ldc + col0;
#pragma unroll
                for (int bj = 0; bj < 2; ++bj)
#pragma unroll
                    for (int n = 0; n < 2; ++n) xv[m][bj][n] = *(const f32x4*)(xin + off + bj * HALF + n * 16); }
#pragma unroll
            for (int m = 0; m < 4; ++m) { const size_t off = (size_t)(row0 + ai * HALF + m * 16) * ldc + col0;
#pragma unroll
                for (int bj = 0; bj < 2; ++bj)
#pragma unroll
                    for (int n = 0; n < 2; ++n) *(f32x4*)(out + off + bj * HALF + n * 16) = xv[m][bj][n] + gv[bj][n] * acc[ai][bj][m][n]; }
            asm volatile("" ::: "memory"); }
    }
};
struct EpiAct {
    static constexpr bool PERM = true;
    bf16_t* V; bf16_t* Gh; bf16_t* Gt; bf16_t* Vh; const float* cw;
    __device__ __forceinline__ void operator()(const f32x4 (&acc)[2][2][4][2], const Unit& u, int wr, int wc, int fr, int fq) const {
        const int lane = fr + 16 * fq, ff0 = u.pn * HALF + wc * 32 + 8 * fq;
        float w0[8], w1[8], w2[8];
#pragma unroll
        for (int e = 0; e < 8; ++e) { w0[e] = cw[ff0 + e]; w1[e] = cw[DFF + ff0 + e]; w2[e] = cw[2 * DFF + ff0 + e]; }
        const int src1 = (fr >= 1) ? lane - 1 : lane + 15, src2 = (fr >= 2) ? lane - 2 : lane + 14;
#pragma unroll
        for (int ai = 0; ai < 2; ++ai) { const int strip = 4 * u.pm + 2 * ai + wr; const size_t row_base = (size_t)u.pm * BM + ai * HALF + wr * 64;
#pragma unroll
            for (int m = 0; m < 4; ++m) { float o[8], gr[8];
#pragma unroll
                for (int n = 0; n < 2; ++n)
#pragma unroll
                    for (int j = 0; j < 4; ++j) { const int e = 4 * n + j; const float g0 = acc[ai][0][m][n][j], v = acc[ai][1][m][n][j], gp = (m > 0) ? acc[ai][0][m > 0 ? m - 1 : 0][n][j] : 0.f;
                        const float s1_ = (fr == 15) ? gp : g0, s2_ = (fr >= 14) ? gp : g0;
                        const float g1 = __int_as_float(__builtin_amdgcn_update_dpp(0, __float_as_int(s1_), 0x121, 0xf, 0xf, false)), g2 = __int_as_float(__builtin_amdgcn_update_dpp(0, __float_as_int(s2_), 0x122, 0xf, 0xf, false));
                        const float y = w0[e] * g2 + w1[e] * g1 + w2[e] * g0; const float a = y * __builtin_amdgcn_rcpf(1.0f + __expf(-y)) * v;
                        o[e] = (m == 0 && fr < 2) ? v : a; gr[e] = g0; }
                { u32x4 w; w.x = pk2(o[0], o[1]); w.y = pk2(o[2], o[3]); w.z = pk2(o[4], o[5]); w.w = pk2(o[6], o[7]);
                  *(u32x4*)(V + (row_base + 16 * m + fr) * DFF + ff0) = w;
                  if (m == 0 && fr < 2) *(u32x4*)(Vh + (size_t)(strip * 2 + fr) * DFF + ff0) = w; }
                if (m == 0 && fr < 2) { u32x4 w; w.x = pk2(gr[0], gr[1]); w.y = pk2(gr[2], gr[3]); w.z = pk2(gr[4], gr[5]); w.w = pk2(gr[6], gr[7]); *(u32x4*)(Gh + (size_t)(strip * 2 + fr) * DFF + ff0) = w; }
                if (m == 3 && fr >= 14) { u32x4 w; w.x = pk2(gr[0], gr[1]); w.y = pk2(gr[2], gr[3]); w.z = pk2(gr[4], gr[5]); w.w = pk2(gr[6], gr[7]); *(u32x4*)(Gt + (size_t)(strip * 2 + fr - 14) * DFF + ff0) = w; } } }
    }
};

template <class Epi>
__device__ __forceinline__ void gemm_phase(LAS unsigned char* lds, const Gemm g, const StaticOrder& S, const Epi& E, const int tid_in) {
    const int tid = tid_in, wid = __builtin_amdgcn_readfirstlane(tid >> 6), lane = tid & 63, wr = wid >> 2, wc = wid & 3, fr = lane & 15, fq = lane >> 4;
    const int K = g.K, nt = K / BK;
    unsigned voffA[2], voffB[2];
#pragma unroll
    for (int i = 0; i < 2; ++i) { int R, C; stage_rc(tid * 16 + i * 8192, R, C); const int Rb = Epi::PERM ? ((R & ~31) + perm32(R & 31)) : R;
        voffA[i] = (unsigned)(R * K + C) * 2u; voffB[i] = (unsigned)(Rb * K + C) * 2u; }
    const size_t kstep = (size_t)(BK * 2);
    const size_t hstep = (size_t)HALF * K * 2;
    const size_t tstep = 2 * hstep;
    const unsigned ldsw = (unsigned)wid * 1024u;
    const int aoff = lds_byte(wr * 64 + fr, fq * 8), boff = lds_byte(wc * 32 + fr, fq * 8);
#define PG8_SA(b, h) (((b) * 2 + (h)) * HTB)
#define PG8_SB(b, h) ((4 + (b) * 2 + (h)) * HTB)
#define PG8_STAGE(bufoff, gbase, voff) do { _Pragma("unroll") for (int _i = 0; _i < 2; ++_i) \
        __builtin_amdgcn_global_load_lds((const unsigned*)((const char*)(gbase) + (voff)[_i]), (LAS unsigned*)(lds + (bufoff) + ldsw + _i * 8192), 16, 0, 0); } while (0)
#define PG8_LDA(dst, b, h) do { _Pragma("unroll") for (int m = 0; m < 4; ++m) _Pragma("unroll") for (int k = 0; k < 2; ++k) dst[m][k] = *(const LAS bf16x8*)(lds + PG8_SA(b, h) + aoff + m * 2048 + k * 1024); } while (0)
#define PG8_LDB(dst, b, h) do { _Pragma("unroll") for (int n = 0; n < 2; ++n) _Pragma("unroll") for (int k = 0; k < 2; ++k) dst[n][k] = *(const LAS bf16x8*)(lds + PG8_SB(b, h) + boff + n * 2048 + k * 1024); } while (0)
#define PG8_MMA(ai, bj, At, Bt) do { __builtin_amdgcn_s_setprio(1); _Pragma("unroll") for (int m = 0; m < 4; ++m) _Pragma("unroll") for (int n = 0; n < 2; ++n) _Pragma("unroll") for (int k = 0; k < 2; ++k) \
        acc[ai][bj][m][n] = __builtin_amdgcn_mfma_f32_16x16x32_bf16(Bt[n][k], At[m][k], acc[ai][bj][m][n], 0, 0, 0); __builtin_amdgcn_s_setprio(0); } while (0)
#define PG8_WAIT_V(n) asm volatile("s_waitcnt vmcnt(" #n ")" ::: "memory")
#define PG8_WAIT_L(n) asm volatile("s_waitcnt lgkmcnt(" #n ")" ::: "memory")
#define PG8_BAR __builtin_amdgcn_s_barrier()
#define PG8_SCHED __builtin_amdgcn_sched_barrier(0)
    Unit cur, nxt; int ui = 0;
    if (!S.next(0, cur)) return;
    f32x4 acc[2][2][4][2];
#pragma unroll
    for (int a = 0; a < 2; ++a)
#pragma unroll
        for (int b = 0; b < 2; ++b)
#pragma unroll
            for (int m = 0; m < 4; ++m)
#pragma unroll
                for (int n = 0; n < 2; ++n) acc[a][b][m][n] = (f32x4){0.f, 0.f, 0.f, 0.f};
    bf16x8 At[4][2], B0[2][2], B1[2][2];
    const char* cA = (const char*)g.A + (size_t)cur.pm * tstep; const char* cB = (const char*)g.Bt + (size_t)cur.pn * tstep;
    PG8_STAGE(PG8_SB(0, 0), cB, voffB); PG8_STAGE(PG8_SB(0, 1), cB + hstep, voffB); PG8_STAGE(PG8_SA(0, 0), cA, voffA); PG8_STAGE(PG8_SA(0, 1), cA + hstep, voffA);
    if (wr == 1) PG8_BAR;
    PG8_WAIT_V(2); PG8_BAR;
    PG8_STAGE(PG8_SB(1, 0), cB + kstep, voffB); PG8_STAGE(PG8_SA(1, 0), cA + kstep, voffA); PG8_STAGE(PG8_SB(1, 1), cB + hstep + kstep, voffB);
    PG8_WAIT_V(6); PG8_BAR;
    for (;;) {
        const bool has_next = S.next(ui + 1, nxt);
        const char* nA = has_next ? (const char*)g.A + (size_t)nxt.pm * tstep : cA; const char* nB = has_next ? (const char*)g.Bt + (size_t)nxt.pn * tstep : cB;
        for (int t = 0; t < nt; t += 2) {
            const bool last = (t == nt - 2);
            const char* a1 = cA + (size_t)(t + 1) * kstep;
            const char* a2 = last ? nA : cA + (size_t)(t + 2) * kstep; const char* b2 = last ? nB : cB + (size_t)(t + 2) * kstep;
            const char* a3 = a2 + kstep; const char* b3 = b2 + kstep;
            PG8_LDB(B0, 0, 0); PG8_LDB(B1, 0, 1); PG8_SCHED; PG8_LDA(At, 0, 0); PG8_STAGE(PG8_SA(1, 1), a1 + hstep, voffA);
            PG8_WAIT_V(8); PG8_WAIT_L(0); PG8_BAR; PG8_MMA(0, 0, At, B0); PG8_MMA(0, 1, At, B1); PG8_BAR; PG8_SCHED;
            PG8_LDA(At, 0, 1); PG8_STAGE(PG8_SB(0, 0), b2, voffB); PG8_STAGE(PG8_SB(0, 1), b2 + hstep, voffB); PG8_STAGE(PG8_SA(0, 0), a2, voffA);
            PG8_WAIT_V(8); PG8_WAIT_L(0); PG8_BAR; PG8_MMA(1, 0, At, B0); PG8_MMA(1, 1, At, B1); PG8_BAR; PG8_SCHED;
            PG8_LDB(B0, 1, 0); PG8_LDB(B1, 1, 1); PG8_SCHED; PG8_LDA(At, 1, 0); PG8_STAGE(PG8_SA(0, 1), a2 + hstep, voffA);
            PG8_WAIT_V(8); PG8_WAIT_L(0); PG8_BAR; PG8_MMA(0, 0, At, B0); PG8_MMA(0, 1, At, B1); PG8_BAR; PG8_SCHED;
            PG8_LDA(At, 1, 1); PG8_STAGE(PG8_SB(1, 0), b3, voffB); PG8_STAGE(PG8_SB(1, 1), b3 + hstep, voffB); PG8_STAGE(PG8_SA(1, 0), a3, voffA);
            PG8_WAIT_V(8); PG8_WAIT_L(0); PG8_BAR; PG8_MMA(1, 0, At, B0); PG8_MMA(1, 1, At, B1); PG8_BAR; PG8_SCHED;
        }
        if (wr == 0) PG8_BAR;
        E(acc, cur, wr, wc, fr, fq);
        if (!has_next) break;
#pragma unroll
        for (int a = 0; a < 2; ++a)
#pragma unroll
            for (int b = 0; b < 2; ++b)
#pragma unroll
                for (int m = 0; m < 4; ++m)
#pragma unroll
                    for (int n = 0; n < 2; ++n) acc[a][b][m][n] = (f32x4){0.f, 0.f, 0.f, 0.f};
        cur = nxt; cA = nA; cB = nB; ++ui;
        if (wr == 1) PG8_BAR;
    }
    PG8_WAIT_V(0);
    PG8_BAR;
#undef PG8_SA
#undef PG8_SB
#undef PG8_STAGE
#undef PG8_LDA
#undef PG8_LDB
#undef PG8_MMA
#undef PG8_WAIT_V
#undef PG8_WAIT_L
#undef PG8_BAR
#undef PG8_SCHED
}
}

__device__ __forceinline__ void transpose_item(const float* W, int K, int Nsrc, bf16_t* WT, int k0, int ndst0, int nsrc0, int nvalid, LAS float* scr, int lane) {
    float vv[32];
#pragma unroll
    for (int i = 0; i < 32; ++i) { const int kk = 2 * i + (lane >> 5), nn = lane & 31;
        vv[i] = (nn < nvalid) ? W[(size_t)(k0 + kk) * Nsrc + nsrc0 + nn] : 0.f; }
#pragma unroll
    for (int i = 0; i < 32; ++i) { const int kk = 2 * i + (lane >> 5), nn = lane & 31; scr[kk * 33 + nn] = vv[i]; }
    LDS_WAIT();
    const int c = lane & 7;
#pragma unroll
    for (int j = 0; j < 4; ++j) { const int n = (lane >> 3) + 8 * j; const LAS float* s = scr + (8 * c) * 33 + n;
        u32x4 o; o.x = pk2(s[0 * 33], s[1 * 33]); o.y = pk2(s[2 * 33], s[3 * 33]); o.z = pk2(s[4 * 33], s[5 * 33]); o.w = pk2(s[6 * 33], s[7 * 33]);
        *(u32x4*)(WT + (size_t)(ndst0 + n) * K + k0 + 8 * c) = o; }
    LDS_WAIT();
}
__device__ __forceinline__ void weight_transposes(const Params& p, LAS unsigned char* lds, const int tid_in, const int l, const int mask, const int gwv, const int NGW);
__device__ __forceinline__ void p0_phase(const Params& p, LAS unsigned char* lds, const int tid_in) {
    const int tid = tid_in, lane = tid & 63, wave = tid >> 6;
    LAS float* sc = (LAS float*)(lds + 8 * 8448);
    for (int k = tid; k < D_; k += 512) sc[k] = silu_f(p.c[k]);
    __syncthreads();
    { const int gw = wave * 256 + (int)blockIdx.x;
      if (gw < 1536) { const int g = gw * 64 + lane; const int l = g / 49152, rem = g % 49152, ks = rem / 3072, c4 = rem % 3072;
          const float* wp = p.w_ada + ((size_t)l * D_ + (size_t)ks * 128) * 12288 + 4 * c4;
          f32x4 a0 = {0.f, 0.f, 0.f, 0.f}, a1 = a0;
#pragma unroll 4
          for (int k = 0; k < 128; k += 2) { const f32x4 w0 = *(const f32x4*)(wp + (size_t)k * 12288), w1 = *(const f32x4*)(wp + (size_t)(k + 1) * 12288);
              a0 += w0 * sc[ks * 128 + k]; a1 += w1 * sc[ks * 128 + k + 1]; }
          *(f32x4*)((float*)(p.ws + WS_MODP) + ((size_t)(ks * 2 + l) * 12288 + 4 * c4)) = a0 + a1; } }
    weight_transposes(p, lds, tid_in, 0, 1, (int)blockIdx.x * 8 + wave, (int)gridDim.x * 8);
}
__device__ __forceinline__ void weight_transposes(const Params& p, LAS unsigned char* lds, const int tid_in, const int l, const int mask, const int gwv, const int NGW) {
    const int lane = tid_in & 63, wave = tid_in >> 6;
    LAS float* scr = (LAS float*)(lds + wave * 8448);
    constexpr int I_IN = 32 * 232, I_OUT = 32 * 64, I_UP = 32 * 352, I_DN = 88 * 64;
    const int n_in = (mask & 1) ? I_IN : 0, n_out = (mask & 2) ? I_OUT : 0, n_up = (mask & 4) ? I_UP : 0, n_dn = (mask & 8) ? I_DN : 0;
    GAS unsigned char* wl = p.ws + WS_W + (size_t)l * W_LAYER;
    for (int it = gwv; it < n_in + n_out + n_up + n_dn; it += NGW) {
        int r = it;
        if (r < n_in) { const int kb = r / 232, nb = r % 232, nd = 32 * nb; int ns, nv;
            if (nd < 4096) { ns = nd; nv = 32; } else if (nd < 7168) { ns = nd + 16; nv = 32; } else if (nd == 7168) { ns = 4096; nv = 16; } else { ns = 0; nv = 0; }
            transpose_item(p.w_in + (size_t)l * D_ * DIN, D_, DIN, (bf16_t*)(wl + W_IN_OFF), 64 * kb, nd, ns, nv, scr, lane); continue; }
        r -= n_in;
        if (r < n_out) { const int kb = r / 64, nb = r % 64; transpose_item(p.w_out + (size_t)l * D_ * D_, D_, D_, (bf16_t*)(wl + W_OUT_OFF), 64 * kb, 32 * nb, 32 * nb, 32, scr, lane); continue; }
        r -= n_out;
        if (r < n_up) { const int kb = r / 352, nb = r % 352, nd = 32 * nb, pn = nd >> 8, x0 = nd & 255;
            transpose_item(p.w_up + (size_t)l * D_ * NUP, D_, NUP, (bf16_t*)(wl + W_UP_OFF), 64 * kb, nd, (x0 < 128) ? 128 * pn + x0 : DFF + 128 * pn + (x0 - 128), 32, scr, lane); continue; }
        r -= n_up;
        { const int kb = r / 64, nb = r % 64; transpose_item(p.w_down + (size_t)l * DFF * D_, DFF, D_, (bf16_t*)(wl + W_DN_OFF), 64 * kb, 32 * nb, 32 * nb, 32, scr, lane); }
    }
}

__device__ __forceinline__ float mod_from_partials(const Params& p, int l, int j) {
    const float* mp = (const float*)(p.ws + WS_MODP);
    float v = p.b_ada[l * 12288 + j];
#pragma unroll
    for (int ks = 0; ks < KS_MOD; ++ks) v += mp[(size_t)(ks * 2 + l) * 12288 + j];
    return v;
}
__device__ __forceinline__ void norm_phase(const Params& p, LAS unsigned char* lds, const float* xin, const float* normw, int l, int off_shift, int off_scale, bool from_partials, const int tid_in) {
    const int tid = tid_in, lane = tid & 63, wave = tid >> 6;
    LAS float* cA = (LAS float*)lds; LAS float* cB = cA + D_;
    float* modf = (float*)(p.ws + WS_MODF);
    if (from_partials) {
        for (int idx = (int)blockIdx.x * 512 + tid; idx < 2 * 12288; idx += (int)gridDim.x * 512) modf[idx] = mod_from_partials(p, idx / 12288, idx % 12288);
        for (int j = tid; j < D_; j += 512) { const float sh = mod_from_partials(p, l, off_shift + j), scv = mod_from_partials(p, l, off_scale + j);
            cA[j] = normw[j] * (1.f + scv); cB[j] = sh; }
    } else {
        for (int j = tid; j < D_; j += 512) { cA[j] = normw[j] * (1.f + modf[l * 12288 + off_scale + j]); cB[j] = modf[l * 12288 + off_shift + j]; }
    }
    __syncthreads();
    f32x4 a[8], b[8];
#pragma unroll
    for (int j = 0; j < 8; ++j) { a[j] = *(const LAS f32x4*)(cA + 4 * lane + 256 * j); b[j] = *(const LAS f32x4*)(cB + 4 * lane + 256 * j); }
    bf16_t* H = (bf16_t*)(p.ws + WS_H);
    for (int m = (int)blockIdx.x * 8 + wave; m < T_; m += (int)gridDim.x * 8) {
        const f32x4* xr = (const f32x4*)(xin + (size_t)m * D_) + lane;
        f32x4 v[8]; float s = 0.f;
#pragma unroll
        for (int j = 0; j < 8; ++j) { v[j] = xr[64 * j]; s += (v[j].x * v[j].x + v[j].y * v[j].y) + (v[j].z * v[j].z + v[j].w * v[j].w); }
        const float rstd = rsqrtf(wave_sum(s) * (1.f / D_) + EPS_);
        u32x2* o8 = (u32x2*)(H + (size_t)m * D_) + lane;
#pragma unroll
        for (int j = 0; j < 8; ++j) { const f32x4 y = v[j] * rstd * a[j] + b[j]; u32x2 w; w.x = pk2(y.x, y.y); w.y = pk2(y.z, y.w); o8[64 * j] = w; }
    }
}


__device__ __forceinline__ void win_small_cols(const Params& p, LAS unsigned char* lds, int l, const int tid_in) {
    const int lane = tid_in & 63, wave = tid_in >> 6, r16 = lane & 15, q4 = lane >> 4;
    const int tw = wave & 3, kh = wave >> 2;
    const int m0 = ((int)blockIdx.x * 4 + tw) * 16;
    const bf16_t* H = (const bf16_t*)(p.ws + WS_H) + (size_t)(m0 + r16) * D_ + 8 * q4 + 1024 * kh;
    const bf16_t* Wt = (const bf16_t*)(p.ws + WS_W + (size_t)l * W_LAYER + W_IN_OFF) + (size_t)(7168 + r16) * D_ + 8 * q4 + 1024 * kh;
    f32x4 acc0 = {0.f, 0.f, 0.f, 0.f}, acc1 = acc0;
#pragma unroll 8
    for (int s = 0; s < 32; s += 2) {
        const bf16x8 a0 = *(const bf16x8*)(H + 32 * s), b0 = *(const bf16x8*)(Wt + 32 * s), a1 = *(const bf16x8*)(H + 32 * s + 32), b1 = *(const bf16x8*)(Wt + 32 * s + 32);
        acc0 = MFMA16(a0, b0, acc0); acc1 = MFMA16(a1, b1, acc1); }
    acc0 += acc1;
    LAS f32x4* xch = (LAS f32x4*)lds;
    if (kh) xch[tw * 64 + lane] = acc0;
    __syncthreads();
    if (!kh) { acc0 += xch[tw * 64 + lane];
        bf16_t* proj = (bf16_t*)(p.ws + WS_PROJ);
#pragma unroll
        for (int rg = 0; rg < 4; ++rg) proj[(size_t)(m0 + 4 * q4 + rg) * NIN + 7168 + r16] = (bf16_t)(pk2(acc0[rg], 0.f) & 0xffffu); }
    __syncthreads();
}

__device__ __forceinline__ void gdn_prep_phase(const Params& p, LAS unsigned char* lds, int l, const int tid_in) {
    const int tid0 = tid_in, wave = __builtin_amdgcn_readfirstlane(tid0 >> 6);
    LAS float* Lslot = (LAS float*)lds;
    LAS bf16_t* Qn = (LAS bf16_t*)(lds + 65536); LAS bf16_t* Kn = (LAS bf16_t*)(lds + 82944); LAS bf16_t* KdTs = (LAS bf16_t*)(lds + 100352);
    LAS float* betaS = (LAS float*)(lds + 118784); LAS float* gcS = (LAS float*)(lds + 119808); LAS float* gS = (LAS float*)(lds + 120832);
    LAS bf16_t* VbT = (LAS bf16_t*)(lds + 65536); LAS bf16_t* KbgT = (LAS bf16_t*)(lds + 82944);
    const bf16_t* proj = (const bf16_t*)(p.ws + WS_PROJ);
    bf16_t* Wg = (bf16_t*)(p.ws + WS_GDN); bf16_t* UTg = (bf16_t*)(p.ws + WS_GDN + 32 * MiB); bf16_t* KdTg = (bf16_t*)(p.ws + WS_GDN + 64 * MiB);
    bf16_t* Qgg = (bf16_t*)(p.ws + WS_GDN + 96 * MiB); bf16_t* Ag = (bf16_t*)(p.ws + WS_GDN + 128 * MiB);
    float* egl = (float*)(p.ws + WS_EGL);
    LAS float* cwS = (LAS float*)(lds + 122880);
    { const int h0 = ((int)blockIdx.x * 8) >> 8; const float* convw = p.conv_qkv + (size_t)l * 4 * 3072;
      for (int u = tid0; u < 4 * 3 * 128; u += 512) { const int r = u / 384, xx = (u % 384) >> 7, d = u & 127; cwS[u] = convw[r * 3072 + xx * 1024 + h0 * 128 + d]; }
      __syncthreads(); }
#pragma unroll 1
    for (int batch = 0; batch < 2; ++batch) {
        { int tid = tid0; asm volatile("" : "+v"(tid));
          const int kk = tid >> 6, row = tid & 63;
          if (tid < 256) { const int I = (int)blockIdx.x * 8 + batch * 4 + kk, h = I >> 8, c = I & 255; const size_t t = (size_t)64 * c + row;
              const float braw = bf2f(proj[t * NIN + PBETA + h]), araw = bf2f(proj[t * NIN + PALPHA + h]);
              betaS[kk * 64 + row] = 1.f / (1.f + __expf(-braw));
              float g = -__expf(p.a_log[l * NH + h]) * softplus_f(araw + p.dt_bias[l * NH + h]);
#pragma unroll
              for (int o = 1; o < 64; o <<= 1) { const float u = __shfl_up(g, o); if (row >= o) g += u; }
              gcS[kk * 64 + row] = g; if (row == 63) egl[I] = __expf(g); }
          __syncthreads(); }
        u32x4 raw[3][4][2];
#define PREP_LOADRAW(kq) do { const int I_ = (int)blockIdx.x * 8 + batch * 4 + (kq), h_ = I_ >> 8, c_ = I_ & 255; \
            _Pragma("unroll") for (int X = 0; X < 3; ++X) _Pragma("unroll") for (int r = 0; r < 4; ++r) { int tt_ = 64 * c_ + (tid0 >> 3) - 3 + r; tt_ = tt_ < 0 ? 0 : tt_; \
                const u32x4* pp_ = (const u32x4*)(proj + (size_t)tt_ * NIN + X * 1024 + h_ * 128 + 16 * (tid0 & 7)); raw[X][r][0] = pp_[0]; raw[X][r][1] = pp_[1]; } } while (0)
        PREP_LOADRAW(0);
#pragma unroll 1
        for (int k = 0; k < 4; ++k) {
            int tid = tid0; asm volatile("" : "+v"(tid));
            const int lane = tid & 63, r16 = lane & 15, q4 = lane >> 4, i = tid >> 3, sub = tid & 7;
            const int I = (int)blockIdx.x * 8 + batch * 4 + k, h = I >> 8, c = I & 255, t = 64 * c + i;
            const float gci = gcS[k * 64 + i], glast = gcS[k * 64 + 63];
#pragma unroll
            for (int X = 0; X < 3; ++X) {
                const int col = X * 1024 + h * 128 + 16 * sub;
                float y[16];
#pragma unroll
                for (int e = 0; e < 16; ++e) y[e] = 0.f;
#pragma unroll
                for (int r = 0; r < 4; ++r) { const int tt = t - 3 + r;
                    if (tt >= 0) { float xv[16]; unpack8(raw[X][r][0], xv); unpack8(raw[X][r][1], xv + 8);
                        const LAS f32x4* wp = (const LAS f32x4*)(cwS + (r * 3 + X) * 128 + 16 * sub);
#pragma unroll
                        for (int e4 = 0; e4 < 4; ++e4) { const f32x4 w = wp[e4]; y[4 * e4] += w.x * xv[4 * e4]; y[4 * e4 + 1] += w.y * xv[4 * e4 + 1]; y[4 * e4 + 2] += w.z * xv[4 * e4 + 2]; y[4 * e4 + 3] += w.w * xv[4 * e4 + 3]; } } }
                float ss = 0.f;
#pragma unroll
                for (int e = 0; e < 16; ++e) { y[e] = silu_f(y[e]); ss += y[e] * y[e]; }
                if (X < 2) { ss += __shfl_xor(ss, 1); ss += __shfl_xor(ss, 2); ss += __shfl_xor(ss, 4);
                    const float scl = rsqrtf(ss + EPS_) * (X == 0 ? 0.08838834764831845f : 1.f);
#pragma unroll
                    for (int e = 0; e < 16; ++e) y[e] *= scl; }
                if (X == 0) { *(LAS u32x4*)(Qn + i * 136 + 16 * sub) = pack8(y); *(LAS u32x4*)(Qn + i * 136 + 16 * sub + 8) = pack8(y + 8);
                    const float eg = __expf(gci); float z[16];
#pragma unroll
                    for (int e = 0; e < 16; ++e) z[e] = y[e] * eg;
                    { const int c8a = 2 * sub, c8b = 2 * sub + 1;
                      *(u32x4*)(Qgg + (size_t)I * 8192 + ((((i >> 4) * 4 + (c8a >> 2)) * 64 + (c8a & 3) * 16 + (i & 15)) * 8)) = pack8(z);
                      *(u32x4*)(Qgg + (size_t)I * 8192 + ((((i >> 4) * 4 + (c8b >> 2)) * 64 + (c8b & 3) * 16 + (i & 15)) * 8)) = pack8(z + 8); }
                } else if (X == 1) { const u32x4 k0 = pack8(y), k1 = pack8(y + 8);
                    *(LAS u32x4*)(Kn + i * 136 + 16 * sub) = k0; *(LAS u32x4*)(Kn + i * 136 + 16 * sub + 8) = k1;
                    u32x4* dst = (u32x4*)(Wg + ((size_t)I * 64 + i) * 128 + 16 * sub); dst[0] = k0; dst[1] = k1;
                    const float ed = __expf(glast - gci);
#pragma unroll
                    for (int e = 0; e < 16; e += 2) { const unsigned w = pk2(y[e] * ed, y[e + 1] * ed); KdTs[(16 * sub + e) * 72 + i] = (bf16_t)(w & 0xffffu); KdTs[(16 * sub + e + 1) * 72 + i] = (bf16_t)(w >> 16); }
                } else { u32x4* dst = (u32x4*)(UTg + ((size_t)I * 64 + i) * 128 + 16 * sub); dst[0] = pack8(y); dst[1] = pack8(y + 8); }
            }
            __syncthreads();
            if (k < 3) PREP_LOADRAW(k + 1);
#pragma unroll
            for (int u = 0; u < 2; ++u) { const int ch = tid + 512 * u, d = ch >> 3, part = ch & 7;
                *(u32x4*)(KdTg + (size_t)I * 8192 + ((((d >> 4) * 2 + (part >> 2)) * 64 + (part & 3) * 16 + (d & 15)) * 8)) = *(const LAS u32x4*)(KdTs + d * 72 + 8 * part); }
            { const int pr = wave >> 2, ti = wave & 3;
              for (int tj = 0; tj < 4; ++tj) {
                  f32x4 acc = {0.f, 0.f, 0.f, 0.f};
                  if (tj <= ti) {
#pragma unroll
                      for (int s = 0; s < 4; ++s) {
                          if (pr == 0) { const bf16x8 a = *(const LAS bf16x8*)(Kn + (16 * ti + r16) * 136 + 32 * s + 8 * q4), b = *(const LAS bf16x8*)(Kn + (16 * tj + r16) * 136 + 32 * s + 8 * q4); acc = MFMA16(a, b, acc); }
                          else { const bf16x8 a = *(const LAS bf16x8*)(Kn + (16 * tj + r16) * 136 + 32 * s + 8 * q4), b = *(const LAS bf16x8*)(Qn + (16 * ti + r16) * 136 + 32 * s + 8 * q4); acc = MFMA16(a, b, acc); }
                      }
                  }
                  if (pr == 0) {
                      if (tj <= ti) { const int jj = 16 * tj + r16; const float gj = gcS[k * 64 + jj];
#pragma unroll
                          for (int rg = 0; rg < 4; ++rg) { const int ii = 16 * ti + 4 * q4 + rg; const float v = (ii > jj) ? betaS[k * 64 + ii] * acc[rg] * __expf(gcS[k * 64 + ii] - gj) : 0.f;
                              Lslot[k * 4096 + ii * 64 + jj] = v; } }
                  } else {
                      const int ii = 16 * ti + r16; const float gi = gcS[k * 64 + ii]; float o[4];
#pragma unroll
                      for (int rg = 0; rg < 4; ++rg) { const int jj = 16 * tj + 4 * q4 + rg; o[rg] = (tj <= ti && ii >= jj) ? acc[rg] * __expf(gi - gcS[k * 64 + jj]) : 0.f; }
                      u32x2 w; w.x = pk2(o[0], o[1]); w.y = pk2(o[2], o[3]);
                      *(u32x2*)(Ag + (size_t)I * 4096 + (((ti * 2 + (tj >> 1)) * 64 + ((2 * tj + (q4 >> 1)) & 3) * 16 + r16) * 8) + 4 * (q4 & 1)) = w;
                  }
              } }
            __syncthreads();
        }
        if (wave < 4) {
            const int lane = tid0 & 63;
            LAS float* L = Lslot + wave * 4096; float tc[64];
#pragma unroll
            for (int ii = 0; ii < 64; ++ii) { float a = (lane == ii) ? 1.f : 0.f;
#pragma unroll
                for (int jj = 0; jj < ii; ++jj) a -= L[ii * 64 + jj] * tc[jj];
                tc[ii] = a;
                if ((ii & 3) == 3) asm volatile("" ::: "memory"); }
            LDS_WAIT();
#pragma unroll
            for (int ii = 0; ii < 64; ++ii) L[ii * 64 + lane] = tc[ii];
        }
        __syncthreads();
#pragma unroll 1
        for (int k = 0; k < 4; ++k) {
            int tid = tid0; asm volatile("" : "+v"(tid));
            const int lane = tid & 63, r16 = lane & 15, q4 = lane >> 4, i = tid >> 3, sub = tid & 7;
            const int I = (int)blockIdx.x * 8 + batch * 4 + k;
            { const float be = betaS[k * 64 + i], beg = be * __expf(gcS[k * 64 + i]);
              const u32x4* pk = (const u32x4*)(Wg + ((size_t)I * 64 + i) * 128 + 16 * sub); const u32x4* pv = (const u32x4*)(UTg + ((size_t)I * 64 + i) * 128 + 16 * sub);
              float kv[16], vv[16]; unpack8(pk[0], kv); unpack8(pk[1], kv + 8); unpack8(pv[0], vv); unpack8(pv[1], vv + 8);
#pragma unroll
              for (int e = 0; e < 16; ++e) { vv[e] *= be; kv[e] *= beg; }
              *(LAS u32x4*)(VbT + i * 136 + 16 * sub) = pack8(vv); *(LAS u32x4*)(VbT + i * 136 + 16 * sub + 8) = pack8(vv + 8);
              *(LAS u32x4*)(KbgT + i * 136 + 16 * sub) = pack8(kv); *(LAS u32x4*)(KbgT + i * 136 + 16 * sub + 8) = pack8(kv + 8); }
            __syncthreads();
            { const int pr = wave >> 2, ti = wave & 3; bf16x8 aT[2];
#pragma unroll
              for (int s = 0; s < 2; ++s) { const LAS float* tp = Lslot + k * 4096 + (16 * ti + r16) * 64 + 32 * s + 8 * q4; const f32x4 t0 = *(const LAS f32x4*)tp, t1 = *(const LAS f32x4*)(tp + 4);
                  u32x4 w; w.x = pk2(t0.x, t0.y); w.y = pk2(t0.z, t0.w); w.z = pk2(t1.x, t1.y); w.w = pk2(t1.z, t1.w); aT[s] = as_bf8(w); }
#pragma unroll 2
              for (int tn = 0; tn < 8; ++tn) { f32x4 acc = {0.f, 0.f, 0.f, 0.f};
                  if (pr == 0) {
#pragma unroll
                      for (int s = 0; s < 2; ++s) { const LAS bf16_t* bp = VbT + (32 * s + 8 * q4 + (r16 >> 2)) * 136 + 16 * tn + 4 * (r16 & 3);
                          const s16x4 t0 = __builtin_amdgcn_ds_read_tr16_b64_v4i16((LAS s16x4*)bp), t1 = __builtin_amdgcn_ds_read_tr16_b64_v4i16((LAS s16x4*)(bp + 4 * 136));
                          const bf16x8 b = {t0[0], t0[1], t0[2], t0[3], t1[0], t1[1], t1[2], t1[3]}; acc = MFMA16(aT[s], b, acc); }
                      u32x2 w; w.x = pk2(acc[0], acc[1]); w.y = pk2(acc[2], acc[3]);
                      *(u32x2*)(UTg + (size_t)I * 8192 + (((tn * 4 + ti) * 64 + lane) * 4)) = w;
                  } else {
#pragma unroll
                      for (int s = 0; s < 2; ++s) { const LAS bf16_t* bp = KbgT + (32 * s + 8 * q4 + (r16 >> 2)) * 136 + 16 * tn + 4 * (r16 & 3);
                          const s16x4 t0 = __builtin_amdgcn_ds_read_tr16_b64_v4i16((LAS s16x4*)bp), t1 = __builtin_amdgcn_ds_read_tr16_b64_v4i16((LAS s16x4*)(bp + 4 * 136));
                          const bf16x8 b = {t0[0], t0[1], t0[2], t0[3], t1[0], t1[1], t1[2], t1[3]}; acc = MFMA16(b, aT[s], acc); }
                      u32x2 w; w.x = pk2(acc[0], acc[1]); w.y = pk2(acc[2], acc[3]);
                      *(u32x2*)(Wg + (size_t)I * 8192 + (((ti * 4 + (tn >> 1)) * 64 + ((2 * tn + (q4 >> 1)) & 3) * 16 + r16) * 8) + 4 * (q4 & 1)) = w;
                  } } }
            __syncthreads();
        }
    }
}

struct ScanBuf { bf16x8 a4[4]; bf16x8 a2[2]; bf16x8 kd[2]; u32x2 u[2]; float eg; };
template <int ROLE, int HOT>
__device__ __forceinline__ void scan_loop(const Params& p, LAS bf16_t* ST, LAS bf16_t* VT, int h, int vs, int wave, int lane) {
    const int r16 = lane & 15, q4 = lane >> 4, tm = wave & 3;
    const bf16_t* Wg = (const bf16_t*)(p.ws + WS_GDN); const bf16_t* UTg = (const bf16_t*)(p.ws + WS_GDN + 32 * MiB); const bf16_t* KdTg = (const bf16_t*)(p.ws + WS_GDN + 64 * MiB);
    const bf16_t* Qgg = (const bf16_t*)(p.ws + WS_GDN + 96 * MiB); const bf16_t* Ag = (const bf16_t*)(p.ws + WS_GDN + 128 * MiB);
    const float* egl = (const float*)(p.ws + WS_EGL);
    bf16_t* ocat = (bf16_t*)(p.ws + (HOT ? WS_H : WS_OCAT));
    const bf16_t* p4 = ROLE ? Qgg : Wg;
    f32x4 accS[2] = {{0.f, 0.f, 0.f, 0.f}, {0.f, 0.f, 0.f, 0.f}};
    ScanBuf B[4];
#define SCAN_LOAD(buf, cc) do { const size_t I_ = (size_t)h * 256 + (HOT ? ((cc) & 3) : (cc)); \
        _Pragma("unroll") for (int s = 0; s < 4; ++s) (buf).a4[s] = *(const bf16x8*)(p4 + I_ * 8192 + ((tm * 4 + s) * 64 + lane) * 8); \
        _Pragma("unroll") for (int s = 0; s < 2; ++s) (buf).kd[s] = *(const bf16x8*)(KdTg + I_ * 8192 + ((wave * 2 + s) * 64 + lane) * 8); \
        if (ROLE) { _Pragma("unroll") for (int s = 0; s < 2; ++s) (buf).a2[s] = *(const bf16x8*)(Ag + I_ * 4096 + ((tm * 2 + s) * 64 + lane) * 8); } \
        else { _Pragma("unroll") for (int tn = 0; tn < 2; ++tn) (buf).u[tn] = *(const u32x2*)(UTg + I_ * 8192 + (((vs * 2 + tn) * 4 + tm) * 64 + lane) * 4); } \
        (buf).eg = egl[I_]; } while (0)
#pragma unroll
    for (int u = 0; u < 4; ++u) SCAN_LOAD(B[u], u);
    for (int c0 = 0; c0 < 256; c0 += 4) {
#pragma unroll
        for (int u = 0; u < 4; ++u) {
            const int c = c0 + u, pb = u & 1;
            const LAS bf16_t* STc = ST + pb * (32 * 136); LAS bf16_t* STn = ST + (pb ^ 1) * (32 * 136);
            if (ROLE == 0) asm volatile("" : "+v"(B[u].u[0].x), "+v"(B[u].u[0].y), "+v"(B[u].u[1].x), "+v"(B[u].u[1].y), "+v"(B[u].eg));
            else asm volatile("" : "+v"(B[u].eg));
            bf16x8 sf[2][4];
#pragma unroll
            for (int tn = 0; tn < 2; ++tn)
#pragma unroll
                for (int s = 0; s < 4; ++s) sf[tn][s] = *(const LAS bf16x8*)(STc + (16 * tn + r16) * 136 + 32 * s + 8 * q4);
            f32x4 o[2] = {{0.f, 0.f, 0.f, 0.f}, {0.f, 0.f, 0.f, 0.f}};
            if (ROLE == 0) {
#pragma unroll
                for (int tn = 0; tn < 2; ++tn) { f32x4 t1 = {0.f, 0.f, 0.f, 0.f};
#pragma unroll
                    for (int s = 0; s < 4; ++s) t1 = MFMA16(B[u].a4[s], sf[tn][s], t1);
                    const float v0 = bflo(B[u].u[tn].x) - t1[0], v1 = bfhi(B[u].u[tn].x) - t1[1], v2 = bflo(B[u].u[tn].y) - t1[2], v3 = bfhi(B[u].u[tn].y) - t1[3];
                    u32x2 w; w.x = pk2(v0, v1); w.y = pk2(v2, v3);
                    *(LAS u32x2*)(VT + (16 * tn + r16) * 72 + 16 * tm + 4 * q4) = w; }
            } else {
#pragma unroll
                for (int tn = 0; tn < 2; ++tn)
#pragma unroll
                    for (int s = 0; s < 4; ++s) o[tn] = MFMA16(sf[tn][s], B[u].a4[s], o[tn]);
            }
            accS[0] *= B[u].eg; accS[1] *= B[u].eg;
            LDS_WAIT(); __builtin_amdgcn_s_barrier(); asm volatile("" ::: "memory");
            bf16x8 vf[2][2];
#pragma unroll
            for (int tn = 0; tn < 2; ++tn)
#pragma unroll
                for (int s = 0; s < 2; ++s) vf[tn][s] = *(const LAS bf16x8*)(VT + (16 * tn + r16) * 72 + 32 * s + 8 * q4);
#pragma unroll
            for (int tn = 0; tn < 2; ++tn) {
#pragma unroll
                for (int s = 0; s < 2; ++s) accS[tn] = MFMA16(B[u].kd[s], vf[tn][s], accS[tn]);
                u32x2 w; w.x = pk2(accS[tn][0], accS[tn][1]); w.y = pk2(accS[tn][2], accS[tn][3]);
                *(LAS u32x2*)(STn + (16 * tn + r16) * 136 + 16 * wave + 4 * q4) = w; }
            if (ROLE) {
#pragma unroll
                for (int tn = 0; tn < 2; ++tn) {
#pragma unroll
                    for (int s = 0; s < 2; ++s) o[tn] = MFMA16(vf[tn][s], B[u].a2[s], o[tn]);
                    u32x2 w; w.x = pk2(o[tn][0], o[tn][1]); w.y = pk2(o[tn][2], o[tn][3]);
                    if (HOT < 2) *(u32x2*)(ocat + (size_t)(64 * c + 16 * tm + r16) * D_ + h * 128 + vs * 32 + 16 * tn + 4 * q4) = w; else asm volatile("" :: "v"(w.x), "v"(w.y)); }
            }
            { const int cn = (c + 4 < 256) ? c + 4 : 255; SCAN_LOAD(B[u], cn); }
            LDS_WAIT(); __builtin_amdgcn_s_barrier(); asm volatile("" ::: "memory");
        }
    }
#undef SCAN_LOAD
}
template <int HOT>
__device__ __forceinline__ void scan_phase(const Params& p, LAS unsigned char* lds, const int tid_in) {
    const int tid = tid_in, lane = tid & 63, wave = __builtin_amdgcn_readfirstlane(tid >> 6);
    const int h = (int)blockIdx.x & 7, vs = (int)blockIdx.x >> 3;
    LAS bf16_t* ST = (LAS bf16_t*)lds;
    LAS bf16_t* VT = (LAS bf16_t*)(lds + 17408);
    for (int u = tid; u < 2 * 32 * 136 / 2; u += 512) ((LAS unsigned*)ST)[u] = 0u;
    __syncthreads();
    if (wave < 4) scan_loop<0, HOT>(p, ST, VT, h, vs, wave, lane); else scan_loop<1, HOT>(p, ST, VT, h, vs, wave, lane);
    __syncthreads();
}


__device__ __forceinline__ void sb_attn_phase(const Params& p, LAS unsigned char* lds, int l, int first_blk, int nblk, const int tid_in) {
    const int tid = tid_in, lane = tid & 63, wave = __builtin_amdgcn_readfirstlane(tid >> 6);
    const int r16 = lane & 15, q4 = lane >> 4;
    LAS bf16_t* Qs = (LAS bf16_t*)lds; LAS bf16_t* Ks = (LAS bf16_t*)(lds + 34816); LAS bf16_t* Vs = (LAS bf16_t*)(lds + 52224);
    LAS float* Z = (LAS float*)(lds + 70656); LAS bf16_t* As = (LAS bf16_t*)(lds + 103936); LAS float* SegTot = (LAS float*)(lds + 122368);
    const bf16_t* proj = (const bf16_t*)(p.ws + WS_PROJ);
    bf16_t* ocat = (bf16_t*)(p.ws + WS_OCAT);
    const float* gq = p.sbq + l * 128; const float* gk = p.sbk + l * 128;
    const int q = tid & 127, seg = tid >> 7;
    for (int item = (int)blockIdx.x - first_blk; item < 1024; item += nblk) {
        const int h = item & 7, qb = 127 - (item >> 3);
#pragma unroll
        for (int u = 0; u < 4; ++u) { const int ch = tid + 512 * u, row = ch >> 4, c8 = ch & 15;
            float xv[8]; unpack8(*(const u32x4*)(proj + (size_t)(128 * qb + row) * NIN + PQ_B + h * 128 + 8 * c8), xv);
            float ss = 0.f;
#pragma unroll
            for (int e = 0; e < 8; ++e) ss += xv[e] * xv[e];
            ss += __shfl_xor(ss, 1); ss += __shfl_xor(ss, 2); ss += __shfl_xor(ss, 4); ss += __shfl_xor(ss, 8);
            const float sc = rsqrtf(ss * (1.f / 128.f) + EPS_) * 0.08838834764831845f;
#pragma unroll
            for (int e = 0; e < 8; ++e) xv[e] *= sc * gq[8 * c8 + e];
            *(LAS u32x4*)(Qs + row * 136 + 8 * c8) = pack8(xv); }
        f32x4 oacc[8];
#pragma unroll
        for (int tn = 0; tn < 8; ++tn) oacc[tn] = (f32x4){0.f, 0.f, 0.f, 0.f};
        float Rq = 0.f;
        const int tq = 128 * qb + q;
        u32x4 kreg[2], vreg[2];
#pragma unroll
        for (int u = 0; u < 2; ++u) { const int ch = tid + 512 * u, row = ch >> 4, c8 = ch & 15; const size_t rb = (size_t)(64 * (2 * qb + 1) + row) * NIN + h * 128 + 8 * c8;
            kreg[u] = *(const u32x4*)(proj + rb + PK_B); vreg[u] = *(const u32x4*)(proj + rb + PV_B); }
        for (int j = 2 * qb + 1; j >= 0; --j) {
#pragma unroll
            for (int u = 0; u < 2; ++u) { const int ch = tid + 512 * u, row = ch >> 4, c8 = ch & 15;
                float xv[8]; unpack8(kreg[u], xv);
                float ss = 0.f;
#pragma unroll
                for (int e = 0; e < 8; ++e) ss += xv[e] * xv[e];
                ss += __shfl_xor(ss, 1); ss += __shfl_xor(ss, 2); ss += __shfl_xor(ss, 4); ss += __shfl_xor(ss, 8);
                const float sc = rsqrtf(ss * (1.f / 128.f) + EPS_);
#pragma unroll
                for (int e = 0; e < 8; ++e) xv[e] *= sc * gk[8 * c8 + e];
                *(LAS u32x4*)(Ks + row * 136 + 8 * c8) = pack8(xv);
                *(LAS u32x4*)(Vs + row * 136 + 8 * c8) = vreg[u]; }
            { const int jn = j > 0 ? j - 1 : 0;
#pragma unroll
              for (int u = 0; u < 2; ++u) { const int ch = tid + 512 * u, row = ch >> 4, c8 = ch & 15; const size_t rb = (size_t)(64 * jn + row) * NIN + h * 128 + 8 * c8;
                  kreg[u] = *(const u32x4*)(proj + rb + PK_B); vreg[u] = *(const u32x4*)(proj + rb + PV_B); } }
            __syncthreads();
            { bf16x8 qf[4];
#pragma unroll
              for (int s = 0; s < 4; ++s) qf[s] = *(const LAS bf16x8*)(Qs + (16 * wave + r16) * 136 + 32 * s + 8 * q4);
#pragma unroll
              for (int tn = 0; tn < 4; ++tn) { f32x4 acc = {0.f, 0.f, 0.f, 0.f};
#pragma unroll
                  for (int s = 0; s < 4; ++s) { const bf16x8 kf = *(const LAS bf16x8*)(Ks + (16 * tn + r16) * 136 + 32 * s + 8 * q4); acc = MFMA16(qf[s], kf, acc); }
#pragma unroll
                  for (int rg = 0; rg < 4; ++rg) Z[(16 * wave + 4 * q4 + rg) * 65 + 16 * tn + r16] = acc[rg]; } }
            __syncthreads();
            float zz[16], ls[16], suf[16]; const int s0 = 64 * j + 16 * seg;
#pragma unroll
            for (int e = 0; e < 16; ++e) { zz[e] = Z[q * 65 + 16 * seg + e]; ls[e] = (s0 + e < tq) ? -softplus_fast(zz[e]) : 0.f; }
            float run = 0.f;
#pragma unroll
            for (int e = 15; e >= 0; --e) { suf[e] = run; run += ls[e]; }
            SegTot[seg * 128 + q] = run;
            __syncthreads();
            float hi = 0.f, all = 0.f;
#pragma unroll
            for (int sg = 0; sg < 4; ++sg) { const float tv = SegTot[sg * 128 + q]; all += tv; if (sg > seg) hi += tv; }
            const float base = Rq + hi; float av[16];
#pragma unroll
            for (int e = 0; e < 16; ++e) av[e] = (s0 + e < tq) ? __expf(zz[e] + ls[e] + base + suf[e]) : 0.f;
            Rq += all;
            *(LAS u32x4*)(As + q * 72 + 16 * seg) = pack8(av); *(LAS u32x4*)(As + q * 72 + 16 * seg + 8) = pack8(av + 8);
            __syncthreads();
            { bf16x8 af[2];
#pragma unroll
              for (int s = 0; s < 2; ++s) af[s] = *(const LAS bf16x8*)(As + (16 * wave + r16) * 72 + 32 * s + 8 * q4);
#pragma unroll
              for (int tn = 0; tn < 8; ++tn)
#pragma unroll
                  for (int s = 0; s < 2; ++s) {
                      const LAS bf16_t* vp = Vs + (32 * s + 8 * q4 + (r16 >> 2)) * 136 + 16 * tn + 4 * (r16 & 3);
                      const s16x4 t0 = __builtin_amdgcn_ds_read_tr16_b64_v4i16((LAS s16x4*)vp), t1 = __builtin_amdgcn_ds_read_tr16_b64_v4i16((LAS s16x4*)(vp + 4 * 136));
                      const bf16x8 vf = {t0[0], t0[1], t0[2], t0[3], t1[0], t1[1], t1[2], t1[3]};
                      oacc[tn] = MFMA16(vf, af[s], oacc[tn]); } }
            if (!__syncthreads_or(Rq >= -104.f)) break;
        }
        __syncthreads();
#pragma unroll
        for (int tn = 0; tn < 8; ++tn) { u32x2 w; w.x = pk2(oacc[tn][0], oacc[tn][1]); w.y = pk2(oacc[tn][2], oacc[tn][3]);
            *(u32x2*)(ocat + (size_t)(128 * qb + 16 * wave + r16) * D_ + 1024 + h * 128 + 16 * tn + 4 * q4) = w; }
    }
}

__device__ __forceinline__ void gdn_finalize_phase(const Params& p, int l, const int tid_in) {
    const int g = opaque_bid() * 512 + tid_in, l16 = g & 15;
    bf16_t* ocat = (bf16_t*)(p.ws + WS_OCAT); const bf16_t* proj = (const bf16_t*)(p.ws + WS_PROJ);
    float gn[8];
#pragma unroll
    for (int e = 0; e < 8; ++e) gn[e] = p.gdn_norm[l * 128 + 8 * l16 + e];
    const int Rstep = ((int)gridDim.x * 512) >> 4;
    for (int R0 = g >> 4; R0 < T_ * NH; R0 += 4 * Rstep) {
        u32x4 oraw[4], zraw[4];
#pragma unroll
        for (int q = 0; q < 4; ++q) { const int R = R0 + q * Rstep, t = R >> 3, h = R & 7;
            oraw[q] = *(const u32x4*)(ocat + (size_t)t * D_ + h * 128 + 8 * l16); zraw[q] = *(const u32x4*)(proj + (size_t)t * NIN + PZ_A + h * 128 + 8 * l16); }
#pragma unroll
        for (int q = 0; q < 4; ++q) { const int R = R0 + q * Rstep, t = R >> 3, h = R & 7;
            float ov[8], zv[8]; unpack8(oraw[q], ov); unpack8(zraw[q], zv);
            float ss = 0.f;
#pragma unroll
            for (int e = 0; e < 8; ++e) ss += ov[e] * ov[e];
            ss += __shfl_xor(ss, 1); ss += __shfl_xor(ss, 2); ss += __shfl_xor(ss, 4); ss += __shfl_xor(ss, 8);
            const float rs = rsqrtf(ss * (1.f / 128.f) + EPS_);
#pragma unroll
            for (int e = 0; e < 8; ++e) ov[e] = ov[e] * rs * gn[e] * silu_f(zv[e]);
            *(u32x4*)(ocat + (size_t)t * D_ + h * 128 + 8 * l16) = pack8(ov); }
    }
}

__device__ __forceinline__ void act_fix_rows(const Params& p, int l, const int tid_in, const int pm) {
    bf16_t* V = (bf16_t*)(p.ws + WS_V); const bf16_t* Gh = (const bf16_t*)(p.ws + WS_G); const bf16_t* Gt = (const bf16_t*)(p.ws + WS_G + 8 * MiB); const bf16_t* Vh = (const bf16_t*)(p.ws + WS_G + 16 * MiB);
    const float* cw = p.conv_ffn + (size_t)l * 3 * DFF;
#pragma unroll 1
    for (int u0 = 0; u0 < 12; u0 += 4) {
        u32x4 ra[4], rb[4], rc[4], rv[4];
#pragma unroll
        for (int u = 0; u < 4; ++u) { int it = tid_in + 512 * (u0 + u); it = it < 8 * 704 ? it : 8 * 704 - 1; const int q = it / 704, col = 8 * (it % 704), sp = 4 * pm + (q >> 1), rs = q & 1, spm = sp > 0 ? sp - 1 : 0;
            ra[u] = *(const u32x4*)(rs ? Gt + (size_t)(spm * 2 + 1) * DFF + col : Gt + (size_t)(spm * 2) * DFF + col);
            rb[u] = *(const u32x4*)(rs ? Gh + (size_t)(sp * 2) * DFF + col : Gt + (size_t)(spm * 2 + 1) * DFF + col);
            rc[u] = *(const u32x4*)(rs ? Gh + (size_t)(sp * 2 + 1) * DFF + col : Gh + (size_t)(sp * 2) * DFF + col);
            rv[u] = *(const u32x4*)(Vh + (size_t)(sp * 2 + rs) * DFF + col); }
#pragma unroll
        for (int u = 0; u < 4; ++u) { const int it = tid_in + 512 * (u0 + u);
            if (it < 8 * 704) { const int q = it / 704, col = 8 * (it % 704), sp = 4 * pm + (q >> 1), rs = q & 1;
                float ga[8], gb[8], gc[8], vv[8], o[8]; unpack8(ra[u], ga); unpack8(rb[u], gb); unpack8(rc[u], gc); unpack8(rv[u], vv);
                const float za = (sp > 0) ? 1.f : 0.f, zb = (sp > 0 || rs) ? 1.f : 0.f;
#pragma unroll
                for (int e = 0; e < 8; ++e) o[e] = silu_f(cw[col + e] * (ga[e] * za) + cw[DFF + col + e] * (gb[e] * zb) + cw[2 * DFF + col + e] * gc[e]) * vv[e];
                *(u32x4*)(V + ((size_t)64 * sp + rs) * DFF + col) = pack8(o); } }
    }
}

__global__ void __launch_bounds__(512) fwd_megakernel(Params p) {
    extern __shared__ __attribute__((aligned(16))) unsigned char lds_raw[];
    LAS unsigned char* lds = (LAS unsigned char*)lds_raw;
    cg::grid_group grid = cg::this_grid();
    const int wave_sg = __builtin_amdgcn_readfirstlane((int)threadIdx.x >> 6);
    if (threadIdx.x < 4) ((volatile LAS unsigned*)(lds + 131072))[threadIdx.x] = 0u;
    __syncthreads();
    (void)xcd_barrier_post((unsigned*)(p.ws + WS_BAR), (volatile LAS unsigned*)(lds + 131072));
    if (p.ph_hi < 0) grid.sync();
#if defined(__HIP_DEVICE_COMPILE__)
#define GRID_BARRIER() xcd_barrier((unsigned*)(((const __attribute__((address_space(4))) Params*)__builtin_amdgcn_kernarg_segment_ptr())->ws + WS_BAR), (volatile LAS unsigned*)(lds + 131072), wave_sg == 0 && lane_id_hw() == 0)
#else
#define GRID_BARRIER() xcd_barrier((unsigned*)(p.ws + WS_BAR), (volatile LAS unsigned*)(lds + 131072), wave_sg == 0 && lane_id_hw() == 0)
#endif
    const int lo = p.ph_lo, hi = p.ph_hi;
    int ph = 0;
#ifndef REP_MASK
#define REP_MASK 0
#endif
#if defined(__HIP_DEVICE_COMPILE__)
#define LOAD_ARGS const __attribute__((address_space(4))) Params* kp_ = (const __attribute__((address_space(4))) Params*)__builtin_amdgcn_kernarg_segment_ptr(); asm volatile("" : "+s"(kp_)); Params pp = *kp_;
#else
#define LOAD_ARGS Params pp = p;
#endif
#define PHASE_BEGIN if (ph >= lo && ph < hi) { const int nrep_ = 1 + ((REP_MASK >> ph) & 1); for (int rep_ = 0; rep_ < nrep_; ++rep_) { if (rep_) GRID_BARRIER(); LOAD_ARGS int ll = l; int tid_ = (wave_sg << 6) | lane_id_hw(); asm volatile("" : "+v"(tid_)); asm volatile("" : "+s"(pp.ws), "+s"(ll)); asm volatile("" : "+s"(pp.out));
#define PHASE_END } } ++ph; if (ph > lo && ph < hi) GRID_BARRIER();
    { const int l = 0; PHASE_BEGIN p0_phase(pp, lds, tid_); PHASE_END }
#ifdef REP_SCAN
#define REP_SCAN_N REP_SCAN
#else
#define REP_SCAN_N 0
#endif
#ifdef REP_ATTN
#define REP_ATTN_N 1
#else
#define REP_ATTN_N 0
#endif
#define LAYER_BODY(l)  \
        PHASE_BEGIN norm_phase(pp, lds, (ll == 0) ? pp.x : (const float*)pp.out, pp.norm1 + ll * D_, ll, 0, 2048, ll == 0, tid_); PHASE_END \
        PHASE_BEGIN { GAS unsigned char* wl = pp.ws + WS_W + (size_t)ll * W_LAYER; \
            win_small_cols(pp, lds, ll, tid_); pg8::Gemm g{(const bf16_t*)(pp.ws + WS_H), (const bf16_t*)(wl + W_IN_OFF), T_, 7168, D_}; pg8::StaticOrder S; S.init(T_, 7168, (int)gridDim.x, (int)blockIdx.x); \
            pg8::EpiBf16 E{(bf16_t*)(pp.ws + WS_PROJ), NIN, 0, 0}; pg8::gemm_phase(lds, g, S, E, tid_); } PHASE_END \
        PHASE_BEGIN gdn_prep_phase(pp, lds, ll, tid_); PHASE_END \
        PHASE_BEGIN if ((int)blockIdx.x < 32) { scan_phase<0>(pp, lds, tid_); \
            if (REP_SCAN_N) { __syncthreads(); scan_phase<(REP_SCAN_N > 0 ? REP_SCAN_N - 1 : 0)>(pp, lds, tid_); } \
            } else { sb_attn_phase(pp, lds, ll, 32, (int)gridDim.x - 32, tid_); \
            if (REP_ATTN_N) { __syncthreads(); sb_attn_phase(pp, lds, ll, 32, (int)gridDim.x - 32, tid_); } \
            { __syncthreads(); const int gw_ = ((int)blockIdx.x - 32) * 8 + (tid_ >> 6), ng_ = ((int)gridDim.x - 32) * 8;        \
              weight_transposes(pp, lds, tid_, l, 2 | 4 | 8, gw_, ng_); if (l == 0) weight_transposes(pp, lds, tid_, 1, 1, gw_, ng_); } \
            } PHASE_END \
        PHASE_BEGIN gdn_finalize_phase(pp, ll, tid_); PHASE_END \
        PHASE_BEGIN { GAS unsigned char* wl = pp.ws + WS_W + (size_t)ll * W_LAYER; const float* modf = (const float*)(pp.ws + WS_MODF) + ll * 12288; \
            pg8::Gemm g{(const bf16_t*)(pp.ws + WS_OCAT), (const bf16_t*)(wl + W_OUT_OFF), T_, D_, D_}; pg8::StaticOrder S; S.init(T_, D_, (int)gridDim.x, (int)blockIdx.x); \
            pg8::EpiRes E{(ll == 0) ? pp.x : (const float*)pp.out, (float*)pp.out, D_, modf + 4096}; pg8::gemm_phase(lds, g, S, E, tid_); } PHASE_END \
        PHASE_BEGIN norm_phase(pp, lds, (const float*)pp.out, pp.norm2 + ll * D_, ll, 6144, 8192, false, tid_); PHASE_END \
        PHASE_BEGIN { GAS unsigned char* wl = pp.ws + WS_W + (size_t)ll * W_LAYER; \
            pg8::Gemm g{(const bf16_t*)(pp.ws + WS_H), (const bf16_t*)(wl + W_UP_OFF), T_, NUP, D_}; pg8::StaticOrder S; S.init(T_, NUP, (int)gridDim.x, (int)blockIdx.x); \
            pg8::EpiAct E{(bf16_t*)(pp.ws + WS_V), (bf16_t*)(pp.ws + WS_G), (bf16_t*)(pp.ws + WS_G + 8 * MiB), (bf16_t*)(pp.ws + WS_G + 16 * MiB), pp.conv_ffn + (size_t)ll * 3 * DFF}; pg8::gemm_phase(lds, g, S, E, tid_); } PHASE_END \
        PHASE_BEGIN { GAS unsigned char* wl = pp.ws + WS_W + (size_t)ll * W_LAYER; const float* modf = (const float*)(pp.ws + WS_MODF) + ll * 12288; \
            pg8::Gemm g{(const bf16_t*)(pp.ws + WS_V), (const bf16_t*)(wl + W_DN_OFF), T_, D_, DFF}; pg8::StaticOrder S; S.init(T_, D_, (int)gridDim.x, (int)blockIdx.x); \
            { pg8::Unit uu_; int last_ = -1; for (int i_ = 0; S.next(i_, uu_); ++i_) if (uu_.pm != last_) { act_fix_rows(pp, ll, tid_, uu_.pm); last_ = uu_.pm; } asm volatile("s_waitcnt vmcnt(0)" ::: "memory"); __syncthreads(); } \
            pg8::EpiRes E{(const float*)pp.out, (float*)pp.out, D_, modf + 10240}; pg8::gemm_phase(lds, g, S, E, tid_); } PHASE_END \

    { const int l = 0; LAYER_BODY(l) }
    { const int l = 1; LAYER_BODY(l) }
#undef LAYER_BODY
#undef PHASE_BEGIN
#undef PHASE_END
#ifdef EXTRA_SYNCS
    for (int e = 0; e < EXTRA_SYNCS; ++e) GRID_BARRIER();
#endif
#ifdef DBG_OFF
    GRID_BARRIER();
    { const bf16_t* src = (const bf16_t*)(p.ws + (size_t)DBG_OFF);
      for (size_t i = (size_t)blockIdx.x * 512 + ((wave_sg << 6) | lane_id_hw()); i < (size_t)T_ * D_; i += (size_t)gridDim.x * 512) p.out[i] = bf2f(src[i]); }
#endif
}

extern "C" void kernel_launch(void* const* d_in, const int* in_sizes, int n_in, void* d_out, int out_size, void* d_ws, size_t ws_size, hipStream_t stream) {
    static int grid = 0;
    if (grid == 0) {
        if (n_in != 17 || ws_size < WS_END) { fprintf(stderr, "kernel_launch: expected 17 inputs and >= %zu bytes of workspace; got %d, %zu\n", (size_t)WS_END, n_in, ws_size); grid = -1; return; }
        int dev = 0, cus = 0, per_cu = 0;
        hipGetDevice(&dev); hipDeviceGetAttribute(&cus, hipDeviceAttributeMultiprocessorCount, dev);
        if (hipFuncSetAttribute((const void*)fwd_megakernel, hipFuncAttributeMaxDynamicSharedMemorySize, LDS_BYTES) != hipSuccess) { fprintf(stderr, "kernel_launch: hipFuncSetAttribute failed\n"); grid = -1; return; }
        hipOccupancyMaxActiveBlocksPerMultiprocessor(&per_cu, (const void*)fwd_megakernel, 512, LDS_BYTES);
        if (per_cu < 1) { fprintf(stderr, "kernel_launch: occupancy query says %d blocks/CU\n", per_cu); per_cu = 1; }
        (void)hipGetLastError();
        grid = cus;
        if (grid > 256) grid = 256;
    }
    if (grid < 0) return;
    Params p{};
    p.x = (const float*)d_in[0]; p.c = (const float*)d_in[1]; p.w_ada = (const float*)d_in[2]; p.b_ada = (const float*)d_in[3]; p.norm1 = (const float*)d_in[4];
    p.w_in = (const float*)d_in[5]; p.conv_qkv = (const float*)d_in[6]; p.a_log = (const float*)d_in[7]; p.dt_bias = (const float*)d_in[8]; p.gdn_norm = (const float*)d_in[9];
    p.sbq = (const float*)d_in[10]; p.sbk = (const float*)d_in[11]; p.w_out = (const float*)d_in[12]; p.norm2 = (const float*)d_in[13]; p.w_up = (const float*)d_in[14];
    p.conv_ffn = (const float*)d_in[15]; p.w_down = (const float*)d_in[16];
    p.out = (GAS float*)d_out; p.ws = (GAS unsigned char*)d_ws; p.ph_lo = 0; p.ph_hi = 19;
#ifdef DBG_HI
    p.ph_hi = DBG_HI;
#endif
    if (hipMemsetAsync((char*)d_ws + WS_BAR, 0, XCD_BAR_WORDS * 4, stream) != hipSuccess) { fprintf(stderr, "kernel_launch: hipMemsetAsync failed\n"); return; }
    void* args[] = {&p};
    hipError_t e = hipLaunchCooperativeKernel((const void*)fwd_megakernel, dim3(grid), dim3(512), args, LDS_BYTES, stream);
    if (e != hipSuccess) fprintf(stderr, "cooperative launch failed: %s (grid %d)\n", hipGetErrorString(e), grid);
}
```
